# Optimizing an MI355X kernel written in HIP

```python
import jax, jax.numpy as jnp
from jax import lax
import numpy as np

D_MODEL = 2048
BATCH = 4
SEQ = 2048
DEPTH = 1
DEC_BATCH = 128
DEC_SEQ = 8
PAST_LEN = 16384
PAGE_SIZE = 128

LRU_WIDTH = D_MODEL
LRU_HEADS = 16
LRU_BLOCK = LRU_WIDTH // LRU_HEADS
LRU_C = 8.0
CONV_WIDTH = 4
SSD_WIDTH = D_MODEL
SSD_HEADDIM = 64
SSD_HEADS = SSD_WIDTH // SSD_HEADDIM
SSD_GROUPS = 2
SSD_STATE = 128
SSD_CHUNK = 128
SSD_CONV_DIM = SSD_WIDTH + 2 * SSD_GROUPS * SSD_STATE
D_MIX = LRU_WIDTH + SSD_WIDTH
IN_SPLITS = [LRU_WIDTH, LRU_WIDTH, SSD_WIDTH, SSD_CONV_DIM, SSD_HEADS]
D_IN = sum(IN_SPLITS)
D_FF = ((8 * D_MODEL // 3 + 255) // 256) * 256
N_MEM = 256
XATTN_HEADS = 4
XATTN_HEAD_DIM = D_MODEL // XATTN_HEADS
EPS = 1e-6

kernel_name = "hymba_rglru_ssd_macaron_memxattn_step"


def rmsnorm(x, g):
    xf = x.astype(jnp.float32)
    xf = xf * lax.rsqrt(jnp.mean(xf * xf, axis=-1, keepdims=True) + EPS)
    return (xf * g.astype(jnp.float32)).astype(x.dtype)


def group_rmsnorm(x, g, n_groups):
    shp = x.shape
    xf = x.astype(jnp.float32).reshape(shp[:-1] + (n_groups, shp[-1] // n_groups))
    xf = xf * lax.rsqrt(jnp.mean(xf * xf, axis=-1, keepdims=True) + EPS)
    return xf.reshape(shp) * g.astype(jnp.float32)


def swiglu(x, w_gate, w_up, w_down):
    return (jax.nn.silu(x @ w_gate) * (x @ w_up)) @ w_down


def causal_conv(u, buf, w, b):
    ext = jnp.concatenate([buf.astype(u.dtype), u], axis=1)
    T = u.shape[1]
    y = b + ext[:, 0:T] * w[0]
    for k in range(1, CONV_WIDTH):
        y = y + ext[:, k:k + T] * w[k]
    return y, ext[:, -(CONV_WIDTH - 1):]


def linear_recurrence(a, b, h0):
    def combine(l, r):
        return (l[0] * r[0], r[0] * l[1] + r[1])
    a_cum, b_cum = lax.associative_scan(combine, (a, b), axis=1)
    h = a_cum * h0[:, None] + b_cum
    return h, h[:, -1]


def ssd_chunked(x, dt, A, B, C, h0):
    bsz, T, H, P = x.shape
    G, N = B.shape[2], B.shape[3]
    Q = H // G
    L = min(SSD_CHUNK, T)
    pad = (-T) % L
    if pad:
        pw = lambda t: jnp.pad(t, [(0, 0), (0, pad)] + [(0, 0)] * (t.ndim - 2))
        x, dt, B, C = pw(x), pw(dt), pw(B), pw(C)
    nc = (T + pad) // L
    x = x.reshape(bsz, nc, L, G, Q, P)
    dt = dt.reshape(bsz, nc, L, G, Q)
    B = B.reshape(bsz, nc, L, G, N)
    C = C.reshape(bsz, nc, L, G, N)
    cs = jnp.cumsum(dt * A.reshape(G, Q), axis=2)
    cs_t = jnp.moveaxis(cs, 2, -1)
    causal = jnp.tril(jnp.ones((L, L), dtype=bool))
    decay = jnp.exp(jnp.where(causal, cs_t[..., :, None] - cs_t[..., None, :], -jnp.inf))
    cb = jnp.einsum('bclgn,bcsgn->bcgls', C, B)
    dt_t = jnp.moveaxis(dt, 2, -1)
    w_diag = cb[:, :, :, None] * decay * dt_t[..., None, :]
    y_diag = jnp.einsum('bcgqls,bcsgqp->bclgqp', w_diag, x)
    to_end = jnp.exp(cs[:, :, -1:] - cs) * dt
    chunk_states = jnp.einsum('bclgn,bclgq,bclgqp->bcgqpn', B, to_end, x)
    chunk_decay = jnp.exp(cs[:, :, -1])

    def step(h, inp):
        dec, st = inp
        return dec[..., None, None] * h + st, h

    h_last, h_in = lax.scan(step, h0.reshape(bsz, G, Q, P, N),
                            (jnp.moveaxis(chunk_decay, 1, 0), jnp.moveaxis(chunk_states, 1, 0)))
    h_in = jnp.moveaxis(h_in, 0, 1)
    y_off = jnp.einsum('bclgn,bcgqpn,bclgq->bclgqp', C, h_in, jnp.exp(cs))
    y = (y_diag + y_off).reshape(bsz, nc * L, H, P)[:, :T]
    return y, h_last.reshape(bsz, H, P, N)


def mem_kv(mem, g, w_k, w_v):
    m = rmsnorm(mem, g)
    b = m.shape[0]
    k = (m @ w_k).reshape(b, -1, XATTN_HEADS, XATTN_HEAD_DIM)
    v = (m @ w_v).reshape(b, -1, XATTN_HEADS, XATTN_HEAD_DIM)
    return k, v


def cross_attn(h, k, v, w_q, w_o):
    b, T, _ = h.shape
    q = (h @ w_q).reshape(b, T, XATTN_HEADS, XATTN_HEAD_DIM)
    s = jnp.einsum('bthd,bmhd->bhtm', q.astype(jnp.float32), k.astype(jnp.float32)) * (XATTN_HEAD_DIM ** -0.5)
    p = jax.nn.softmax(s, axis=-1)
    o = jnp.einsum('bhtm,bmhd->bthd', p, v.astype(jnp.float32)).reshape(b, T, D_MODEL)
    return o.astype(h.dtype) @ w_o


def layer(x, k_mem, v_mem, lru_conv0, lru_h0, ssd_conv0, ssd_h0, w):
    (ffn1_g, ffn1_wg, ffn1_wu, ffn1_wd, mix_g, w_in,
     lru_conv_w, lru_conv_b, lru_w_a, lru_b_a, lru_w_x, lru_b_x, lru_lambda, lru_out_g,
     ssd_conv_w, ssd_conv_b, ssd_dt_bias, ssd_a_log, ssd_d, ssd_out_g, w_out,
     xattn_g, w_q, w_o, ffn2_g, ffn2_wg, ffn2_wu, ffn2_wd) = w
    f32 = jnp.float32
    x = x + 0.5 * swiglu(rmsnorm(x, ffn1_g), ffn1_wg, ffn1_wu, ffn1_wd)
    h = rmsnorm(x, mix_g)
    proj = h @ w_in
    idx = [int(v) for v in np.cumsum(IN_SPLITS)[:-1]]
    x_lru, g_lru, z, xbc, dt_raw = jnp.split(proj, idx, axis=-1)
    bsz, T = x.shape[0], x.shape[1]
    u, lru_conv1 = causal_conv(x_lru, lru_conv0, lru_conv_w, lru_conv_b)
    uf = u.astype(f32)
    uh = uf.reshape(bsz, T, LRU_HEADS, LRU_BLOCK)
    r = jax.nn.sigmoid(jnp.einsum('bthi,hij->bthj', uh, lru_w_a.astype(f32)).reshape(bsz, T, LRU_WIDTH) + lru_b_a)
    i = jax.nn.sigmoid(jnp.einsum('bthi,hij->bthj', uh, lru_w_x.astype(f32)).reshape(bsz, T, LRU_WIDTH) + lru_b_x)
    log_a = -LRU_C * r * jax.nn.softplus(-lru_lambda.astype(f32))
    a = jnp.exp(log_a)
    beta = jnp.sqrt(-jnp.expm1(2.0 * log_a))
    hs, lru_h1 = linear_recurrence(a, beta * i * uf, lru_h0.astype(f32))
    y_lru = rmsnorm(hs * jax.nn.gelu(g_lru.astype(f32)), lru_out_g)
    xbc_c, ssd_conv1 = causal_conv(xbc, ssd_conv0, ssd_conv_w, ssd_conv_b)
    xbc_c = jax.nn.silu(xbc_c.astype(f32))
    xs, Bm, Cm = jnp.split(xbc_c, [SSD_WIDTH, SSD_WIDTH + SSD_GROUPS * SSD_STATE], axis=-1)
    dt = jax.nn.softplus(dt_raw.astype(f32) + ssd_dt_bias)
    A = -jnp.exp(ssd_a_log.astype(f32))
    xh = xs.reshape(bsz, T, SSD_HEADS, SSD_HEADDIM)
    y, ssd_h1 = ssd_chunked(xh, dt, A,
                            Bm.reshape(bsz, T, SSD_GROUPS, SSD_STATE),
                            Cm.reshape(bsz, T, SSD_GROUPS, SSD_STATE),
                            ssd_h0.astype(f32))
    y = (y + ssd_d.astype(f32)[:, None] * xh).reshape(bsz, T, SSD_WIDTH)
    y_ssd = group_rmsnorm(y * jax.nn.silu(z.astype(f32)), ssd_out_g, SSD_GROUPS)
    mixed = jnp.concatenate([y_lru, y_ssd], axis=-1).astype(x.dtype) @ w_out
    x = x + mixed
    x = x + cross_attn(rmsnorm(x, xattn_g), k_mem, v_mem, w_q, w_o)
    x = x + 0.5 * swiglu(rmsnorm(x, ffn2_g), ffn2_wg, ffn2_wu, ffn2_wd)
    return x, (lru_conv1, lru_h1, ssd_conv1, ssd_h1)


def setup_inputs(seed: int = 0) -> dict:
    key = jax.random.key(seed)
    ks = iter(jax.random.split(key, 64))
    f32 = jnp.float32

    def normal(shape, scale):
        return scale * jax.random.normal(next(ks), shape, f32)

    def gain(shape):
        return 1.0 + normal(shape, 0.01)

    Lz = DEPTH
    a_init = jax.random.uniform(next(ks), (Lz, LRU_WIDTH), f32, 0.9, 0.999)
    s = a_init ** (1.0 / LRU_C)
    lru_lambda = jnp.log(s) - jnp.log1p(-s)
    dt_init = jnp.exp(jax.random.uniform(next(ks), (Lz, SSD_HEADS), f32, np.log(1e-3), np.log(1e-1)))
    ssd_dt_bias = dt_init + jnp.log(-jnp.expm1(-dt_init))
    ssd_a_log = jnp.log(jax.random.uniform(next(ks), (Lz, SSD_HEADS), f32, 1.0, 16.0))
    return {
        'x_prompt': normal((BATCH, SEQ, D_MODEL), 1.0),
        'mem_prompt': normal((BATCH, N_MEM, D_MODEL), 1.0),
        'x_sample': normal((DEC_BATCH, DEC_SEQ, D_MODEL), 1.0),
        'cache_mem_k': normal((Lz, DEC_BATCH, N_MEM, XATTN_HEADS, XATTN_HEAD_DIM), 1.0),
        'cache_mem_v': normal((Lz, DEC_BATCH, N_MEM, XATTN_HEADS, XATTN_HEAD_DIM), 1.0),
        'state_lru_conv': normal((Lz, DEC_BATCH, CONV_WIDTH - 1, LRU_WIDTH), 1.0),
        'state_lru_h': normal((Lz, DEC_BATCH, LRU_WIDTH), 0.5),
        'state_ssd_conv': normal((Lz, DEC_BATCH, CONV_WIDTH - 1, SSD_CONV_DIM), 1.0),
        'state_ssd_h': normal((Lz, DEC_BATCH, SSD_HEADS, SSD_HEADDIM, SSD_STATE), 0.1),
        'ffn1_norm_g': gain((Lz, D_MODEL)),
        'ffn1_w_gate': normal((Lz, D_MODEL, D_FF), D_MODEL ** -0.5),
        'ffn1_w_up': normal((Lz, D_MODEL, D_FF), D_MODEL ** -0.5),
        'ffn1_w_down': normal((Lz, D_FF, D_MODEL), D_FF ** -0.5),
        'mix_norm_g': gain((Lz, D_MODEL)),
        'w_in': normal((Lz, D_MODEL, D_IN), D_MODEL ** -0.5),
        'lru_conv_w': normal((Lz, CONV_WIDTH, LRU_WIDTH), CONV_WIDTH ** -0.5),
        'lru_conv_b': normal((Lz, LRU_WIDTH), 0.01),
        'lru_w_a': normal((Lz, LRU_HEADS, LRU_BLOCK, LRU_BLOCK), LRU_BLOCK ** -0.5),
        'lru_b_a': normal((Lz, LRU_WIDTH), 0.01),
        'lru_w_x': normal((Lz, LRU_HEADS, LRU_BLOCK, LRU_BLOCK), LRU_BLOCK ** -0.5),
        'lru_b_x': normal((Lz, LRU_WIDTH), 0.01),
        'lru_lambda': lru_lambda,
        'lru_out_norm_g': gain((Lz, LRU_WIDTH)),
        'ssd_conv_w': normal((Lz, CONV_WIDTH, SSD_CONV_DIM), CONV_WIDTH ** -0.5),
        'ssd_conv_b': normal((Lz, SSD_CONV_DIM), 0.01),
        'ssd_dt_bias': ssd_dt_bias,
        'ssd_a_log': ssd_a_log,
        'ssd_d': gain((Lz, SSD_HEADS)),
        'ssd_out_norm_g': gain((Lz, SSD_WIDTH)),
        'w_out': normal((Lz, D_MIX, D_MODEL), D_MIX ** -0.5),
        'xattn_norm_g': gain((Lz, D_MODEL)),
        'mem_norm_g': gain((Lz, D_MODEL)),
        'xattn_w_q': normal((Lz, D_MODEL, D_MODEL), D_MODEL ** -0.5),
        'xattn_w_k': normal((Lz, D_MODEL, D_MODEL), D_MODEL ** -0.5),
        'xattn_w_v': normal((Lz, D_MODEL, D_MODEL), D_MODEL ** -0.5),
        'xattn_w_o': normal((Lz, D_MODEL, D_MODEL), D_MODEL ** -0.5),
        'ffn2_norm_g': gain((Lz, D_MODEL)),
        'ffn2_w_gate': normal((Lz, D_MODEL, D_FF), D_MODEL ** -0.5),
        'ffn2_w_up': normal((Lz, D_MODEL, D_FF), D_MODEL ** -0.5),
        'ffn2_w_down': normal((Lz, D_FF, D_MODEL), D_FF ** -0.5),
        'final_norm_g': gain((D_MODEL,)),
    }


def reference(x_prompt, mem_prompt, x_sample, cache_mem_k, cache_mem_v,
              state_lru_conv, state_lru_h, state_ssd_conv, state_ssd_h,
              ffn1_norm_g, ffn1_w_gate, ffn1_w_up, ffn1_w_down, mix_norm_g, w_in,
              lru_conv_w, lru_conv_b, lru_w_a, lru_b_a, lru_w_x, lru_b_x, lru_lambda, lru_out_norm_g,
              ssd_conv_w, ssd_conv_b, ssd_dt_bias, ssd_a_log, ssd_d, ssd_out_norm_g, w_out,
              xattn_norm_g, mem_norm_g, xattn_w_q, xattn_w_k, xattn_w_v, xattn_w_o,
              ffn2_norm_g, ffn2_w_gate, ffn2_w_up, ffn2_w_down, final_norm_g):
    layer_weights = (ffn1_norm_g, ffn1_w_gate, ffn1_w_up, ffn1_w_down, mix_norm_g, w_in,
                     lru_conv_w, lru_conv_b, lru_w_a, lru_b_a, lru_w_x, lru_b_x, lru_lambda, lru_out_norm_g,
                     ssd_conv_w, ssd_conv_b, ssd_dt_bias, ssd_a_log, ssd_d, ssd_out_norm_g, w_out,
                     xattn_norm_g, xattn_w_q, xattn_w_o, ffn2_norm_g, ffn2_w_gate, ffn2_w_up, ffn2_w_down)
    bp = x_prompt.shape[0]
    xp, xs = x_prompt, x_sample
    p_lc, p_lh, p_sc, p_sh, p_mk, p_mv = [], [], [], [], [], []
    s_lc, s_lh, s_sc, s_sh = [], [], [], []
    for l in range(DEPTH):
        w = tuple(t[l] for t in layer_weights)
        mk, mv = mem_kv(mem_prompt, mem_norm_g[l], xattn_w_k[l], xattn_w_v[l])
        xp, (lc, lh, sc, sh) = layer(
            xp, mk, mv,
            jnp.zeros((bp, CONV_WIDTH - 1, LRU_WIDTH), xp.dtype),
            jnp.zeros((bp, LRU_WIDTH), jnp.float32),
            jnp.zeros((bp, CONV_WIDTH - 1, SSD_CONV_DIM), xp.dtype),
            jnp.zeros((bp, SSD_HEADS, SSD_HEADDIM, SSD_STATE), jnp.float32),
            w)
        p_lc.append(lc); p_lh.append(lh); p_sc.append(sc); p_sh.append(sh); p_mk.append(mk); p_mv.append(mv)
        xs, (lc, lh, sc, sh) = layer(
            xs, cache_mem_k[l], cache_mem_v[l],
            state_lru_conv[l], state_lru_h[l], state_ssd_conv[l], state_ssd_h[l], w)
        s_lc.append(lc); s_lh.append(lh); s_sc.append(sc); s_sh.append(sh)
    y_prompt = rmsnorm(xp, final_norm_g)
    y_sample = rmsnorm(xs, final_norm_g)
    return (y_prompt, y_sample,
            jnp.stack(p_lc), jnp.stack(p_lh), jnp.stack(p_sc), jnp.stack(p_sh), jnp.stack(p_mk), jnp.stack(p_mv),
            jnp.stack(s_lc), jnp.stack(s_lh), jnp.stack(s_sc), jnp.stack(s_sh))
```

```cpp
#include <hip/hip_runtime.h>
#include <cstdio>
#include <cstdint>

constexpr int NWAVES = 8;
constexpr int D = 2048, MP = 8192, MS = 1024, M = MP + MS, TP = 2048, TS = 8, NBP = 4, NBS = 128;
constexpr int FF = 5632, NGU = 2 * FF, DIN = 8736, DINP = 8960, DMIX = 4096, NMEM = 256, MMEM = NBP * NMEM;
constexpr int LRU_H = 16, LRU_B = 128, SSD_H = 32, SSD_P = 64, SSD_N = 128, XBC = 2560;
constexpr int C_XL = 0, C_GL = 2048, C_Z = 4096, C_XBC = 6144, C_DT = 8704;
constexpr float EPS = 1e-6f;
constexpr int NSSQ = 32;
constexpr int NSQV = 144;
constexpr size_t O_Y = 0, O_PLC = (size_t)M * D, O_PLH = O_PLC + (size_t)NBP * 3 * D, O_PSC = O_PLH + (size_t)NBP * D, O_PSH = O_PSC + (size_t)NBP * 3 * XBC,
                 O_PMK = O_PSH + (size_t)NBP * SSD_H * SSD_P * SSD_N, O_PMV = O_PMK + (size_t)MMEM * D, O_SLC = O_PMV + (size_t)MMEM * D, O_SLH = O_SLC + (size_t)NBS * 3 * D,
                 O_SSC = O_SLH + (size_t)NBS * D, O_SSH = O_SSC + (size_t)NBS * 3 * XBC, O_END = O_SSH + (size_t)NBS * SSD_H * SSD_P * SSD_N;
static_assert(O_END == 59766784, "d_out size");
enum { I_XP = 0, I_MEMP, I_XS, I_CK, I_CV, I_SLC, I_SLH, I_SSC, I_SSH, I_F1G, I_F1WG, I_F1WU, I_F1WD, I_MIXG, I_WIN, I_LCW, I_LCB, I_LWA, I_LBA, I_LWX, I_LBX, I_LLAM, I_LOG,
       I_SCW, I_SCB, I_SDTB, I_SALOG, I_SD, I_SOG, I_WOUT, I_XAG, I_MEMG, I_WQ, I_WK, I_WV, I_WO, I_F2G, I_F2WG, I_F2WU, I_F2WD, I_FING, N_IN };
static_assert(N_IN == 41, "inputs");

constexpr size_t MiB = 1u << 20;
constexpr size_t al(size_t x) { return (x + 4095) & ~(size_t)4095; }
constexpr size_t WS_CTL = 0, CTL_ZERO_BYTES = 1 * MiB;
constexpr size_t WS_W1GU = 2 * MiB;
constexpr size_t WS_W1D  = WS_W1GU + al((size_t)NGU * D * 2);
constexpr size_t WS_WIN  = WS_W1D + al((size_t)D * FF * 2);
constexpr size_t WS_WOUT = WS_WIN + al((size_t)DINP * D * 2);
constexpr size_t WS_WQ   = WS_WOUT + al((size_t)D * DMIX * 2);
constexpr size_t WS_WKV  = WS_WQ + al((size_t)D * D * 2);
constexpr size_t WS_WO   = WS_WKV + al((size_t)2 * D * D * 2);
constexpr size_t WS_W2GU = WS_WO + al((size_t)D * D * 2);
constexpr size_t WS_W2D  = WS_W2GU + al((size_t)NGU * D * 2);
constexpr size_t WS_WL   = WS_W2D + al((size_t)D * FF * 2);
constexpr size_t WS_XBA  = WS_WL + al((size_t)LRU_H * 256 * 128 * 2);
constexpr size_t WS_XBB  = WS_XBA + al((size_t)M * D * 2);
constexpr size_t WS_MEMB = WS_XBB + al((size_t)M * D * 2);
constexpr size_t WS_ACT  = WS_MEMB + al((size_t)MMEM * D * 2);
constexpr size_t WS_XR   = WS_ACT + al((size_t)M * FF * 2);
constexpr size_t WS_PROJ = WS_XR + al((size_t)M * D * 4);
constexpr size_t WS_V    = WS_PROJ + al((size_t)M * DINP * 4);
constexpr size_t WS_Q    = WS_V + al((size_t)M * DMIX * 2);
constexpr size_t WS_O    = WS_Q + al((size_t)M * D * 2);
constexpr size_t WS_KM   = WS_O + al((size_t)M * D * 2);
constexpr size_t WS_VT   = WS_KM + al((size_t)MMEM * D * 2);
constexpr size_t WS_SSQ  = WS_VT + al((size_t)MMEM * D * 2);
constexpr size_t WS_SSQM = WS_SSQ + al((size_t)4 * M * NSSQ * 4);
constexpr size_t WS_SQV  = WS_SSQM + al((size_t)MMEM * NSSQ * 4);
constexpr size_t WS_END  = WS_SQV + al((size_t)M * NSQV * 4);
constexpr int CW_TMO = 0, CW_CODE = 1, CW_QUEUE = 64, CW_BAR = 4096;

namespace pg8 {
#define PG8_LAS __attribute__((address_space(3)))
typedef unsigned short bf16_t;
typedef short bf16x8 __attribute__((ext_vector_type(8)));
typedef float f32x4 __attribute__((ext_vector_type(4)));
typedef unsigned u32x4 __attribute__((ext_vector_type(4)));
constexpr int BM = 256, BK = 64, HALF = 128, HTB = HALF * BK * 2  , STAGE_BYTES = 8 * HTB, NXCD = 8, WGM = 8;

__host__ __device__ __forceinline__ int lds_byte(int r, int c) { const int st = (r >> 4) * 2 + (c >> 5), rr = r & 15, cc = c & 31, ob = rr * 64 + cc * 2; return st * 1024 + (ob ^ (((ob >> 9) & 1) << 5)); }
__host__ __device__ __forceinline__ void stage_rc(int b, int& R, int& C) { const int st = b / 1024, sb = b % 1024, swz = sb ^ (((sb >> 9) & 1) << 5); R = (st >> 1) * 16 + swz / 64; C = (st & 1) * 32 + (swz % 64) / 2; }
__host__ __device__ __forceinline__ int perm32(int rho) { const int n = rho >> 4, i = rho & 15; return 8 * (i >> 2) + 4 * n + (i & 3); }

struct Unit { int pm, pn; };
struct Gemm { const bf16_t* A; const bf16_t* Bt; int M, N, K; };

struct StaticOrder {
    int nM, nN, nwg, G, c;
    __host__ __device__ void init(int M, int N, int G_, int c_) { nM = M / BM; nN = N / BM; nwg = nM * nN; G = G_; c = c_; }
    __host__ __device__ bool next(int i, Unit& u) const {
        const long L = (long)i * G + c; if (L >= nwg) return false;
        int wgid = (int)L; { const int q = nwg / NXCD, r = nwg % NXCD, xcd = wgid % NXCD, off = wgid / NXCD; wgid = (xcd < r ? xcd * (q + 1) : r * (q + 1) + (xcd - r) * q) + off; }
        const int nig = WGM * nN, gid = wgid / nig, fm = gid * WGM, gsz = (nM - fm) < WGM ? (nM - fm) : WGM;
        u.pm = fm + ((wgid % nig) % gsz); u.pn = (wgid % nig) / gsz; return true;
    }
    __device__ __forceinline__ void a_ready(const Unit&) const {}
    __device__ __forceinline__ void done(const Unit&) const {}
};

__device__ __forceinline__ unsigned cvt_pk_bf16(float lo, float hi) { unsigned r; asm volatile("v_cvt_pk_bf16_f32 %0, %1, %2" : "=v"(r) : "v"(lo), "v"(hi)); return r; }
typedef unsigned u32x2 __attribute__((ext_vector_type(2)));
constexpr float EPS_ = 1e-6f;
__device__ __forceinline__ float row_rstd(const float* ssq, int row, int fq) {
    const f32x4* p = (const f32x4*)(ssq + (size_t)row * 32 + fq * 8);
    const f32x4 a = p[0], b = p[1];
    float s = ((a[0] + a[1]) + (a[2] + a[3])) + ((b[0] + b[1]) + (b[2] + b[3]));
    s += __shfl_xor(s, 16); s += __shfl_xor(s, 32);
    return __builtin_amdgcn_rsqf(s * (1.0f / 2048.0f) + EPS_);
}
__device__ __forceinline__ float silu_f(float x) { return x * __builtin_amdgcn_rcpf(1.0f + __expf(-x)); }

struct EpiSwiglu {
    static constexpr bool PERM = true, AFTER_DRAIN = false;
    bf16_t* O; int ldc; const float* ssq;
    __device__ __forceinline__ void operator()(const f32x4 (&acc)[2][2][4][2], const Unit& u, int wr, int wc, int fr, int fq) const {
        const int row0 = u.pm * BM + wr * 64 + fr, col0 = u.pn * HALF + wc * 32 + 8 * fq;
#pragma unroll
        for (int ai = 0; ai < 2; ++ai)
#pragma unroll
            for (int m = 0; m < 4; ++m) { const int row = row0 + ai * HALF + m * 16; const float rs = row_rstd(ssq, row, fq);
                u32x4 w; float o[8];
#pragma unroll
                for (int n = 0; n < 2; ++n)
#pragma unroll
                    for (int i = 0; i < 4; ++i) { const float g = acc[ai][0][m][n][i] * rs, up = acc[ai][1][m][n][i] * rs; o[4 * n + i] = silu_f(g) * up; }
                w.x = cvt_pk_bf16(o[0], o[1]); w.y = cvt_pk_bf16(o[2], o[3]); w.z = cvt_pk_bf16(o[4], o[5]); w.w = cvt_pk_bf16(o[6], o[7]);
                *(u32x4*)(O + (size_t)row * ldc + col0) = w; }
    }
};
struct EpiKV {
    static constexpr bool PERM = false, AFTER_DRAIN = false;
    float* ko; float* vo; bf16_t* km; bf16_t* vt; const float* ssq;
    __device__ __forceinline__ void operator()(const f32x4 (&acc)[2][2][4][2], const Unit& u, int wr, int wc, int fr, int fq) const {
        const int row0 = u.pm * BM + wr * 64 + fr;
#pragma unroll
        for (int ai = 0; ai < 2; ++ai)
#pragma unroll
            for (int m = 0; m < 4; ++m) { const int row = row0 + ai * HALF + m * 16; const float rs = row_rstd(ssq, row, fq);
#pragma unroll
                for (int bj = 0; bj < 2; ++bj)
#pragma unroll
                    for (int n = 0; n < 2; ++n) { const int col = u.pn * BM + bj * HALF + wc * 32 + n * 16 + 4 * fq; const f32x4 v = acc[ai][bj][m][n] * rs;
                        if (u.pn < 8) { *(f32x4*)(ko + (size_t)row * 2048 + col) = v; u32x2 w; w.x = cvt_pk_bf16(v[0], v[1]); w.y = cvt_pk_bf16(v[2], v[3]); *(u32x2*)(km + (size_t)row * 2048 + col) = w; }
                        else { const int c2 = col - 2048; *(f32x4*)(vo + (size_t)row * 2048 + c2) = v; const int b = row >> 8, key = row & 255;
                            const unsigned w0 = cvt_pk_bf16(v[0], v[1]), w1 = cvt_pk_bf16(v[2], v[3]); bf16_t* t = vt + ((size_t)(b * 2048 + c2)) * 256 + key;
                            t[0] = (bf16_t)(w0 & 0xffffu); t[256] = (bf16_t)(w0 >> 16); t[512] = (bf16_t)(w1 & 0xffffu); t[768] = (bf16_t)(w1 >> 16); } } }
    }
};
template <bool FIRST, bool WRITE_XB> struct EpiRes {
    static constexpr bool PERM = false, AFTER_DRAIN = false;
    const float* xp; const float* xs; float* xr; bf16_t* xb; float* ssq_out; float alpha;
    __device__ __forceinline__ void operator()(const f32x4 (&acc)[2][2][4][2], const Unit& u, int wr, int wc, int fr, int fq) const {
        const int row0 = u.pm * BM + wr * 64 + fr;
#pragma unroll
        for (int ai = 0; ai < 2; ++ai)
#pragma unroll
            for (int m = 0; m < 4; ++m) { const int row = row0 + ai * HALF + m * 16; float q = 0.f;
                const float* base = FIRST ? (row < 8192 ? xp + (size_t)row * 2048 : xs + (size_t)(row - 8192) * 2048) : xr + (size_t)row * 2048;
#pragma unroll
                for (int bj = 0; bj < 2; ++bj)
#pragma unroll
                    for (int n = 0; n < 2; ++n) { const int col = u.pn * BM + bj * HALF + wc * 32 + n * 16 + 4 * fq; const f32x4 b = *(const f32x4*)(base + col); const f32x4 o = b + acc[ai][bj][m][n] * alpha;
                        *(f32x4*)(xr + (size_t)row * 2048 + col) = o; q += (o[0] * o[0] + o[1] * o[1]) + (o[2] * o[2] + o[3] * o[3]);
                        if (WRITE_XB) { u32x2 w; w.x = cvt_pk_bf16(o[0], o[1]); w.y = cvt_pk_bf16(o[2], o[3]); *(u32x2*)(xb + (size_t)row * 2048 + col) = w; } }
                q += __shfl_xor(q, 16); q += __shfl_xor(q, 32);
                if (fq == 0) ssq_out[(size_t)row * 32 + u.pn * 4 + wc] = q; }
    }
};
struct EpiProj {
    static constexpr bool PERM = false, AFTER_DRAIN = false;
    float* C; int ldc; const float* ssq;
    __device__ __forceinline__ void operator()(const f32x4 (&acc)[2][2][4][2], const Unit& u, int wr, int wc, int fr, int fq) const {
        const int row0 = u.pm * BM + wr * 64 + fr;
#pragma unroll
        for (int ai = 0; ai < 2; ++ai)
#pragma unroll
            for (int m = 0; m < 4; ++m) { const int row = row0 + ai * HALF + m * 16; const float rs = row_rstd(ssq, row, fq);
#pragma unroll
                for (int bj = 0; bj < 2; ++bj)
#pragma unroll
                    for (int n = 0; n < 2; ++n) { const int col = u.pn * BM + bj * HALF + wc * 32 + n * 16 + 4 * fq; *(f32x4*)(C + (size_t)row * ldc + col) = acc[ai][bj][m][n] * rs; } }
    }
};
struct EpiQ {
    static constexpr bool PERM = true, AFTER_DRAIN = false;
    bf16_t* O; const float* ssq; float scale;
    __device__ __forceinline__ void operator()(const f32x4 (&acc)[2][2][4][2], const Unit& u, int wr, int wc, int fr, int fq) const {
        const int row0 = u.pm * BM + wr * 64 + fr, col0 = u.pn * BM + wc * 32 + 8 * fq;
#pragma unroll
        for (int ai = 0; ai < 2; ++ai)
#pragma unroll
            for (int m = 0; m < 4; ++m) { const int row = row0 + ai * HALF + m * 16; const float rs = row_rstd(ssq, row, fq) * scale;
#pragma unroll
                for (int bj = 0; bj < 2; ++bj) { const f32x4 v0 = acc[ai][bj][m][0] * rs, v1 = acc[ai][bj][m][1] * rs;
                    u32x4 w; w.x = cvt_pk_bf16(v0[0], v0[1]); w.y = cvt_pk_bf16(v0[2], v0[3]); w.z = cvt_pk_bf16(v1[0], v1[1]); w.w = cvt_pk_bf16(v1[2], v1[3]);
                    *(u32x4*)(O + (size_t)row * 2048 + col0 + bj * HALF) = w; } }
    }
};

template <class Epi, class Sched, bool ALIGN_EPI = false, bool SP2 = false>
__device__ __forceinline__ void gemm_phase(PG8_LAS unsigned char* lds, const Gemm g, const Sched& S, const Epi& E) {
    const int tid = threadIdx.x, wid = __builtin_amdgcn_readfirstlane(tid >> 6), lane = tid & 63, wr = wid >> 2, wc = wid & 3, fr = lane & 15, fq = lane >> 4;
    const int K = g.K, nt = K / BK;
    unsigned voffA[2], voffB[2];
#pragma unroll
    for (int i = 0; i < 2; ++i) { int R, C; stage_rc(tid * 16 + i * 8192, R, C); const int Rb = Epi::PERM ? ((R & ~31) + perm32(R & 31)) : R;
        voffA[i] = (unsigned)(R * K + C) * 2u; voffB[i] = (unsigned)(Rb * K + C) * 2u; }
    const size_t kstep = (size_t)(BK * 2);
    const size_t hstep = (size_t)HALF * K * 2;
    const size_t tstep = 2 * hstep;
    const unsigned ldsw = (unsigned)wid * 1024u;
    const int aoff = lds_byte(wr * 64 + fr, fq * 8), boff = lds_byte(wc * 32 + fr, fq * 8);
#define PG8_SA(b, h) (((b) * 2 + (h)) * HTB)
#define PG8_SB(b, h) ((4 + (b) * 2 + (h)) * HTB)
#define PG8_STAGE(bufoff, gbase, voff) do { _Pragma("unroll") for (int _i = 0; _i < 2; ++_i) \
        __builtin_amdgcn_global_load_lds((const unsigned*)((const char*)(gbase) + (voff)[_i]), (PG8_LAS unsigned*)(lds + (bufoff) + ldsw + _i * 8192), 16, 0, 0); } while (0)
#define PG8_LDA(dst, b, h) do { _Pragma("unroll") for (int m = 0; m < 4; ++m) _Pragma("unroll") for (int k = 0; k < 2; ++k) dst[m][k] = *(const PG8_LAS bf16x8*)(lds + PG8_SA(b, h) + aoff + m * 2048 + k * 1024); } while (0)
#define PG8_LDB(dst, b, h) do { _Pragma("unroll") for (int n = 0; n < 2; ++n) _Pragma("unroll") for (int k = 0; k < 2; ++k) dst[n][k] = *(const PG8_LAS bf16x8*)(lds + PG8_SB(b, h) + boff + n * 2048 + k * 1024); } while (0)
#define PG8_MMA(ai, bj, At, Bt) do { __builtin_amdgcn_s_setprio(1); _Pragma("unroll") for (int m = 0; m < 4; ++m) _Pragma("unroll") for (int n = 0; n < 2; ++n) _Pragma("unroll") for (int k = 0; k < 2; ++k) \
        acc[ai][bj][m][n] = __builtin_amdgcn_mfma_f32_16x16x32_bf16(Bt[n][k], At[m][k], acc[ai][bj][m][n], 0, 0, 0); __builtin_amdgcn_s_setprio(0); } while (0)
#define PG8_WAIT_V(n) asm volatile("s_waitcnt vmcnt(" #n ")" ::: "memory")
#define PG8_WAIT_L(n) asm volatile("s_waitcnt lgkmcnt(" #n ")" ::: "memory")
#define PG8_BAR __builtin_amdgcn_s_barrier()
#define PG8_SCHED __builtin_amdgcn_sched_barrier(0)
    Unit cur, nxt; int ui = 0;
    if (!S.next(0, cur)) return;
    f32x4 acc[2][2][4][2];
#pragma unroll
    for (int a = 0; a < 2; ++a)
#pragma unroll
        for (int b = 0; b < 2; ++b)
#pragma unroll
            for (int m = 0; m < 4; ++m)
#pragma unroll
                for (int n = 0; n < 2; ++n) acc[a][b][m][n] = (f32x4){0.f, 0.f, 0.f, 0.f};
    bf16x8 At[4][2], B0[2][2], B1[2][2];
    const char* cA = (const char*)g.A + (size_t)cur.pm * tstep; const char* cB = (const char*)g.Bt + (size_t)cur.pn * tstep;
    S.a_ready(cur);
    if constexpr (SP2) {
        PG8_STAGE(PG8_SB(0, 0), cB, voffB); PG8_STAGE(PG8_SB(0, 1), cB + hstep, voffB); PG8_STAGE(PG8_SA(0, 0), cA, voffA); PG8_STAGE(PG8_SA(0, 1), cA + hstep, voffA);
        if (wr == 1) PG8_BAR;
        PG8_WAIT_V(2); PG8_BAR;
        PG8_STAGE(PG8_SB(1, 0), cB + kstep, voffB); PG8_STAGE(PG8_SA(1, 0), cA + kstep, voffA); PG8_STAGE(PG8_SB(1, 1), cB + hstep + kstep, voffB);
        PG8_WAIT_V(6); PG8_BAR;
    } else {
        PG8_STAGE(PG8_SB(0, 0), cB, voffB); PG8_STAGE(PG8_SA(0, 0), cA, voffA); PG8_STAGE(PG8_SB(0, 1), cB + hstep, voffB); PG8_STAGE(PG8_SA(0, 1), cA + hstep, voffA);
        if (wr == 1) PG8_BAR;
        PG8_WAIT_V(4); PG8_BAR;
        PG8_STAGE(PG8_SB(1, 0), cB + kstep, voffB); PG8_STAGE(PG8_SA(1, 0), cA + kstep, voffA); PG8_STAGE(PG8_SB(1, 1), cB + hstep + kstep, voffB);
        PG8_WAIT_V(6); PG8_BAR;
    }
    for (;;) {
        const bool has_next = S.next(ui + 1, nxt);
        const char* nA = has_next ? (const char*)g.A + (size_t)nxt.pm * tstep : cA; const char* nB = has_next ? (const char*)g.Bt + (size_t)nxt.pn * tstep : cB;
        for (int t = 0; t < nt; t += 2) {
            const bool last = (t == nt - 2);
            const char* a1 = cA + (size_t)(t + 1) * kstep;
            const char* a2 = last ? nA : cA + (size_t)(t + 2) * kstep; const char* b2 = last ? nB : cB + (size_t)(t + 2) * kstep;
            const char* a3 = a2 + kstep; const char* b3 = b2 + kstep;
            if (last && has_next) S.a_ready(nxt);
            if constexpr (SP2) {
            PG8_LDB(B0, 0, 0); PG8_LDB(B1, 0, 1); PG8_SCHED; PG8_LDA(At, 0, 0); PG8_STAGE(PG8_SA(1, 1), a1 + hstep, voffA);
            PG8_WAIT_V(8); PG8_WAIT_L(0); PG8_BAR; PG8_MMA(0, 0, At, B0); PG8_MMA(0, 1, At, B1); PG8_BAR; PG8_SCHED;
            PG8_LDA(At, 0, 1); PG8_STAGE(PG8_SB(0, 0), b2, voffB); PG8_STAGE(PG8_SB(0, 1), b2 + hstep, voffB); PG8_STAGE(PG8_SA(0, 0), a2, voffA);
            PG8_WAIT_V(8); PG8_WAIT_L(0); PG8_BAR; PG8_MMA(1, 0, At, B0); PG8_MMA(1, 1, At, B1); PG8_BAR; PG8_SCHED;
            PG8_LDB(B0, 1, 0); PG8_LDB(B1, 1, 1); PG8_SCHED; PG8_LDA(At, 1, 0); PG8_STAGE(PG8_SA(0, 1), a2 + hstep, voffA);
            PG8_WAIT_V(8); PG8_WAIT_L(0); PG8_BAR; PG8_MMA(0, 0, At, B0); PG8_MMA(0, 1, At, B1); PG8_BAR; PG8_SCHED;
            PG8_LDA(At, 1, 1); PG8_STAGE(PG8_SB(1, 0), b3, voffB); PG8_STAGE(PG8_SB(1, 1), b3 + hstep, voffB); PG8_STAGE(PG8_SA(1, 0), a3, voffA);
            PG8_WAIT_V(8); PG8_WAIT_L(0); PG8_BAR; PG8_MMA(1, 0, At, B0); PG8_MMA(1, 1, At, B1); PG8_BAR; PG8_SCHED;
            } else {
            PG8_LDB(B0, 0, 0); PG8_SCHED; PG8_LDA(At, 0, 0); PG8_STAGE(PG8_SA(1, 1), a1 + hstep, voffA);
            PG8_WAIT_L(8); PG8_BAR; PG8_WAIT_L(0); PG8_MMA(0, 0, At, B0); PG8_BAR; PG8_SCHED;
            PG8_LDB(B1, 0, 1); PG8_STAGE(PG8_SB(0, 0), b2, voffB);
            PG8_BAR; PG8_WAIT_L(0); PG8_MMA(0, 1, At, B1); PG8_BAR;
            PG8_LDA(At, 0, 1); PG8_STAGE(PG8_SA(0, 0), a2, voffA);
            PG8_BAR; PG8_WAIT_L(0); PG8_MMA(1, 0, At, B0); PG8_BAR; PG8_SCHED;
            PG8_STAGE(PG8_SB(0, 1), b2 + hstep, voffB);
            PG8_WAIT_V(6); PG8_BAR; PG8_MMA(1, 1, At, B1); PG8_BAR;
            PG8_LDB(B0, 1, 0); PG8_SCHED; PG8_LDA(At, 1, 0); PG8_STAGE(PG8_SA(0, 1), a2 + hstep, voffA);
            PG8_WAIT_L(8); PG8_BAR; PG8_WAIT_L(0); PG8_MMA(0, 0, At, B0); PG8_BAR; PG8_SCHED;
            PG8_LDB(B1, 1, 1); PG8_STAGE(PG8_SB(1, 0), b3, voffB);
            PG8_BAR; PG8_WAIT_L(0); PG8_MMA(0, 1, At, B1); PG8_BAR;
            PG8_LDA(At, 1, 1); PG8_STAGE(PG8_SA(1, 0), a3, voffA);
            PG8_BAR; PG8_WAIT_L(0); PG8_MMA(1, 0, At, B0); PG8_BAR; PG8_SCHED;
            PG8_STAGE(PG8_SB(1, 1), b3 + hstep, voffB);
            PG8_WAIT_V(6); PG8_BAR; PG8_MMA(1, 1, At, B1); PG8_BAR;
            }
        }
        if constexpr (ALIGN_EPI) { if (wr == 0) PG8_BAR; }
        if constexpr (!Epi::AFTER_DRAIN) { E(acc, cur, wr, wc, fr, fq); S.done(cur); }
        if (!has_next) break;
#pragma unroll
        for (int a = 0; a < 2; ++a)
#pragma unroll
            for (int b = 0; b < 2; ++b)
#pragma unroll
                for (int m = 0; m < 4; ++m)
#pragma unroll
                    for (int n = 0; n < 2; ++n) acc[a][b][m][n] = (f32x4){0.f, 0.f, 0.f, 0.f};
        cur = nxt; cA = nA; cB = nB; ++ui;
        if constexpr (ALIGN_EPI) { if (wr == 1) PG8_BAR; }
    }
    PG8_WAIT_V(0);
    if constexpr (!ALIGN_EPI) { if (wr == 0) PG8_BAR; }
    PG8_BAR;
    if constexpr (Epi::AFTER_DRAIN) { E.fused(acc, cur, wr, wc, fr, fq, lds, wid, lane); S.done(cur); }
#undef PG8_SA
#undef PG8_SB
#undef PG8_STAGE
#undef PG8_LDA
#undef PG8_LDB
#undef PG8_MMA
#undef PG8_WAIT_V
#undef PG8_WAIT_L
#undef PG8_BAR
#undef PG8_SCHED
}
}
#ifndef PG8_SP2
#define PG8_SP2 true
#endif
#ifndef PG8_ALIGN
#define PG8_ALIGN true
#endif
constexpr int RING_OFF = 0, RING_BYTES = 131072;
constexpr int LDSCTL_OFF = RING_BYTES, MISC_OFF = LDSCTL_OFF + 320;
constexpr int LDS_BYTES = 147456;
static_assert(MISC_OFF + 128 <= LDS_BYTES, "LDS map");

#define GAS __attribute__((address_space(1)))
#define LAS __attribute__((address_space(3)))
typedef unsigned short bf16;
typedef unsigned v4u __attribute__((ext_vector_type(4)));
typedef unsigned v2u __attribute__((ext_vector_type(2)));
typedef float f32x4 __attribute__((ext_vector_type(4)));
typedef float f32x2 __attribute__((ext_vector_type(2)));
typedef short bf16x8 __attribute__((ext_vector_type(8)));
typedef short bf16x4 __attribute__((ext_vector_type(4)));
typedef GAS unsigned gu32;
#define RLX_AGENT __ATOMIC_RELAXED, __HIP_MEMORY_SCOPE_AGENT
#define LDS_WAIT() asm volatile("s_waitcnt lgkmcnt(0)" ::: "memory")
#define VM_WAIT() asm volatile("s_waitcnt vmcnt(0)" ::: "memory")
__device__ __forceinline__ unsigned f2bf(float f) { unsigned u = __builtin_bit_cast(unsigned, f); return (u + 0x7fffu + ((u >> 16) & 1u)) >> 16; }
__device__ __forceinline__ unsigned pk2(float lo, float hi) { return f2bf(lo) | (f2bf(hi) << 16); }
__device__ __forceinline__ float bf2f(unsigned b) { return __builtin_bit_cast(float, b << 16); }
__device__ __forceinline__ float wave_sum(float v) {
#pragma unroll
    for (int o = 1; o < 64; o <<= 1) v += __shfl_xor(v, o);
    return v;
}
__device__ __forceinline__ float sigmoid_f(float x) { return __builtin_amdgcn_rcpf(1.0f + __expf(-x)); }
__device__ __forceinline__ float siluf_(float x) { return x * sigmoid_f(x); }
__device__ __forceinline__ float softplus_f(float x) { return x > 20.f ? x : log1pf(__expf(x)); }
__device__ __forceinline__ float gelu_tanh_f(float x) { const float t = 0.7978845608028654f * (x + 0.044715f * x * x * x); return x * sigmoid_f(2.0f * t); }
#define MFMA16(a, b, c) __builtin_amdgcn_mfma_f32_16x16x32_bf16((a), (b), (c), 0, 0, 0)

#define XB_TMO      128
#define XB_XCNT(j)  (256  + 64 * (j))
#define XB_XSUB(j)  (1280 + 64 * (j))
#define XB_XGEN(j)  (2304 + 64 * (j))
#define XB_TOP      3328
#define XB_TOPGEN   3392
#define XCD_BAR_WORDS 3456
#define XB_SPIN_CAP (1u << 18)

__device__ __forceinline__ unsigned xb_ld(unsigned* p)              { return __hip_atomic_load(p, __ATOMIC_RELAXED, __HIP_MEMORY_SCOPE_AGENT); }
__device__ __forceinline__ unsigned xb_add(unsigned* p, unsigned v) { return __hip_atomic_fetch_add(p, v, __ATOMIC_RELAXED, __HIP_MEMORY_SCOPE_AGENT); }
__device__ __forceinline__ unsigned xb_xcc_id() { return (unsigned)__builtin_amdgcn_s_getreg((3 << 11) | 20) & 0xFu; }
#define XB_SPIN(cond, bar) do { unsigned _sp = 0; while (cond) { __builtin_amdgcn_s_sleep(1); \
    if ((++_sp & 255u) == 0u) { if (xb_ld(&(bar)[XB_TMO])) break; if (_sp > XB_SPIN_CAP) { atomicAdd(&(bar)[XB_TMO], 1u); break; } } } } while (0)

struct XcdBarrier {
    unsigned* bar; unsigned x;
    volatile LAS unsigned* st;
};

__device__ __forceinline__ XcdBarrier xcd_barrier_post(unsigned* bar, volatile LAS unsigned* st) {
    XcdBarrier b; b.bar = bar; b.x = xb_xcc_id(); b.st = st;
    if (threadIdx.x == 0) (void)xb_add(&bar[XB_XCNT(b.x)], 1u);
    return b;
}
__device__ __forceinline__ void xcd_barrier_complete(unsigned* bar, unsigned x, unsigned& nloc, unsigned& nx) {
    const unsigned G = gridDim.x * gridDim.y * gridDim.z;
    unsigned sum, cnt, mine, sp = 0u;
    for (;;) {
        sum = 0u; cnt = 0u; mine = 0u;
#pragma unroll
        for (unsigned j = 0; j < 16; ++j) { const unsigned c = xb_ld(&bar[XB_XCNT(j)]); sum += c; cnt += (c > 0u) ? 1u : 0u; mine = (j == x) ? c : mine; }
        if (sum == G) break;
        __builtin_amdgcn_s_sleep(1);
        if ((++sp & 255u) == 0u) { if (xb_ld(&bar[XB_TMO])) break; if (sp > XB_SPIN_CAP) { atomicAdd(&bar[XB_TMO], 1u); break; } }
    }
    nloc = mine > 0u ? mine : 1u; nx = cnt > 0u ? cnt : 1u;
}

__device__ __forceinline__ void xcd_barrier(const XcdBarrier& b) {
    asm volatile("s_waitcnt vmcnt(0)" ::: "memory");
    __syncthreads();
    if (threadIdx.x == 0) {
        unsigned* bar = b.bar;
        __builtin_amdgcn_s_waitcnt(0);
        unsigned nloc = b.st[0], nx = b.st[1];
        if (nloc == 0u) { xcd_barrier_complete(bar, b.x, nloc, nx); b.st[0] = nloc; b.st[1] = nx; }
        const unsigned old = xb_add(&bar[XB_XSUB(b.x)], 1u);
        const unsigned gen = old / nloc;
        if (old + 1u == (gen + 1u) * nloc) {
            __builtin_amdgcn_fence(__ATOMIC_RELEASE, "agent");
            asm volatile("s_waitcnt vmcnt(0)" ::: "memory");
            const unsigned og = xb_add(&bar[XB_TOP], 1u);
            const unsigned tg = og / nx;
            if (og + 1u == (tg + 1u) * nx) xb_add(&bar[XB_TOPGEN], 1u);
            else XB_SPIN(xb_ld(&bar[XB_TOPGEN]) == tg, bar);
            __builtin_amdgcn_fence(__ATOMIC_ACQUIRE, "agent");
            xb_add(&bar[XB_XGEN(b.x)], 1u);
            asm volatile("s_waitcnt vmcnt(0)" ::: "memory");
        } else {
            XB_SPIN(xb_ld(&bar[XB_XGEN(b.x)]) == gen, bar);
            __builtin_amdgcn_fence(__ATOMIC_ACQUIRE, "agent");
            asm volatile("s_waitcnt vmcnt(0)" ::: "memory");
        }
    }
    __syncthreads();
}
struct Args { const float* in[41]; float* out; unsigned char* ws; int ph_lo, ph_hi; };
struct Frame {
    LAS unsigned char* lds;
    volatile LAS unsigned* MISC;
    gu32* ctl;
    int tid, lane, wave;
    int vcu, G;
    float* out;
    unsigned char* ws;
};
#define WSP(T, off) ((T*)(F.ws + (off)))
#define INP(i) (A.in[(i)])

__device__ __forceinline__ void p0_transpose_item(const float* W, int N, bf16* WT, int ldt, int kdst, int dst_row0, const float* gain, LAS float* scr, int k0, int n0, int lane) {
#pragma unroll 8
    for (int i = 0; i < 32; ++i) { const int kk = 2 * i + (lane >> 5); const float g = gain ? gain[k0 + kk] : 1.0f; scr[kk * 33 + (lane & 31)] = W[(size_t)(k0 + kk) * N + n0 + (lane & 31)] * g; }
    LDS_WAIT(); asm volatile("" ::: "memory");
    const int c = lane & 7;
#pragma unroll
    for (int j = 0; j < 4; ++j) { const int n = (lane >> 3) + 8 * j; const LAS float* s = scr + (8 * c) * 33 + n;
        v4u o; o.x = pk2(s[0 * 33], s[1 * 33]); o.y = pk2(s[2 * 33], s[3 * 33]); o.z = pk2(s[4 * 33], s[5 * 33]); o.w = pk2(s[6 * 33], s[7 * 33]);
        *(GAS v4u*)(WT + (size_t)(dst_row0 + n) * ldt + kdst + k0 + 8 * c) = o; }
    LDS_WAIT(); asm volatile("" ::: "memory");
}
__device__ __forceinline__ void p0_tr(const float* W, int K, int N, bf16* WT, int ldt, int kdst, int row_base, int mode  , const float* gain, LAS float* scr, int item, int lane) {
    const int nblk = N / 32, kb = item / nblk, nb = item % nblk, k0 = 64 * kb, n0 = 32 * nb; (void)K;
    const int dr = mode == 0 ? row_base + n0 : (n0 / 128) * 256 + (n0 % 128) + (mode == 2 ? 128 : 0);
    p0_transpose_item(W, N, WT, ldt, kdst, dr, gain, scr, k0, n0, lane);
}
__device__ __forceinline__ void row_to_bf16_ssq(const float* xrow, bf16* orow, float* ssq32, int lane) {
    const GAS f32x4* xr = (const GAS f32x4*)xrow + lane; GAS v2u* o8 = (GAS v2u*)orow + lane; float s = 0.f;
#pragma unroll
    for (int j = 0; j < 8; ++j) { const f32x4 v = xr[64 * j]; s += (v.x * v.x + v.y * v.y) + (v.z * v.z + v.w * v.w); v2u w; w.x = pk2(v.x, v.y); w.y = pk2(v.z, v.w); o8[64 * j] = w; }
    s = wave_sum(s);
    if (lane < 32) ssq32[lane] = lane == 0 ? s : 0.f;
}
__device__ __forceinline__ void p0_prologue(Frame& F, const Args& A) {
    LAS float* scr = (LAS float*)(F.lds + RING_OFF + F.wave * 16384);
    const int gw = F.vcu * NWAVES + F.wave, NGW = F.G * NWAVES;
    constexpr int I_GU = (D / 64) * (FF / 32), I_DN = (FF / 64) * (D / 32), I_IN = (D / 64) * (DIN / 32), I_SQ = (D / 64) * (D / 32), I_L = 16 * 8;
    constexpr int NITEMS = 4 * I_GU + 2 * I_DN + I_IN + 6 * I_SQ + 2 * I_L;
    for (int it = gw; it < NITEMS; it += NGW) {
        int r = it;
        if (r < I_GU) { p0_tr(INP(I_F1WG), D, FF, WSP(bf16, WS_W1GU), D, 0, 0, 1, INP(I_F1G), scr, r, F.lane); continue; } r -= I_GU;
        if (r < I_GU) { p0_tr(INP(I_F1WU), D, FF, WSP(bf16, WS_W1GU), D, 0, 0, 2, INP(I_F1G), scr, r, F.lane); continue; } r -= I_GU;
        if (r < I_DN) { p0_tr(INP(I_F1WD), FF, D, WSP(bf16, WS_W1D), FF, 0, 0, 0, nullptr, scr, r, F.lane); continue; } r -= I_DN;
        if (r < I_IN) { p0_tr(INP(I_WIN), D, DIN, WSP(bf16, WS_WIN), D, 0, 0, 0, INP(I_MIXG), scr, r, F.lane); continue; } r -= I_IN;
        if (r < I_SQ) { p0_tr(INP(I_WOUT), D, D, WSP(bf16, WS_WOUT), DMIX, 0, 0, 0, INP(I_LOG), scr, r, F.lane); continue; } r -= I_SQ;
        if (r < I_SQ) { p0_tr(INP(I_WOUT) + (size_t)D * D, D, D, WSP(bf16, WS_WOUT), DMIX, D, 0, 0, INP(I_SOG), scr, r, F.lane); continue; } r -= I_SQ;
        if (r < I_SQ) { p0_tr(INP(I_WQ), D, D, WSP(bf16, WS_WQ), D, 0, 0, 0, INP(I_XAG), scr, r, F.lane); continue; } r -= I_SQ;
        if (r < I_SQ) { p0_tr(INP(I_WK), D, D, WSP(bf16, WS_WKV), D, 0, 0, 0, INP(I_MEMG), scr, r, F.lane); continue; } r -= I_SQ;
        if (r < I_SQ) { p0_tr(INP(I_WV), D, D, WSP(bf16, WS_WKV), D, 0, D, 0, INP(I_MEMG), scr, r, F.lane); continue; } r -= I_SQ;
        if (r < I_SQ) { p0_tr(INP(I_WO), D, D, WSP(bf16, WS_WO), D, 0, 0, 0, nullptr, scr, r, F.lane); continue; } r -= I_SQ;
        if (r < I_GU) { p0_tr(INP(I_F2WG), D, FF, WSP(bf16, WS_W2GU), D, 0, 0, 1, INP(I_F2G), scr, r, F.lane); continue; } r -= I_GU;
        if (r < I_GU) { p0_tr(INP(I_F2WU), D, FF, WSP(bf16, WS_W2GU), D, 0, 0, 2, INP(I_F2G), scr, r, F.lane); continue; } r -= I_GU;
        if (r < I_DN) { p0_tr(INP(I_F2WD), FF, D, WSP(bf16, WS_W2D), FF, 0, 0, 0, nullptr, scr, r, F.lane); continue; } r -= I_DN;
        if (r < I_L) { const int h = r >> 3; p0_tr(INP(I_LWA) + (size_t)h * 16384, 128, 128, WSP(bf16, WS_WL), 128, 0, h * 256, 0, nullptr, scr, r & 7, F.lane); continue; } r -= I_L;
        { const int h = r >> 3; p0_tr(INP(I_LWX) + (size_t)h * 16384, 128, 128, WSP(bf16, WS_WL), 128, 0, h * 256 + 128, 0, nullptr, scr, r & 7, F.lane); }
    }
    for (int m = gw; m < M; m += NGW) { const float* src = m < MP ? INP(I_XP) + (size_t)m * D : INP(I_XS) + (size_t)(m - MP) * D;
        row_to_bf16_ssq(src, WSP(bf16, WS_XBA) + (size_t)m * D, WSP(float, WS_SSQ) + (size_t)m * NSSQ, F.lane); }
    for (int m = gw; m < MMEM; m += NGW) row_to_bf16_ssq(INP(I_MEMP) + (size_t)m * D, WSP(bf16, WS_MEMB) + (size_t)m * D, WSP(float, WS_SSQM) + (size_t)m * NSSQ, F.lane);
    { GAS v4u* z = (GAS v4u*)(WSP(bf16, WS_WIN) + (size_t)DIN * D); const int nz = (DINP - DIN) * D * 2 / 16;
      for (int i = gw * 64 + F.lane; i < nz; i += NGW * 64) z[i] = (v4u){0u, 0u, 0u, 0u}; }
}

__device__ __forceinline__ void p5_normalize(Frame& F, const Args& A) {
    const int gw = F.vcu * NWAVES + F.wave, NGW = F.G * NWAVES, lane = F.lane;
    bf16* V = WSP(bf16, WS_V); const float* SQ = WSP(float, WS_SQV);
    for (int m = gw; m < M; m += NGW) {
        const float* sq = SQ + (size_t)m * NSQV;
        const float pl = lane < 16 ? sq[lane] : 0.f, p0 = sq[16 + lane], p1 = sq[80 + lane];
        const float rl = __builtin_amdgcn_rsqf(wave_sum(pl) * (1.0f / 2048.0f) + EPS), r0 = __builtin_amdgcn_rsqf(wave_sum(p0) * (1.0f / 1024.0f) + EPS), r1 = __builtin_amdgcn_rsqf(wave_sum(p1) * (1.0f / 1024.0f) + EPS);
        GAS v4u* row = (GAS v4u*)(V + (size_t)m * DMIX) + lane;
#pragma unroll
        for (int i = 0; i < 8; ++i) { const float rs = i < 4 ? rl : (i < 6 ? r0 : r1); v4u w = row[64 * i];
            w.x = pk2(bf2f(w.x & 0xffffu) * rs, bf2f(w.x >> 16) * rs); w.y = pk2(bf2f(w.y & 0xffffu) * rs, bf2f(w.y >> 16) * rs);
            w.z = pk2(bf2f(w.z & 0xffffu) * rs, bf2f(w.z >> 16) * rs); w.w = pk2(bf2f(w.w & 0xffffu) * rs, bf2f(w.w >> 16) * rs); row[64 * i] = w; }
    }
    const float* P = WSP(float, WS_PROJ);
    for (int it = gw; it < (NBP + NBS) * 3; it += NGW) { const int sq = it / 3, k = it % 3;
        const int row = sq < NBP ? sq * TP + TP - 3 + k : MP + (sq - NBP) * TS + TS - 3 + k;
        float* lc = sq < NBP ? F.out + O_PLC + (size_t)(sq * 3 + k) * D : F.out + O_SLC + (size_t)((sq - NBP) * 3 + k) * D;
        float* sc = sq < NBP ? F.out + O_PSC + (size_t)(sq * 3 + k) * XBC : F.out + O_SSC + (size_t)((sq - NBP) * 3 + k) * XBC;
        const float* src = P + (size_t)row * DINP;
        for (int c = lane * 4; c < D; c += 256) *(GAS f32x4*)(lc + c) = *(const GAS f32x4*)(src + C_XL + c);
        for (int c = lane * 4; c < XBC; c += 256) *(GAS f32x4*)(sc + c) = *(const GAS f32x4*)(src + C_XBC + c);
    }
}
__device__ __forceinline__ void p12_final(Frame& F, const Args& A) {
    const int gw = F.vcu * NWAVES + F.wave, NGW = F.G * NWAVES, lane = F.lane;
    const float* XR = WSP(float, WS_XR); const float* SSQ = WSP(float, WS_SSQ) + (size_t)4 * M * NSSQ; const float* g = INP(I_FING);
    for (int m = gw; m < M; m += NGW) {
        const float p = lane < 32 ? SSQ[(size_t)m * NSSQ + lane] : 0.f; const float rs = __builtin_amdgcn_rsqf(wave_sum(p) * (1.0f / 2048.0f) + EPS);
        const GAS f32x4* xr = (const GAS f32x4*)(XR + (size_t)m * D) + lane; const GAS f32x4* gg = (const GAS f32x4*)g + lane; GAS f32x4* o = (GAS f32x4*)(F.out + O_Y + (size_t)m * D) + lane;
#pragma unroll
        for (int j = 0; j < 8; ++j) o[64 * j] = xr[64 * j] * rs * gg[64 * j];
    }
}

__device__ __forceinline__ bf16x8 pack8(const f32x4 a, const f32x4 b) { v4u w; w.x = pg8::cvt_pk_bf16(a[0], a[1]); w.y = pg8::cvt_pk_bf16(a[2], a[3]); w.z = pg8::cvt_pk_bf16(b[0], b[1]); w.w = pg8::cvt_pk_bf16(b[2], b[3]); return __builtin_bit_cast(bf16x8, w); }
template <bool SAMPLE>
__device__ __forceinline__ void attn_item(Frame& F, const Args& A, int b, int h, int qt) {
    const int lane = F.lane, c16 = lane & 15, g = lane >> 4;
    const int R = SAMPLE ? MP + b * TS + (c16 & 7) : b * TP + qt * 16 + c16; const bool qvalid = SAMPLE ? (c16 < 8) : true;
    const bf16* Q = WSP(bf16, WS_Q) + (size_t)R * D + h * 512;
    bf16x8 qf[16];
#pragma unroll
    for (int ks = 0; ks < 16; ++ks) qf[ks] = *(const GAS bf16x8*)(Q + ks * 32 + 8 * g);
    f32x4 s[16];
#pragma unroll
    for (int kt = 0; kt < 16; ++kt) { s[kt] = (f32x4){0.f, 0.f, 0.f, 0.f}; const int key = kt * 16 + c16;
        if (!SAMPLE) { const bf16* kp = WSP(bf16, WS_KM) + (size_t)(b * NMEM + key) * D + h * 512 + 8 * g;
#pragma unroll
            for (int ks = 0; ks < 16; ++ks) { const bf16x8 kf = *(const GAS bf16x8*)(kp + ks * 32); s[kt] = MFMA16(kf, qf[ks], s[kt]); } }
        else { const float* kp = INP(I_CK) + (size_t)(b * NMEM + key) * D + h * 512 + 8 * g;
#pragma unroll
            for (int ks = 0; ks < 16; ++ks) { const f32x4 x0 = *(const GAS f32x4*)(kp + ks * 32), x1 = *(const GAS f32x4*)(kp + ks * 32 + 4); s[kt] = MFMA16(pack8(x0, x1), qf[ks], s[kt]); } }
    }
    float mx = -3.0e38f;
#pragma unroll
    for (int kt = 0; kt < 16; ++kt) mx = fmaxf(mx, fmaxf(fmaxf(s[kt][0], s[kt][1]), fmaxf(s[kt][2], s[kt][3])));
    mx = fmaxf(mx, __shfl_xor(mx, 16)); mx = fmaxf(mx, __shfl_xor(mx, 32));
    float sum = 0.f;
#pragma unroll
    for (int kt = 0; kt < 16; ++kt) {
#pragma unroll
        for (int j = 0; j < 4; ++j) { const float e = __expf(s[kt][j] - mx); s[kt][j] = e; sum += e; } }
    sum += __shfl_xor(sum, 16); sum += __shfl_xor(sum, 32);
    const float inv = 1.0f / sum;
    bf16x8 pf[8];
#pragma unroll
    for (int kk = 0; kk < 8; ++kk) pf[kk] = pack8(s[2 * kk], s[2 * kk + 1]);
    bf16* O = WSP(bf16, WS_O) + (size_t)R * D + h * 512 + 4 * g;
    for (int dt = 0; dt < 32; ++dt) { const int d = dt * 16 + c16; f32x4 o = (f32x4){0.f, 0.f, 0.f, 0.f};
        if (!SAMPLE) { const bf16* vp = WSP(bf16, WS_VT) + (size_t)(b * D + h * 512 + d) * NMEM + 4 * g;
#pragma unroll
            for (int kk = 0; kk < 8; ++kk) { const v2u lo = *(const GAS v2u*)(vp + kk * 32), hi = *(const GAS v2u*)(vp + kk * 32 + 16); v4u w; w.x = lo.x; w.y = lo.y; w.z = hi.x; w.w = hi.y;
                o = MFMA16(__builtin_bit_cast(bf16x8, w), pf[kk], o); } }
        else { const float* vp = INP(I_CV) + (size_t)(b * NMEM + 4 * g) * D + h * 512 + d;
#pragma unroll
            for (int kk = 0; kk < 8; ++kk) { const float* v0 = vp + (size_t)(kk * 32) * D; f32x4 x0, x1;
                x0[0] = v0[0]; x0[1] = v0[D]; x0[2] = v0[2 * D]; x0[3] = v0[3 * D]; x1[0] = v0[16 * D]; x1[1] = v0[17 * D]; x1[2] = v0[18 * D]; x1[3] = v0[19 * D];
                o = MFMA16(pack8(x0, x1), pf[kk], o); } }
        o = o * inv;
        if (qvalid) { v2u w; w.x = pg8::cvt_pk_bf16(o[0], o[1]); w.y = pg8::cvt_pk_bf16(o[2], o[3]); *(GAS v2u*)(O + dt * 16) = w; }
    }
}
__device__ __forceinline__ void p8_attention(Frame& F, const Args& A) {
    const int f = F.wave * F.G + F.vcu, NF = F.G * NWAVES;
    for (int it = f; it < NBS * 4; it += NF) attn_item<true>(F, A, it >> 2, it & 3, 0);
    for (int it = f; it < NBP * 4 * (TP / 16); it += NF) attn_item<false>(F, A, it >> 9, (it >> 7) & 3, it & 127);
}

__device__ __forceinline__ float conv4(const float* cur, int t, const float* st, int sp, float w0, float w1, float w2, float w3, float bias) {
    const float x3 = cur[0];
    const float x2 = t >= 1 ? cur[-(ptrdiff_t)DINP] : (st ? st[2 * sp] : 0.f);
    const float x1 = t >= 2 ? cur[-(ptrdiff_t)2 * DINP] : (st ? st[(t + 1) * sp] : 0.f);
    const float x0 = t >= 3 ? cur[-(ptrdiff_t)3 * DINP] : (st ? st[t * sp] : 0.f);
    return bias + w0 * x0 + w1 * x1 + w2 * x2 + w3 * x3;
}
constexpr int LR_U32 = 0, LR_A32 = 32768, LR_UB = 65536, LR_UBP = 136;
template <bool SAMPLE>
__device__ __forceinline__ void lru_item(Frame& F, const Args& A, int sidx, int h) {
    LAS float* U32 = (LAS float*)(F.lds + LR_U32); LAS float* A32 = (LAS float*)(F.lds + LR_A32); LAS bf16* UB = (LAS bf16*)(F.lds + LR_UB);
    const int tid = F.tid, lane = F.lane, w = F.wave, c16 = lane & 15, g = lane >> 4;
    const float* P = WSP(float, WS_PROJ);
    const bf16* WL = WSP(bf16, WS_WL) + (size_t)h * 256 * 128;
    bf16x8 ba[4], bx[4];
#pragma unroll
    for (int ks = 0; ks < 4; ++ks) { ba[ks] = *(const GAS bf16x8*)(WL + (size_t)(16 * w + c16) * 128 + ks * 32 + 8 * g); bx[ks] = *(const GAS bf16x8*)(WL + (size_t)(128 + 16 * w + c16) * 128 + ks * 32 + 8 * g); }
    const int mcol = 16 * w + c16, mch = h * 128 + mcol;
    const float b_a = INP(I_LBA)[mch], b_x = INP(I_LBX)[mch], cl = -8.0f * softplus_f(-INP(I_LLAM)[mch]);
    const int cc = tid & 127, tq = tid >> 7, ch = h * 128 + cc;
    const float cw0 = INP(I_LCW)[ch], cw1 = INP(I_LCW)[D + ch], cw2 = INP(I_LCW)[2 * D + ch], cw3 = INP(I_LCW)[3 * D + ch], cb = INP(I_LCB)[ch];
    float hstate = 0.f;
    const int nchunk = SAMPLE ? 1 : TP / 64;
    for (int chunk = 0; chunk < nchunk; ++chunk) {
        const int R0 = SAMPLE ? MP + sidx * 64 : sidx * TP + chunk * 64;
#pragma unroll 4
        for (int i = 0; i < 16; ++i) { const int r = tq * 16 + i, R = R0 + r, t = SAMPLE ? (r & 7) : chunk * 64 + r;
            const float* st = SAMPLE ? INP(I_SLC) + (size_t)((sidx * 8 + (r >> 3)) * 3) * D + ch : nullptr;
            const float u = conv4(P + (size_t)R * DINP + C_XL + ch, t, st, D, cw0, cw1, cw2, cw3, cb);
            U32[r * 128 + cc] = u; UB[r * LR_UBP + cc] = (bf16)f2bf(u); }
        __syncthreads();
        f32x4 ra[4], rx[4];
#pragma unroll
        for (int m = 0; m < 4; ++m) { ra[m] = (f32x4){0.f, 0.f, 0.f, 0.f}; rx[m] = (f32x4){0.f, 0.f, 0.f, 0.f};
#pragma unroll
            for (int ks = 0; ks < 4; ++ks) { const bf16x8 af = *(const LAS bf16x8*)(UB + (16 * m + c16) * LR_UBP + ks * 32 + 8 * g); ra[m] = MFMA16(af, ba[ks], ra[m]); rx[m] = MFMA16(af, bx[ks], rx[m]); } }
#pragma unroll
        for (int m = 0; m < 4; ++m)
#pragma unroll
            for (int j = 0; j < 4; ++j) { const int r = 16 * m + 4 * g + j; const float rr = sigmoid_f(ra[m][j] + b_a), ii = sigmoid_f(rx[m][j] + b_x), la = cl * rr;
                const float a = __expf(la), mult = sqrtf(-expm1f(2.0f * la)); const float u = U32[r * 128 + mcol]; A32[r * 128 + mcol] = a; U32[r * 128 + mcol] = mult * ii * u; }
        __syncthreads();
        if (tid < 128) {
#pragma unroll 8
            for (int r = 0; r < 64; ++r) {
                if (SAMPLE && (r & 7) == 0) hstate = INP(I_SLH)[(size_t)(sidx * 8 + (r >> 3)) * D + h * 128 + tid];
                hstate = A32[r * 128 + tid] * hstate + U32[r * 128 + tid]; U32[r * 128 + tid] = hstate;
                if (SAMPLE && (r & 7) == 7) F.out[O_SLH + (size_t)(sidx * 8 + (r >> 3)) * D + h * 128 + tid] = hstate; }
            if (!SAMPLE && chunk == nchunk - 1) F.out[O_PLH + (size_t)sidx * D + h * 128 + tid] = hstate;
        }
        __syncthreads();
#pragma unroll 2
        for (int i = 0; i < 8; ++i) { const int r = 8 * w + i, R = R0 + r;
            const f32x2 gg = *(const GAS f32x2*)(P + (size_t)R * DINP + C_GL + h * 128 + 2 * lane); const float h0 = U32[r * 128 + 2 * lane], h1 = U32[r * 128 + 2 * lane + 1];
            const float v0 = h0 * gelu_tanh_f(gg.x), v1 = h1 * gelu_tanh_f(gg.y);
            *(GAS unsigned*)(WSP(bf16, WS_V) + (size_t)R * DMIX + h * 128 + 2 * lane) = pk2(v0, v1);
            const float q = wave_sum(v0 * v0 + v1 * v1); if (lane == 0) WSP(float, WS_SQV)[(size_t)R * NSQV + h] = q; }
        __syncthreads();
    }
}
constexpr int SD_CS = 0, SD_DT = 256, SD_WG = 512, SD_CM = 1024, SD_BM = 18432, SD_BT = 35840, SD_XT = 54272, SD_XS = 63488, SD_HB = 72704, SD_XF = 90112;
constexpr int SP136 = 136, SP72 = 72, SP68 = 68;
template <int L  >
__device__ __forceinline__ void ssd_item(Frame& F, const Args& A, int sq, int head) {
    constexpr bool SAMPLE = (L == 16); constexpr int LT = L / 16, KK = (L + 31) / 32, TV = SAMPLE ? TS : L;
    LAS float* CS = (LAS float*)(F.lds + SD_CS); LAS float* DT = (LAS float*)(F.lds + SD_DT); LAS float* WG = (LAS float*)(F.lds + SD_WG);
    LAS bf16* CM = (LAS bf16*)(F.lds + SD_CM); LAS bf16* BM = (LAS bf16*)(F.lds + SD_BM); LAS bf16* BT = (LAS bf16*)(F.lds + SD_BT);
    LAS bf16* XT = (LAS bf16*)(F.lds + SD_XT); LAS bf16* XS = (LAS bf16*)(F.lds + SD_XS); LAS bf16* HB = (LAS bf16*)(F.lds + SD_HB); LAS float* XF = (LAS float*)(F.lds + SD_XF);
    const int tid = F.tid, lane = F.lane, w = F.wave, c16 = lane & 15, g = lane >> 4, grp = head >> 4;
    const float* P = WSP(float, WS_PROJ);
    const float Aneg = -__expf(INP(I_SALOG)[head]), dtb = INP(I_SDTB)[head], Dh = INP(I_SD)[head];
    const int hpt = w & 3, hnt0 = 4 * (w >> 2);
    f32x4 Hacc[4];
    const size_t hbase = ((size_t)(sq * SSD_H + head) * SSD_P) * SSD_N;
#pragma unroll
    for (int i = 0; i < 4; ++i)
#pragma unroll
        for (int j = 0; j < 4; ++j) Hacc[i][j] = SAMPLE ? INP(I_SSH)[hbase + (size_t)(16 * hpt + 4 * g + j) * SSD_N + 16 * (hnt0 + i) + c16] : 0.f;
#pragma unroll
    for (int i = 0; i < 4; ++i)
#pragma unroll
        for (int j = 0; j < 4; ++j) HB[(16 * hpt + 4 * g + j) * SP136 + 16 * (hnt0 + i) + c16] = (bf16)f2bf(Hacc[i][j]);
    if (SAMPLE) {
        for (int e = tid; e < 64 * 16; e += 512) { const int p = e >> 4, c = 16 + (e & 15); XT[p * SP72 + c] = 0; XS[p * SP72 + c] = 0; }
        for (int e = tid; e < 128 * 16; e += 512) { const int n = e >> 4, c = 16 + (e & 15); BT[n * SP72 + c] = 0; }
    }
    const int nchunk = SAMPLE ? 1 : TP / 64;
    for (int chunk = 0; chunk < nchunk; ++chunk) {
        const int R0 = SAMPLE ? MP + sq * TS : sq * TP + chunk * 64;
        for (int e = tid; e < L * 320; e += 512) { const int r = e / 320, ch = e - r * 320;
            const int xc = ch < 64 ? head * 64 + ch : (ch < 192 ? 2048 + grp * 128 + (ch - 64) : 2304 + grp * 128 + (ch - 192));
            float val = 0.f;
            if (r < TV) { const int t = SAMPLE ? r : chunk * 64 + r; const float* st = SAMPLE ? INP(I_SSC) + (size_t)(sq * 3) * XBC + xc : nullptr;
                const float* cw = INP(I_SCW) + xc;
                val = siluf_(conv4(P + (size_t)(R0 + r) * DINP + C_XBC + xc, t, st, XBC, cw[0], cw[XBC], cw[2 * XBC], cw[3 * XBC], INP(I_SCB)[xc])); }
            const bf16 vb = (bf16)f2bf(val);
            if (ch < 64) { XF[r * SP68 + ch] = val; XT[ch * SP72 + r] = vb; }
            else if (ch < 192) { BM[r * SP136 + ch - 64] = vb; BT[(ch - 64) * SP72 + r] = vb; }
            else CM[r * SP136 + ch - 192] = vb; }
        if (w == 0) { const int r = lane; float dt = 0.f;
            if (r < TV) dt = softplus_f(P[(size_t)(R0 + r) * DINP + C_DT + head] + dtb);
            float cs = dt * Aneg;
#pragma unroll
            for (int o = 1; o < 64; o <<= 1) { const float up = __shfl_up(cs, o); if (lane >= o) cs += up; }
            const float csl = __shfl(cs, L - 1);
            if (r < L) { CS[r] = cs; DT[r] = dt; WG[r] = __expf(csl - cs) * dt; } }
        __syncthreads();
        for (int e = tid; e < 64 * L; e += 512) { const int p = e & 63, l = e >> 6; XS[p * SP72 + l] = (bf16)f2bf(XF[l * SP68 + p] * WG[l]); }
        __syncthreads();
        if (L == 64 || w < 4) {
            const int lt = (L == 64) ? (w & 3) : 0, l = 16 * lt + c16; constexpr int NPT = (L == 64) ? 2 : 1; const int pt0 = (L == 64) ? 2 * (w >> 2) : w;
            bf16x8 cf[4];
#pragma unroll
            for (int ks = 0; ks < 4; ++ks) cf[ks] = *(const LAS bf16x8*)(CM + l * SP136 + ks * 32 + 8 * g);
            const float cs_l = CS[l];
            f32x4 gt[2 * KK];
#pragma unroll
            for (int st = 0; st < 2 * KK; ++st) { gt[st] = (f32x4){0.f, 0.f, 0.f, 0.f};
                if (st < LT) {
#pragma unroll
                    for (int ks = 0; ks < 4; ++ks) { const bf16x8 af = *(const LAS bf16x8*)(BM + (16 * st + c16) * SP136 + ks * 32 + 8 * g); gt[st] = MFMA16(af, cf[ks], gt[st]); }
#pragma unroll
                    for (int j = 0; j < 4; ++j) { const int s = 16 * st + 4 * g + j; gt[st][j] = (s <= l) ? gt[st][j] * __expf(cs_l - CS[s]) * DT[s] : 0.f; } } }
            bf16x8 wf[KK];
#pragma unroll
            for (int kk = 0; kk < KK; ++kk) wf[kk] = pack8(gt[2 * kk], gt[2 * kk + 1]);
            const float ecl = __expf(cs_l); const bool valid = (l < TV); const int R = R0 + l;
#pragma unroll
            for (int pi = 0; pi < NPT; ++pi) { const int pt = pt0 + pi; f32x4 a1 = (f32x4){0.f, 0.f, 0.f, 0.f}, a2 = (f32x4){0.f, 0.f, 0.f, 0.f};
#pragma unroll
                for (int kk = 0; kk < KK; ++kk) { const v2u lo = *(const LAS v2u*)(XT + (16 * pt + c16) * SP72 + 32 * kk + 4 * g), hi = *(const LAS v2u*)(XT + (16 * pt + c16) * SP72 + 32 * kk + 16 + 4 * g);
                    v4u wv; wv.x = lo.x; wv.y = lo.y; wv.z = hi.x; wv.w = hi.y; a1 = MFMA16(__builtin_bit_cast(bf16x8, wv), wf[kk], a1); }
#pragma unroll
                for (int ks = 0; ks < 4; ++ks) { const bf16x8 af = *(const LAS bf16x8*)(HB + (16 * pt + c16) * SP136 + ks * 32 + 8 * g); a2 = MFMA16(af, cf[ks], a2); }
                const f32x4 x4 = *(const LAS f32x4*)(XF + l * SP68 + 16 * pt + 4 * g);
                f32x4 z4 = (f32x4){0.f, 0.f, 0.f, 0.f}; if (valid) z4 = *(const GAS f32x4*)(P + (size_t)R * DINP + C_Z + head * 64 + 16 * pt + 4 * g);
                float v[4], q = 0.f;
#pragma unroll
                for (int j = 0; j < 4; ++j) { const float y = a1[j] + ecl * a2[j] + Dh * x4[j]; v[j] = y * siluf_(z4[j]); q += v[j] * v[j]; }
                q += __shfl_xor(q, 16); q += __shfl_xor(q, 32);
                if (valid) { v2u o; o.x = pk2(v[0], v[1]); o.y = pk2(v[2], v[3]); *(GAS v2u*)(WSP(bf16, WS_V) + (size_t)R * DMIX + 2048 + head * 64 + 16 * pt + 4 * g) = o;
                    if (g == 0) WSP(float, WS_SQV)[(size_t)R * NSQV + 16 + head * 4 + pt] = q; } }
        }
        __syncthreads();
        { const float dec = __expf(CS[L - 1]);
#pragma unroll
          for (int i = 0; i < 4; ++i) Hacc[i] = Hacc[i] * dec;
#pragma unroll
          for (int kk = 0; kk < KK; ++kk) { const bf16x8 af = *(const LAS bf16x8*)(XS + (16 * hpt + c16) * SP72 + 32 * kk + 8 * g);
#pragma unroll
              for (int i = 0; i < 4; ++i) { const bf16x8 bfr = *(const LAS bf16x8*)(BT + (16 * (hnt0 + i) + c16) * SP72 + 32 * kk + 8 * g); Hacc[i] = MFMA16(af, bfr, Hacc[i]); } }
          if (chunk + 1 < nchunk) {
#pragma unroll
              for (int i = 0; i < 4; ++i)
#pragma unroll
                  for (int j = 0; j < 4; ++j) HB[(16 * hpt + 4 * g + j) * SP136 + 16 * (hnt0 + i) + c16] = (bf16)f2bf(Hacc[i][j]); } }
        __syncthreads();
    }
    float* ho = F.out + (SAMPLE ? O_SSH : O_PSH) + hbase;
#pragma unroll
    for (int i = 0; i < 4; ++i)
#pragma unroll
        for (int j = 0; j < 4; ++j) ho[(size_t)(16 * hpt + 4 * g + j) * SSD_N + 16 * (hnt0 + i) + c16] = Hacc[i][j];
}
__device__ __forceinline__ void p4_mixer(Frame& F, const Args& A) {
    const int bid = blockIdx.x;
    for (int it = bid; it < 64 + 128; it += F.G) {
        if (it < 64) lru_item<false>(F, A, it >> 4, it & 15); else ssd_item<64>(F, A, (it - 64) >> 5, (it - 64) & 31);
    }
    for (;;) {
        __syncthreads();
        if (F.tid == 0) F.MISC[0] = __hip_atomic_fetch_add(F.ctl + CW_QUEUE, 1u, RLX_AGENT);
        __syncthreads();
        const int it = (int)F.MISC[0];
        if (it >= 256 + NBS * SSD_H) break;
        if (it < 256) lru_item<true>(F, A, it >> 4, it & 15); else ssd_item<16>(F, A, (it - 256) >> 5, (it - 256) & 31);
    }
}

#ifndef MK_PER_PHASE
#define MK_PER_PHASE 0
#endif
constexpr int N_PHASES = 13;
template <class Epi> __device__ __forceinline__ void run_gemm(Frame& F, const bf16* Aop, const bf16* Bt, int Mr, int N, int K, const Epi& E, int c) {
    pg8::Gemm g{Aop, Bt, Mr, N, K}; pg8::StaticOrder S; S.init(Mr, N, F.G, c);
    pg8::gemm_phase<Epi, pg8::StaticOrder, PG8_ALIGN, PG8_SP2>(F.lds + RING_OFF, g, S, E);
}
__global__ void __launch_bounds__(NWAVES * 64, 2) hymba_fwd(Args args) {
    extern __shared__ __attribute__((aligned(16))) unsigned char lds[];
    const Args& A = args;
    Frame F;
    F.lds = (LAS unsigned char*)lds;
    F.MISC = (volatile LAS unsigned*)(F.lds + MISC_OFF);
    F.tid = threadIdx.x; F.lane = F.tid & 63; F.wave = __builtin_amdgcn_readfirstlane(F.tid >> 6);
    F.G = gridDim.x; { const int bx = blockIdx.x; F.vcu = (F.G % 8 == 0) ? (bx % 8) * (F.G / 8) + bx / 8 : bx; }
    F.ws = args.ws; F.out = args.out; F.ctl = (gu32*)(args.ws + WS_CTL);
    for (int u = F.tid; u < (LDS_BYTES - LDSCTL_OFF) / 4; u += NWAVES * 64) ((LAS unsigned*)(F.lds + LDSCTL_OFF))[u] = 0u;
    __syncthreads();
    XcdBarrier bar; bar.bar = (unsigned*)(F.ctl + CW_BAR); bar.x = 0; bar.st = nullptr;
    if (!MK_PER_PHASE) bar = xcd_barrier_post((unsigned*)(F.ctl + CW_BAR), F.MISC + 8);
#define GRID_BAR() do { if (!MK_PER_PHASE) xcd_barrier(bar); } while (0)
    const int lo = args.ph_lo, hi = args.ph_hi;
#define IN(k) (lo <= (k) && (k) < hi)
#define BOTH(k) (IN(k) && IN((k) + 1))
    const int bid = blockIdx.x;
    float* SSQ0 = WSP(float, WS_SSQ); float* SSQ1 = SSQ0 + (size_t)M * NSSQ; float* SSQ2 = SSQ1 + (size_t)M * NSSQ; float* SSQ3 = SSQ2 + (size_t)M * NSSQ; float* SSQ4 = SSQ3 + (size_t)M * NSSQ;

    if (IN(0)) { p0_prologue(F, A); if (BOTH(0)) GRID_BAR(); }
    if (IN(1)) {
        { pg8::EpiSwiglu E{WSP(bf16, WS_ACT), FF, SSQ0}; run_gemm(F, WSP(bf16, WS_XBA), WSP(bf16, WS_W1GU), M, NGU, D, E, bid); }
        { pg8::EpiKV E{F.out + O_PMK, F.out + O_PMV, WSP(bf16, WS_KM), WSP(bf16, WS_VT), WSP(float, WS_SSQM)}; run_gemm(F, WSP(bf16, WS_MEMB), WSP(bf16, WS_WKV), MMEM, 2 * D, D, E, (bid + F.G - (F.G * 3) / 4) % F.G); }
        if (BOTH(1)) GRID_BAR(); }
    if (IN(2)) {
        pg8::EpiRes<true, true> E{INP(I_XP), INP(I_XS), WSP(float, WS_XR), WSP(bf16, WS_XBB), SSQ1, 0.5f}; run_gemm(F, WSP(bf16, WS_ACT), WSP(bf16, WS_W1D), M, D, FF, E, bid);
        if (BOTH(2)) GRID_BAR(); }
    if (IN(3)) {
        pg8::EpiProj E{WSP(float, WS_PROJ), DINP, SSQ1}; run_gemm(F, WSP(bf16, WS_XBB), WSP(bf16, WS_WIN), M, DINP, D, E, bid);
        if (BOTH(3)) GRID_BAR(); }
    if (IN(4)) { p4_mixer(F, A); if (BOTH(4)) GRID_BAR(); }
    if (IN(5)) { p5_normalize(F, A); if (BOTH(5)) GRID_BAR(); }
    if (IN(6)) {
        pg8::EpiRes<false, true> E{nullptr, nullptr, WSP(float, WS_XR), WSP(bf16, WS_XBA), SSQ2, 1.0f}; run_gemm(F, WSP(bf16, WS_V), WSP(bf16, WS_WOUT), M, D, DMIX, E, bid);
        if (BOTH(6)) GRID_BAR(); }
    if (IN(7)) {
        pg8::EpiQ E{WSP(bf16, WS_Q), SSQ2, 0.04419417382415922f}; run_gemm(F, WSP(bf16, WS_XBA), WSP(bf16, WS_WQ), M, D, D, E, bid);
        if (BOTH(7)) GRID_BAR(); }
    if (IN(8)) { p8_attention(F, A); if (BOTH(8)) GRID_BAR(); }
    if (IN(9)) {
        pg8::EpiRes<false, true> E{nullptr, nullptr, WSP(float, WS_XR), WSP(bf16, WS_XBB), SSQ3, 1.0f}; run_gemm(F, WSP(bf16, WS_O), WSP(bf16, WS_WO), M, D, D, E, bid);
        if (BOTH(9)) GRID_BAR(); }
    if (IN(10)) {
        pg8::EpiSwiglu E{WSP(bf16, WS_ACT), FF, SSQ3}; run_gemm(F, WSP(bf16, WS_XBB), WSP(bf16, WS_W2GU), M, NGU, D, E, bid);
        if (BOTH(10)) GRID_BAR(); }
    if (IN(11)) {
        pg8::EpiRes<false, false> E{nullptr, nullptr, WSP(float, WS_XR), nullptr, SSQ4, 0.5f}; run_gemm(F, WSP(bf16, WS_ACT), WSP(bf16, WS_W2D), M, D, FF, E, bid);
        if (BOTH(11)) GRID_BAR(); }
    if (IN(12)) { p12_final(F, A); }
#undef IN
#undef BOTH
}

extern "C" void kernel_launch(void* const* d_in, const int* in_sizes, int n_in, void* d_out, int out_size, void* d_ws, size_t ws_size, hipStream_t stream) {
    static int grid = 0;
    if (grid == 0) {
        if (n_in != N_IN || (size_t)out_size != O_END || ws_size < WS_END) { fprintf(stderr, "kernel_launch: shape mismatch: n_in %d out %d ws %zu (need %zu)\n", n_in, out_size, ws_size, (size_t)WS_END); grid = -1; return; }
        int dev = 0, cus = 0, per_cu = 0;
        if (hipGetDevice(&dev) != hipSuccess || hipDeviceGetAttribute(&cus, hipDeviceAttributeMultiprocessorCount, dev) != hipSuccess) { grid = -1; return; }
        if (hipFuncSetAttribute((const void*)hymba_fwd, hipFuncAttributeMaxDynamicSharedMemorySize, LDS_BYTES) != hipSuccess) { fprintf(stderr, "kernel_launch: hipFuncSetAttribute failed\n"); grid = -1; return; }
        if (hipOccupancyMaxActiveBlocksPerMultiprocessor(&per_cu, (const void*)hymba_fwd, NWAVES * 64, LDS_BYTES) != hipSuccess || per_cu < 1) { fprintf(stderr, "kernel_launch: occupancy query says %d blocks per CU\n", per_cu); (void)hipGetLastError(); grid = -1; return; }
        grid = cus;
    }
    if (grid < 0) return;
    if (hipMemsetAsync((char*)d_ws + WS_CTL, 0, CTL_ZERO_BYTES, stream) != hipSuccess) return;
    Args a{};
    for (int i = 0; i < N_IN; ++i) a.in[i] = (const float*)d_in[i];
    a.out = (float*)d_out; a.ws = (unsigned char*)d_ws;
#if MK_PER_PHASE
    for (int p = 0; p < N_PHASES; ++p) { a.ph_lo = p; a.ph_hi = p + 1; hipLaunchKernelGGL(hymba_fwd, dim3(grid), dim3(NWAVES * 64), LDS_BYTES, stream, a); }
#else
    a.ph_lo = 0; a.ph_hi = N_PHASES; hipLaunchKernelGGL(hymba_fwd, dim3(grid), dim3(NWAVES * 64), LDS_BYTES, stream, a);
#endif
}
```

```cpp
#include <hip/hip_runtime.h>
#include <cstdio>
#include <cstdint>

constexpr int NWAVES = 8;
constexpr int D = 2048, MP = 8192, MS = 1024, M = MP + MS, TP = 2048, TS = 8, NBP = 4, NBS = 128;
constexpr int FF = 5632, NGU = 2 * FF, DIN = 8736, DINP = 8960, DMIX = 4096, NMEM = 256, MMEM = NBP * NMEM;
constexpr int LRU_H = 16, LRU_B = 128, SSD_H = 32, SSD_P = 64, SSD_N = 128, XBC = 2560;
constexpr int C_XL = 0, C_GL = 2048, C_Z = 4096, C_XBC = 6144, C_DT = 8704;
constexpr float EPS = 1e-6f;
constexpr int NSSQ = 32;
constexpr int NSQV = 144;
constexpr size_t O_Y = 0, O_PLC = (size_t)M * D, O_PLH = O_PLC + (size_t)NBP * 3 * D, O_PSC = O_PLH + (size_t)NBP * D, O_PSH = O_PSC + (size_t)NBP * 3 * XBC,
                 O_PMK = O_PSH + (size_t)NBP * SSD_H * SSD_P * SSD_N, O_PMV = O_PMK + (size_t)MMEM * D, O_SLC = O_PMV + (size_t)MMEM * D, O_SLH = O_SLC + (size_t)NBS * 3 * D,
                 O_SSC = O_SLH + (size_t)NBS * D, O_SSH = O_SSC + (size_t)NBS * 3 * XBC, O_END = O_SSH + (size_t)NBS * SSD_H * SSD_P * SSD_N;
static_assert(O_END == 59766784, "d_out size");
enum { I_XP = 0, I_MEMP, I_XS, I_CK, I_CV, I_SLC, I_SLH, I_SSC, I_SSH, I_F1G, I_F1WG, I_F1WU, I_F1WD, I_MIXG, I_WIN, I_LCW, I_LCB, I_LWA, I_LBA, I_LWX, I_LBX, I_LLAM, I_LOG,
       I_SCW, I_SCB, I_SDTB, I_SALOG, I_SD, I_SOG, I_WOUT, I_XAG, I_MEMG, I_WQ, I_WK, I_WV, I_WO, I_F2G, I_F2WG, I_F2WU, I_F2WD, I_FING, N_IN };
static_assert(N_IN == 41, "inputs");

constexpr size_t MiB = 1u << 20;
constexpr size_t al(size_t x) { return (x + 4095) & ~(size_t)4095; }
constexpr size_t WS_CTL = 0, CTL_ZERO_BYTES = 1 * MiB;
constexpr size_t WS_W1GU = 2 * MiB;
constexpr size_t WS_W1D  = WS_W1GU + al((size_t)NGU * D * 2);
constexpr size_t WS_WIN  = WS_W1D + al((size_t)D * FF * 2);
constexpr size_t WS_WOUT = WS_WIN + al((size_t)DINP * D * 2);
constexpr size_t WS_WQ   = WS_WOUT + al((size_t)D * DMIX * 2);
constexpr size_t WS_WKV  = WS_WQ + al((size_t)D * D * 2);
constexpr size_t WS_WO   = WS_WKV + al((size_t)2 * D * D * 2);
constexpr size_t WS_W2GU = WS_WO + al((size_t)D * D * 2);
constexpr size_t WS_W2D  = WS_W2GU + al((size_t)NGU * D * 2);
constexpr size_t WS_WL   = WS_W2D + al((size_t)D * FF * 2);
constexpr size_t WS_XBA  = WS_WL + al((size_t)LRU_H * 256 * 128 * 2);
constexpr size_t WS_XBB  = WS_XBA + al((size_t)M * D * 2);
constexpr size_t WS_MEMB = WS_XBB + al((size_t)M * D * 2);
constexpr size_t WS_ACT  = WS_MEMB + al((size_t)MMEM * D * 2);
constexpr size_t WS_XR   = WS_ACT + al((size_t)M * FF * 2);
constexpr size_t WS_PROJ = WS_XR + al((size_t)M * D * 4);
constexpr size_t WS_V    = WS_PROJ + al((size_t)M * DINP * 4);
constexpr size_t WS_Q    = WS_V + al((size_t)M * DMIX * 2);
constexpr size_t WS_O    = WS_Q + al((size_t)M * D * 2);
constexpr size_t WS_KM   = WS_O + al((size_t)M * D * 2);
constexpr size_t WS_VT   = WS_KM + al((size_t)MMEM * D * 2);
constexpr size_t WS_SSQ  = WS_VT + al((size_t)MMEM * D * 2);
constexpr size_t WS_SSQM = WS_SSQ + al((size_t)4 * M * NSSQ * 4);
constexpr size_t WS_SQV  = WS_SSQM + al((size_t)MMEM * NSSQ * 4);
constexpr size_t WS_END  = WS_SQV + al((size_t)M * NSQV * 4);
constexpr int CW_TMO = 0, CW_CODE = 1, CW_QUEUE = 64, CW_BAR = 4096;

namespace pg8 {
#define PG8_LAS __attribute__((address_space(3)))
typedef unsigned short bf16_t;
typedef short bf16x8 __attribute__((ext_vector_type(8)));
typedef float f32x4 __attribute__((ext_vector_type(4)));
typedef unsigned u32x4 __attribute__((ext_vector_type(4)));
constexpr int BM = 256, BK = 64, HALF = 128, HTB = HALF * BK * 2  , STAGE_BYTES = 8 * HTB, NXCD = 8, WGM = 8;

__host__ __device__ __forceinline__ int lds_byte(int r, int c) { const int st = (r >> 4) * 2 + (c >> 5), rr = r & 15, cc = c & 31, ob = rr * 64 + cc * 2; return st * 1024 + (ob ^ (((ob >> 9) & 1) << 5)); }
__host__ __device__ __forceinline__ void stage_rc(int b, int& R, int& C) { const int st = b / 1024, sb = b % 1024, swz = sb ^ (((sb >> 9) & 1) << 5); R = (st >> 1) * 16 + swz / 64; C = (st & 1) * 32 + (swz % 64) / 2; }
__host__ __device__ __forceinline__ int perm32(int rho) { const int n = rho >> 4, i = rho & 15; return 8 * (i >> 2) + 4 * n + (i & 3); }

struct Unit { int pm, pn; };
struct Gemm { const bf16_t* A; const bf16_t* Bt; int M, N, K; };

struct StaticOrder {
    int nM, nN, nwg, G, c;
    __host__ __device__ void init(int M, int N, int G_, int c_) { nM = M / BM; nN = N / BM; nwg = nM * nN; G = G_; c = c_; }
    __host__ __device__ bool next(int i, Unit& u) const {
        const long L = (long)i * G + c; if (L >= nwg) return false;
        int wgid = (int)L; { const int q = nwg / NXCD, r = nwg % NXCD, xcd = wgid % NXCD, off = wgid / NXCD; wgid = (xcd < r ? xcd * (q + 1) : r * (q + 1) + (xcd - r) * q) + off; }
        const int nig = WGM * nN, gid = wgid / nig, fm = gid * WGM, gsz = (nM - fm) < WGM ? (nM - fm) : WGM;
        u.pm = fm + ((wgid % nig) % gsz); u.pn = (wgid % nig) / gsz; return true;
    }
    __device__ __forceinline__ void a_ready(const Unit&) const {}
    __device__ __forceinline__ void done(const Unit&) const {}
};

__device__ __forceinline__ unsigned cvt_pk_bf16(float lo, float hi) { unsigned r; asm volatile("v_cvt_pk_bf16_f32 %0, %1, %2" : "=v"(r) : "v"(lo), "v"(hi)); return r; }
typedef unsigned u32x2 __attribute__((ext_vector_type(2)));
constexpr float EPS_ = 1e-6f;
__device__ __forceinline__ float row_rstd(const float* ssq, int row, int fq) {
    const f32x4* p = (const f32x4*)(ssq + (size_t)row * 32 + fq * 8);
    const f32x4 a = p[0], b = p[1];
    float s = ((a[0] + a[1]) + (a[2] + a[3])) + ((b[0] + b[1]) + (b[2] + b[3]));
    s += __shfl_xor(s, 16); s += __shfl_xor(s, 32);
    return __builtin_amdgcn_rsqf(s * (1.0f / 2048.0f) + EPS_);
}
__device__ __forceinline__ float silu_f(float x) { return x * __builtin_amdgcn_rcpf(1.0f + __expf(-x)); }

struct EpiSwiglu {
    static constexpr bool PERM = true, AFTER_DRAIN = false;
    bf16_t* O; int ldc; const float* ssq;
    __device__ __forceinline__ void operator()(const f32x4 (&acc)[2][2][4][2], const Unit& u, int wr, int wc, int fr, int fq) const {
        const int row0 = u.pm * BM + wr * 64 + fr, col0 = u.pn * HALF + wc * 32 + 8 * fq;
#pragma unroll
        for (int ai = 0; ai < 2; ++ai)
#pragma unroll
            for (int m = 0; m < 4; ++m) { const int row = row0 + ai * HALF + m * 16; const float rs = row_rstd(ssq, row, fq);
                u32x4 w; float o[8];
#pragma unroll
                for (int n = 0; n < 2; ++n)
#pragma unroll
                    for (int i = 0; i < 4; ++i) { const float g = acc[ai][0][m][n][i] * rs, up = acc[ai][1][m][n][i] * rs; o[4 * n + i] = silu_f(g) * up; }
                w.x = cvt_pk_bf16(o[0], o[1]); w.y = cvt_pk_bf16(o[2], o[3]); w.z = cvt_pk_bf16(o[4], o[5]); w.w = cvt_pk_bf16(o[6], o[7]);
                *(u32x4*)(O + (size_t)row * ldc + col0) = w; }
    }
};
struct EpiKV {
    static constexpr bool PERM = false, AFTER_DRAIN = false;
    float* ko; float* vo; bf16_t* km; bf16_t* vt; const float* ssq;
    __device__ __forceinline__ void operator()(const f32x4 (&acc)[2][2][4][2], const Unit& u, int wr, int wc, int fr, int fq) const {
        const int row0 = u.pm * BM + wr * 64 + fr;
#pragma unroll
        for (int ai = 0; ai < 2; ++ai)
#pragma unroll
            for (int m = 0; m < 4; ++m) { const int row = row0 + ai * HALF + m * 16; const float rs = row_rstd(ssq, row, fq);
#pragma unroll
                for (int bj = 0; bj < 2; ++bj)
#pragma unroll
                    for (int n = 0; n < 2; ++n) { const int col = u.pn * BM + bj * HALF + wc * 32 + n * 16 + 4 * fq; const f32x4 v = acc[ai][bj][m][n] * rs;
                        if (u.pn < 8) { *(f32x4*)(ko + (size_t)row * 2048 + col) = v; u32x2 w; w.x = cvt_pk_bf16(v[0], v[1]); w.y = cvt_pk_bf16(v[2], v[3]); *(u32x2*)(km + (size_t)row * 2048 + col) = w; }
                        else { const int c2 = col - 2048; *(f32x4*)(vo + (size_t)row * 2048 + c2) = v; const int b = row >> 8, key = row & 255;
                            const unsigned w0 = cvt_pk_bf16(v[0], v[1]), w1 = cvt_pk_bf16(v[2], v[3]); bf16_t* t = vt + ((size_t)(b * 2048 + c2)) * 256 + key;
                            t[0] = (bf16_t)(w0 & 0xffffu); t[256] = (bf16_t)(w0 >> 16); t[512] = (bf16_t)(w1 & 0xffffu); t[768] = (bf16_t)(w1 >> 16); } } }
    }
};
template <bool FIRST, bool WRITE_XB> struct EpiRes {
    static constexpr bool PERM = false, AFTER_DRAIN = false;
    const float* xp; const float* xs; float* xr; bf16_t* xb; float* ssq_out; float alpha;
    __device__ __forceinline__ void operator()(const f32x4 (&acc)[2][2][4][2], const Unit& u, int wr, int wc, int fr, int fq) const {
        const int row0 = u.pm * BM + wr * 64 + fr;
#pragma unroll
        for (int ai = 0; ai < 2; ++ai)
#pragma unroll
            for (int m = 0; m < 4; ++m) { const int row = row0 + ai * HALF + m * 16; float q = 0.f;
                const float* base = FIRST ? (row < 8192 ? xp + (size_t)row * 2048 : xs + (size_t)(row - 8192) * 2048) : xr + (size_t)row * 2048;
#pragma unroll
                for (int bj = 0; bj < 2; ++bj)
#pragma unroll
                    for (int n = 0; n < 2; ++n) { const int col = u.pn * BM + bj * HALF + wc * 32 + n * 16 + 4 * fq; const f32x4 b = *(const f32x4*)(base + col); const f32x4 o = b + acc[ai][bj][m][n] * alpha;
                        *(f32x4*)(xr + (size_t)row * 2048 + col) = o; q += (o[0] * o[0] + o[1] * o[1]) + (o[2] * o[2] + o[3] * o[3]);
                        if (WRITE_XB) { u32x2 w; w.x = cvt_pk_bf16(o[0], o[1]); w.y = cvt_pk_bf16(o[2], o[3]); *(u32x2*)(xb + (size_t)row * 2048 + col) = w; } }
                q += __shfl_xor(q, 16); q += __shfl_xor(q, 32);
                if (fq == 0) ssq_out[(size_t)row * 32 + u.pn * 4 + wc] = q; }
    }
};
struct EpiProj {
    static constexpr bool PERM = false, AFTER_DRAIN = false;
    float* C; int ldc; const float* ssq;
    __device__ __forceinline__ void operator()(const f32x4 (&acc)[2][2][4][2], const Unit& u, int wr, int wc, int fr, int fq) const {
        const int row0 = u.pm * BM + wr * 64 + fr;
#pragma unroll
        for (int ai = 0; ai < 2; ++ai)
#pragma unroll
            for (int m = 0; m < 4; ++m) { const int row = row0 + ai * HALF + m * 16; const float rs = row_rstd(ssq, row, fq);
#pragma unroll
                for (int bj = 0; bj < 2; ++bj)
#pragma unroll
                    for (int n = 0; n < 2; ++n) { const int col = u.pn * BM + bj * HALF + wc * 32 + n * 16 + 4 * fq; *(f32x4*)(C + (size_t)row * ldc + col) = acc[ai][bj][m][n] * rs; } }
    }
};
struct EpiQ {
    static constexpr bool PERM = true, AFTER_DRAIN = false;
    bf16_t* O; const float* ssq; float scale;
    __device__ __forceinline__ void operator()(const f32x4 (&acc)[2][2][4][2], const Unit& u, int wr, int wc, int fr, int fq) const {
        const int row0 = u.pm * BM + wr * 64 + fr, col0 = u.pn * BM + wc * 32 + 8 * fq;
#pragma unroll
        for (int ai = 0; ai < 2; ++ai)
#pragma unroll
            for (int m = 0; m < 4; ++m) { const int row = row0 + ai * HALF + m * 16; const float rs = row_rstd(ssq, row, fq) * scale;
#pragma unroll
                for (int bj = 0; bj < 2; ++bj) { const f32x4 v0 = acc[ai][bj][m][0] * rs, v1 = acc[ai][bj][m][1] * rs;
                    u32x4 w; w.x = cvt_pk_bf16(v0[0], v0[1]); w.y = cvt_pk_bf16(v0[2], v0[3]); w.z = cvt_pk_bf16(v1[0], v1[1]); w.w = cvt_pk_bf16(v1[2], v1[3]);
                    *(u32x4*)(O + (size_t)row * 2048 + col0 + bj * HALF) = w; } }
    }
};

template <class Epi, class Sched, bool ALIGN_EPI = false, bool SP2 = false>
__device__ __forceinline__ void gemm_phase(PG8_LAS unsigned char* lds, const Gemm g, const Sched& S, const Epi& E) {
    const int tid = threadIdx.x, wid = __builtin_amdgcn_readfirstlane(tid >> 6), lane = tid & 63, wr = wid >> 2, wc = wid & 3, fr = lane & 15, fq = lane >> 4;
    const int K = g.K, nt = K / BK;
    unsigned voffA[2], voffB[2];
#pragma unroll
    for (int i = 0; i < 2; ++i) { int R, C; stage_rc(tid * 16 + i * 8192, R, C); const int Rb = Epi::PERM ? ((R & ~31) + perm32(R & 31)) : R;
        voffA[i] = (unsigned)(R * K + C) * 2u; voffB[i] = (unsigned)(Rb * K + C) * 2u; }
    const size_t kstep = (size_t)(BK * 2);
    const size_t hstep = (size_t)HALF * K * 2;
    const size_t tstep = 2 * hstep;
    const unsigned ldsw = (unsigned)wid * 1024u;
    const int aoff = lds_byte(wr * 64 + fr, fq * 8), boff = lds_byte(wc * 32 + fr, fq * 8);
#define PG8_SA(b, h) (((b) * 2 + (h)) * HTB)
#define PG8_SB(b, h) ((4 + (b) * 2 + (h)) * HTB)
#define PG8_STAGE(bufoff, gbase, voff) do { _Pragma("unroll") for (int _i = 0; _i < 2; ++_i) \
        __builtin_amdgcn_global_load_lds((const unsigned*)((const char*)(gbase) + (voff)[_i]), (PG8_LAS unsigned*)(lds + (bufoff) + ldsw + _i * 8192), 16, 0, 0); } while (0)
#define PG8_LDA(dst, b, h) do { _Pragma("unroll") for (int m = 0; m < 4; ++m) _Pragma("unroll") for (int k = 0; k < 2; ++k) dst[m][k] = *(const PG8_LAS bf16x8*)(lds + PG8_SA(b, h) + aoff + m * 2048 + k * 1024); } while (0)
#define PG8_LDB(dst, b, h) do { _Pragma("unroll") for (int n = 0; n < 2; ++n) _Pragma("unroll") for (int k = 0; k < 2; ++k) dst[n][k] = *(const PG8_LAS bf16x8*)(lds + PG8_SB(b, h) + boff + n * 2048 + k * 1024); } while (0)
#define PG8_MMA(ai, bj, At, Bt) do { __builtin_amdgcn_s_setprio(1); _Pragma("unroll") for (int m = 0; m < 4; ++m) _Pragma("unroll") for (int n = 0; n < 2; ++n) _Pragma("unroll") for (int k = 0; k < 2; ++k) \
        acc[ai][bj][m][n] = __builtin_amdgcn_mfma_f32_16x16x32_bf16(Bt[n][k], At[m][k], acc[ai][bj][m][n], 0, 0, 0); __builtin_amdgcn_s_setprio(0); } while (0)
#define PG8_WAIT_V(n) asm volatile("s_waitcnt vmcnt(" #n ")" ::: "memory")
#define PG8_WAIT_L(n) asm volatile("s_waitcnt lgkmcnt(" #n ")" ::: "memory")
#define PG8_BAR __builtin_amdgcn_s_barrier()
#define PG8_SCHED __builtin_amdgcn_sched_barrier(0)
    Unit cur, nxt; int ui = 0;
    if (!S.next(0, cur)) return;
    f32x4 acc[2][2][4][2];
#pragma unroll
    for (int a = 0; a < 2; ++a)
#pragma unroll
        for (int b = 0; b < 2; ++b)
#pragma unroll
            for (int m = 0; m < 4; ++m)
#pragma unroll
                for (int n = 0; n < 2; ++n) acc[a][b][m][n] = (f32x4){0.f, 0.f, 0.f, 0.f};
    bf16x8 At[4][2], B0[2][2], B1[2][2];
    const char* cA = (const char*)g.A + (size_t)cur.pm * tstep; const char* cB = (const char*)g.Bt + (size_t)cur.pn * tstep;
    S.a_ready(cur);
    if constexpr (SP2) {
        PG8_STAGE(PG8_SB(0, 0), cB, voffB); PG8_STAGE(PG8_SB(0, 1), cB + hstep, voffB); PG8_STAGE(PG8_SA(0, 0), cA, voffA); PG8_STAGE(PG8_SA(0, 1), cA + hstep, voffA);
        if (wr == 1) PG8_BAR;
        PG8_WAIT_V(2); PG8_BAR;
        PG8_STAGE(PG8_SB(1, 0), cB + kstep, voffB); PG8_STAGE(PG8_SA(1, 0), cA + kstep, voffA); PG8_STAGE(PG8_SB(1, 1), cB + hstep + kstep, voffB);
        PG8_WAIT_V(6); PG8_BAR;
    } else {
        PG8_STAGE(PG8_SB(0, 0), cB, voffB); PG8_STAGE(PG8_SA(0, 0), cA, voffA); PG8_STAGE(PG8_SB(0, 1), cB + hstep, voffB); PG8_STAGE(PG8_SA(0, 1), cA + hstep, voffA);
        if (wr == 1) PG8_BAR;
        PG8_WAIT_V(4); PG8_BAR;
        PG8_STAGE(PG8_SB(1, 0), cB + kstep, voffB); PG8_STAGE(PG8_SA(1, 0), cA + kstep, voffA); PG8_STAGE(PG8_SB(1, 1), cB + hstep + kstep, voffB);
        PG8_WAIT_V(6); PG8_BAR;
    }
    for (;;) {
        const bool has_next = S.next(ui + 1, nxt);
        const char* nA = has_next ? (const char*)g.A + (size_t)nxt.pm * tstep : cA; const char* nB = has_next ? (const char*)g.Bt + (size_t)nxt.pn * tstep : cB;
        for (int t = 0; t < nt; t += 2) {
            const bool last = (t == nt - 2);
            const char* a1 = cA + (size_t)(t + 1) * kstep;
            const char* a2 = last ? nA : cA + (size_t)(t + 2) * kstep; const char* b2 = last ? nB : cB + (size_t)(t + 2) * kstep;
            const char* a3 = a2 + kstep; const char* b3 = b2 + kstep;
            if (last && has_next) S.a_ready(nxt);
            if constexpr (SP2) {
            PG8_LDB(B0, 0, 0); PG8_LDB(B1, 0, 1); PG8_SCHED; PG8_LDA(At, 0, 0); PG8_STAGE(PG8_SA(1, 1), a1 + hstep, voffA);
            PG8_WAIT_V(8); PG8_WAIT_L(0); PG8_BAR; PG8_MMA(0, 0, At, B0); PG8_MMA(0, 1, At, B1); PG8_BAR; PG8_SCHED;
            PG8_LDA(At, 0, 1); PG8_STAGE(PG8_SB(0, 0), b2, voffB); PG8_STAGE(PG8_SB(0, 1), b2 + hstep, voffB); PG8_STAGE(PG8_SA(0, 0), a2, voffA);
            PG8_WAIT_V(8); PG8_WAIT_L(0); PG8_BAR; PG8_MMA(1, 0, At, B0); PG8_MMA(1, 1, At, B1); PG8_BAR; PG8_SCHED;
            PG8_LDB(B0, 1, 0); PG8_LDB(B1, 1, 1); PG8_SCHED; PG8_LDA(At, 1, 0); PG8_STAGE(PG8_SA(0, 1), a2 + hstep, voffA);
            PG8_WAIT_V(8); PG8_WAIT_L(0); PG8_BAR; PG8_MMA(0, 0, At, B0); PG8_MMA(0, 1, At, B1); PG8_BAR; PG8_SCHED;
            PG8_LDA(At, 1, 1); PG8_STAGE(PG8_SB(1, 0), b3, voffB); PG8_STAGE(PG8_SB(1, 1), b3 + hstep, voffB); PG8_STAGE(PG8_SA(1, 0), a3, voffA);
            PG8_WAIT_V(8); PG8_WAIT_L(0); PG8_BAR; PG8_MMA(1, 0, At, B0); PG8_MMA(1, 1, At, B1); PG8_BAR; PG8_SCHED;
            } else {
            PG8_LDB(B0, 0, 0); PG8_SCHED; PG8_LDA(At, 0, 0); PG8_STAGE(PG8_SA(1, 1), a1 + hstep, voffA);
            PG8_WAIT_L(8); PG8_BAR; PG8_WAIT_L(0); PG8_MMA(0, 0, At, B0); PG8_BAR; PG8_SCHED;
            PG8_LDB(B1, 0, 1); PG8_STAGE(PG8_SB(0, 0), b2, voffB);
            PG8_BAR; PG8_WAIT_L(0); PG8_MMA(0, 1, At, B1); PG8_BAR;
            PG8_LDA(At, 0, 1); PG8_STAGE(PG8_SA(0, 0), a2, voffA);
            PG8_BAR; PG8_WAIT_L(0); PG8_MMA(1, 0, At, B0); PG8_BAR; PG8_SCHED;
            PG8_STAGE(PG8_SB(0, 1), b2 + hstep, voffB);
            PG8_WAIT_V(6); PG8_BAR; PG8_MMA(1, 1, At, B1); PG8_BAR;
            PG8_LDB(B0, 1, 0); PG8_SCHED; PG8_LDA(At, 1, 0); PG8_STAGE(PG8_SA(0, 1), a2 + hstep, voffA);
            PG8_WAIT_L(8); PG8_BAR; PG8_WAIT_L(0); PG8_MMA(0, 0, At, B0); PG8_BAR; PG8_SCHED;
            PG8_LDB(B1, 1, 1); PG8_STAGE(PG8_SB(1, 0), b3, voffB);
            PG8_BAR; PG8_WAIT_L(0); PG8_MMA(0, 1, At, B1); PG8_BAR;
            PG8_LDA(At, 1, 1); PG8_STAGE(PG8_SA(1, 0), a3, voffA);
            PG8_BAR; PG8_WAIT_L(0); PG8_MMA(1, 0, At, B0); PG8_BAR; PG8_SCHED;
            PG8_STAGE(PG8_SB(1, 1), b3 + hstep, voffB);
            PG8_WAIT_V(6); PG8_BAR; PG8_MMA(1, 1, At, B1); PG8_BAR;
            }
        }
        if constexpr (ALIGN_EPI) { if (wr == 0) PG8_BAR; }
        if constexpr (!Epi::AFTER_DRAIN) { E(acc, cur, wr, wc, fr, fq); S.done(cur); }
        if (!has_next) break;
#pragma unroll
        for (int a = 0; a < 2; ++a)
#pragma unroll
            for (int b = 0; b < 2; ++b)
#pragma unroll
                for (int m = 0; m < 4; ++m)
#pragma unroll
                    for (int n = 0; n < 2; ++n) acc[a][b][m][n] = (f32x4){0.f, 0.f, 0.f, 0.f};
        cur = nxt; cA = nA; cB = nB; ++ui;
        if constexpr (ALIGN_EPI) { if (wr == 1) PG8_BAR; }
    }
    PG8_WAIT_V(0);
    if constexpr (!ALIGN_EPI) { if (wr == 0) PG8_BAR; }
    PG8_BAR;
    if constexpr (Epi::AFTER_DRAIN) { E.fused(acc, cur, wr, wc, fr, fq, lds, wid, lane); S.done(cur); }
#undef PG8_SA
#undef PG8_SB
#undef PG8_STAGE
#undef PG8_LDA
#undef PG8_LDB
#undef PG8_MMA
#undef PG8_WAIT_V
#undef PG8_WAIT_L
#undef PG8_BAR
#undef PG8_SCHED
}
}
#ifndef PG8_SP2
#define PG8_SP2 true
#endif
#ifndef PG8_ALIGN
#define PG8_ALIGN true
#endif
constexpr int RING_OFF = 0, RING_BYTES = 131072;
constexpr int LDSCTL_OFF = RING_BYTES, MISC_OFF = LDSCTL_OFF + 320;
constexpr int LDS_BYTES = 147456;
static_assert(MISC_OFF + 128 <= LDS_BYTES, "LDS map");

#define GAS __attribute__((address_space(1)))
#define LAS __attribute__((address_space(3)))
typedef unsigned short bf16;
typedef unsigned v4u __attribute__((ext_vector_type(4)));
typedef unsigned v2u __attribute__((ext_vector_type(2)));
typedef float f32x4 __attribute__((ext_vector_type(4)));
typedef float f32x2 __attribute__((ext_vector_type(2)));
typedef short bf16x8 __attribute__((ext_vector_type(8)));
typedef short bf16x4 __attribute__((ext_vector_type(4)));
typedef GAS unsigned gu32;
#define RLX_AGENT __ATOMIC_RELAXED, __HIP_MEMORY_SCOPE_AGENT
#define LDS_WAIT() asm volatile("s_waitcnt lgkmcnt(0)" ::: "memory")
#define VM_WAIT() asm volatile("s_waitcnt vmcnt(0)" ::: "memory")
__device__ __forceinline__ unsigned f2bf(float f) { unsigned u = __builtin_bit_cast(unsigned, f); return (u + 0x7fffu + ((u >> 16) & 1u)) >> 16; }
__device__ __forceinline__ unsigned pk2(float lo, float hi) { return f2bf(lo) | (f2bf(hi) << 16); }
__device__ __forceinline__ float bf2f(unsigned b) { return __builtin_bit_cast(float, b << 16); }
__device__ __forceinline__ float wave_sum(float v) {
#pragma unroll
    for (int o = 1; o < 64; o <<= 1) v += __shfl_xor(v, o);
    return v;
}
__device__ __forceinline__ float sigmoid_f(float x) { return __builtin_amdgcn_rcpf(1.0f + __expf(-x)); }
__device__ __forceinline__ float siluf_(float x) { return x * sigmoid_f(x); }
__device__ __forceinline__ float softplus_f(float x) { return x > 20.f ? x : log1pf(__expf(x)); }
__device__ __forceinline__ float gelu_tanh_f(float x) { const float t = 0.7978845608028654f * (x + 0.044715f * x * x * x); return x * sigmoid_f(2.0f * t); }
#define MFMA16(a, b, c) __builtin_amdgcn_mfma_f32_16x16x32_bf16((a), (b), (c), 0, 0, 0)

#define XB_TMO      128
#define XB_XCNT(j)  (256  + 64 * (j))
#define XB_XSUB(j)  (1280 + 64 * (j))
#define XB_XGEN(j)  (2304 + 64 * (j))
#define XB_TOP      3328
#define XB_TOPGEN   3392
#define XCD_BAR_WORDS 3456
#define XB_SPIN_CAP (1u << 18)

__device__ __forceinline__ unsigned xb_ld(unsigned* p)              { return __hip_atomic_load(p, __ATOMIC_RELAXED, __HIP_MEMORY_SCOPE_AGENT); }
__device__ __forceinline__ unsigned xb_add(unsigned* p, unsigned v) { return __hip_atomic_fetch_add(p, v, __ATOMIC_RELAXED, __HIP_MEMORY_SCOPE_AGENT); }
__device__ __forceinline__ unsigned xb_xcc_id() { return (unsigned)__builtin_amdgcn_s_getreg((3 << 11) | 20) & 0xFu; }
#define XB_SPIN(cond, bar) do { unsigned _sp = 0; while (cond) { __builtin_amdgcn_s_sleep(1); \
    if ((++_sp & 255u) == 0u) { if (xb_ld(&(bar)[XB_TMO])) break; if (_sp > XB_SPIN_CAP) { atomicAdd(&(bar)[XB_TMO], 1u); break; } } } } while (0)

struct XcdBarrier {
    unsigned* bar; unsigned x;
    volatile LAS unsigned* st;
};

__device__ __forceinline__ XcdBarrier xcd_barrier_post(unsigned* bar, volatile LAS unsigned* st) {
    XcdBarrier b; b.bar = bar; b.x = xb_xcc_id(); b.st = st;
    if (threadIdx.x == 0) (void)xb_add(&bar[XB_XCNT(b.x)], 1u);
    return b;
}
__device__ __forceinline__ void xcd_barrier_complete(unsigned* bar, unsigned x, unsigned& nloc, unsigned& nx) {
    const unsigned G = gridDim.x * gridDim.y * gridDim.z;
    unsigned sum, cnt, mine, sp = 0u;
    for (;;) {
        sum = 0u; cnt = 0u; mine = 0u;
#pragma unroll
        for (unsigned j = 0; j < 16; ++j) { const unsigned c = xb_ld(&bar[XB_XCNT(j)]); sum += c; cnt += (c > 0u) ? 1u : 0u; mine = (j == x) ? c : mine; }
        if (sum == G) break;
        __builtin_amdgcn_s_sleep(1);
        if ((++sp & 255u) == 0u) { if (xb_ld(&bar[XB_TMO])) break; if (sp > XB_SPIN_CAP) { atomicAdd(&bar[XB_TMO], 1u); break; } }
    }
    nloc = mine > 0u ? mine : 1u; nx = cnt > 0u ? cnt : 1u;
}

__device__ __forceinline__ void xcd_barrier(const XcdBarrier& b) {
    asm volatile("s_waitcnt vmcnt(0)" ::: "memory");
    __syncthreads();
    if (threadIdx.x == 0) {
        unsigned* bar = b.bar;
        __builtin_amdgcn_s_waitcnt(0);
        unsigned nloc = b.st[0], nx = b.st[1];
        if (nloc == 0u) { xcd_barrier_complete(bar, b.x, nloc, nx); b.st[0] = nloc; b.st[1] = nx; }
        const unsigned old = xb_add(&bar[XB_XSUB(b.x)], 1u);
        const unsigned gen = old / nloc;
        if (old + 1u == (gen + 1u) * nloc) {
            __builtin_amdgcn_fence(__ATOMIC_RELEASE, "agent");
            asm volatile("s_waitcnt vmcnt(0)" ::: "memory");
            const unsigned og = xb_add(&bar[XB_TOP], 1u);
            const unsigned tg = og / nx;
            if (og + 1u == (tg + 1u) * nx) xb_add(&bar[XB_TOPGEN], 1u);
            else XB_SPIN(xb_ld(&bar[XB_TOPGEN]) == tg, bar);
            __builtin_amdgcn_fence(__ATOMIC_ACQUIRE, "agent");
            xb_add(&bar[XB_XGEN(b.x)], 1u);
            asm volatile("s_waitcnt vmcnt(0)" ::: "memory");
        } else {
            XB_SPIN(xb_ld(&bar[XB_XGEN(b.x)]) == gen, bar);
            __builtin_amdgcn_fence(__ATOMIC_ACQUIRE, "agent");
            asm volatile("s_waitcnt vmcnt(0)" ::: "memory");
        }
    }
    __syncthreads();
}
struct Args { const float* in[41]; float* out; unsigned char* ws; int ph_lo, ph_hi; };
struct Frame {
    LAS unsigned char* lds;
    volatile LAS unsigned* MISC;
    gu32* ctl;
    int tid, lane, wave;
    int vcu, G;
    float* out;
    unsigned char* ws;
};
#define WSP(T, off) ((T*)(F.ws + (off)))
#define INP(i) (A.in[(i)])

__device__ __forceinline__ void p0_transpose_item(const float* W, int N, bf16* WT, int ldt, int kdst, int dst_row0, const float* gain, LAS float* scr, int k0, int n0, int lane) {
    const int rs = lane >> 3, c4 = (lane & 7) * 4; f32x4 v[8]; float gn[8];
    const GAS float* src = (const GAS float*)W + (size_t)(k0 + rs) * N + n0 + c4;
#pragma unroll
    for (int i = 0; i < 8; ++i) { v[i] = *(const GAS f32x4*)(src + (size_t)(8 * i) * N); gn[i] = gain ? gain[k0 + 8 * i + rs] : 1.0f; }
#pragma unroll
    for (int i = 0; i < 8; ++i) { LAS float* d = scr + (8 * i + rs) * 33 + c4; d[0] = v[i].x * gn[i]; d[1] = v[i].y * gn[i]; d[2] = v[i].z * gn[i]; d[3] = v[i].w * gn[i]; }
    LDS_WAIT(); asm volatile("" ::: "memory");
    const int c = lane & 7;
#pragma unroll
    for (int j = 0; j < 4; ++j) { const int n = (lane >> 3) + 8 * j; const LAS float* s = scr + (8 * c) * 33 + n;
        v4u o; o.x = pk2(s[0 * 33], s[1 * 33]); o.y = pk2(s[2 * 33], s[3 * 33]); o.z = pk2(s[4 * 33], s[5 * 33]); o.w = pk2(s[6 * 33], s[7 * 33]);
        *(GAS v4u*)(WT + (size_t)(dst_row0 + n) * ldt + kdst + k0 + 8 * c) = o; }
    LDS_WAIT(); asm volatile("" ::: "memory");
}
__device__ __forceinline__ void p0_tr(const float* W, int K, int N, bf16* WT, int ldt, int kdst, int row_base, int mode  , const float* gain, LAS float* scr, int item, int lane) {
    const int nblk = N / 32, kb = item / nblk, nb = item % nblk, k0 = 64 * kb, n0 = 32 * nb; (void)K;
    const int dr = mode == 0 ? row_base + n0 : (n0 / 128) * 256 + (n0 % 128) + (mode == 2 ? 128 : 0);
    p0_transpose_item(W, N, WT, ldt, kdst, dr, gain, scr, k0, n0, lane);
}
__device__ __forceinline__ void row_to_bf16_ssq(const float* xrow, bf16* orow, float* ssq32, int lane) {
    const GAS f32x4* xr = (const GAS f32x4*)xrow + lane; GAS v2u* o8 = (GAS v2u*)orow + lane; float s = 0.f;
#pragma unroll
    for (int j = 0; j < 8; ++j) { const f32x4 v = xr[64 * j]; s += (v.x * v.x + v.y * v.y) + (v.z * v.z + v.w * v.w); v2u w; w.x = pk2(v.x, v.y); w.y = pk2(v.z, v.w); o8[64 * j] = w; }
    s = wave_sum(s);
    if (lane < 32) ssq32[lane] = lane == 0 ? s : 0.f;
}
__device__ __forceinline__ void p0_prologue(Frame& F, const Args& A) {
    LAS float* scr = (LAS float*)(F.lds + RING_OFF + F.wave * 16384);
    const int gw = F.vcu * NWAVES + F.wave, NGW = F.G * NWAVES;
    constexpr int I_GU = (D / 64) * (FF / 32), I_DN = (FF / 64) * (D / 32), I_IN = (D / 64) * (DIN / 32), I_SQ = (D / 64) * (D / 32), I_L = 16 * 8;
    constexpr int NITEMS = 4 * I_GU + 2 * I_DN + I_IN + 6 * I_SQ + 2 * I_L;
    for (int it = gw; it < NITEMS; it += NGW) {
        int r = it;
        if (r < I_GU) { p0_tr(INP(I_F1WG), D, FF, WSP(bf16, WS_W1GU), D, 0, 0, 1, INP(I_F1G), scr, r, F.lane); continue; } r -= I_GU;
        if (r < I_GU) { p0_tr(INP(I_F1WU), D, FF, WSP(bf16, WS_W1GU), D, 0, 0, 2, INP(I_F1G), scr, r, F.lane); continue; } r -= I_GU;
        if (r < I_DN) { p0_tr(INP(I_F1WD), FF, D, WSP(bf16, WS_W1D), FF, 0, 0, 0, nullptr, scr, r, F.lane); continue; } r -= I_DN;
        if (r < I_IN) { p0_tr(INP(I_WIN), D, DIN, WSP(bf16, WS_WIN), D, 0, 0, 0, INP(I_MIXG), scr, r, F.lane); continue; } r -= I_IN;
        if (r < I_SQ) { p0_tr(INP(I_WOUT), D, D, WSP(bf16, WS_WOUT), DMIX, 0, 0, 0, INP(I_LOG), scr, r, F.lane); continue; } r -= I_SQ;
        if (r < I_SQ) { p0_tr(INP(I_WOUT) + (size_t)D * D, D, D, WSP(bf16, WS_WOUT), DMIX, D, 0, 0, INP(I_SOG), scr, r, F.lane); continue; } r -= I_SQ;
        if (r < I_SQ) { p0_tr(INP(I_WQ), D, D, WSP(bf16, WS_WQ), D, 0, 0, 0, INP(I_XAG), scr, r, F.lane); continue; } r -= I_SQ;
        if (r < I_SQ) { p0_tr(INP(I_WK), D, D, WSP(bf16, WS_WKV), D, 0, 0, 0, INP(I_MEMG), scr, r, F.lane); continue; } r -= I_SQ;
        if (r < I_SQ) { p0_tr(INP(I_WV), D, D, WSP(bf16, WS_WKV), D, 0, D, 0, INP(I_MEMG), scr, r, F.lane); continue; } r -= I_SQ;
        if (r < I_SQ) { p0_tr(INP(I_WO), D, D, WSP(bf16, WS_WO), D, 0, 0, 0, nullptr, scr, r, F.lane); continue; } r -= I_SQ;
        if (r < I_GU) { p0_tr(INP(I_F2WG), D, FF, WSP(bf16, WS_W2GU), D, 0, 0, 1, INP(I_F2G), scr, r, F.lane); continue; } r -= I_GU;
        if (r < I_GU) { p0_tr(INP(I_F2WU), D, FF, WSP(bf16, WS_W2GU), D, 0, 0, 2, INP(I_F2G), scr, r, F.lane); continue; } r -= I_GU;
        if (r < I_DN) { p0_tr(INP(I_F2WD), FF, D, WSP(bf16, WS_W2D), FF, 0, 0, 0, nullptr, scr, r, F.lane); continue; } r -= I_DN;
        if (r < I_L) { const int h = r >> 3; p0_tr(INP(I_LWA) + (size_t)h * 16384, 128, 128, WSP(bf16, WS_WL), 128, 0, h * 256, 0, nullptr, scr, r & 7, F.lane); continue; } r -= I_L;
        { const int h = r >> 3; p0_tr(INP(I_LWX) + (size_t)h * 16384, 128, 128, WSP(bf16, WS_WL), 128, 0, h * 256 + 128, 0, nullptr, scr, r & 7, F.lane); }
    }
    for (int m = gw; m < M; m += NGW) { const float* src = m < MP ? INP(I_XP) + (size_t)m * D : INP(I_XS) + (size_t)(m - MP) * D;
        row_to_bf16_ssq(src, WSP(bf16, WS_XBA) + (size_t)m * D, WSP(float, WS_SSQ) + (size_t)m * NSSQ, F.lane); }
    for (int m = gw; m < MMEM; m += NGW) row_to_bf16_ssq(INP(I_MEMP) + (size_t)m * D, WSP(bf16, WS_MEMB) + (size_t)m * D, WSP(float, WS_SSQM) + (size_t)m * NSSQ, F.lane);
    { GAS v4u* z = (GAS v4u*)(WSP(bf16, WS_WIN) + (size_t)DIN * D); const int nz = (DINP - DIN) * D * 2 / 16;
      for (int i = gw * 64 + F.lane; i < nz; i += NGW * 64) z[i] = (v4u){0u, 0u, 0u, 0u}; }
}

__device__ __forceinline__ void p5_normalize(Frame& F, const Args& A) {
    const int gw = F.vcu * NWAVES + F.wave, NGW = F.G * NWAVES, lane = F.lane;
    bf16* V = WSP(bf16, WS_V); const float* SQ = WSP(float, WS_SQV);
    for (int m = gw; m < M; m += NGW) {
        const float* sq = SQ + (size_t)m * NSQV;
        const float pl = lane < 16 ? sq[lane] : 0.f, p0 = sq[16 + lane], p1 = sq[80 + lane];
        const float rl = __builtin_amdgcn_rsqf(wave_sum(pl) * (1.0f / 2048.0f) + EPS), r0 = __builtin_amdgcn_rsqf(wave_sum(p0) * (1.0f / 1024.0f) + EPS), r1 = __builtin_amdgcn_rsqf(wave_sum(p1) * (1.0f / 1024.0f) + EPS);
        GAS v4u* row = (GAS v4u*)(V + (size_t)m * DMIX) + lane;
#pragma unroll
        for (int i = 0; i < 8; ++i) { const float rs = i < 4 ? rl : (i < 6 ? r0 : r1); v4u w = row[64 * i];
            w.x = pk2(bf2f(w.x & 0xffffu) * rs, bf2f(w.x >> 16) * rs); w.y = pk2(bf2f(w.y & 0xffffu) * rs, bf2f(w.y >> 16) * rs);
            w.z = pk2(bf2f(w.z & 0xffffu) * rs, bf2f(w.z >> 16) * rs); w.w = pk2(bf2f(w.w & 0xffffu) * rs, bf2f(w.w >> 16) * rs); row[64 * i] = w; }
    }
    const float* P = WSP(float, WS_PROJ);
    for (int it = gw; it < (NBP + NBS) * 3; it += NGW) { const int sq = it / 3, k = it % 3;
        const int row = sq < NBP ? sq * TP + TP - 3 + k : MP + (sq - NBP) * TS + TS - 3 + k;
        float* lc = sq < NBP ? F.out + O_PLC + (size_t)(sq * 3 + k) * D : F.out + O_SLC + (size_t)((sq - NBP) * 3 + k) * D;
        float* sc = sq < NBP ? F.out + O_PSC + (size_t)(sq * 3 + k) * XBC : F.out + O_SSC + (size_t)((sq - NBP) * 3 + k) * XBC;
        const float* src = P + (size_t)row * DINP;
        for (int c = lane * 4; c < D; c += 256) *(GAS f32x4*)(lc + c) = *(const GAS f32x4*)(src + C_XL + c);
        for (int c = lane * 4; c < XBC; c += 256) *(GAS f32x4*)(sc + c) = *(const GAS f32x4*)(src + C_XBC + c);
    }
}
__device__ __forceinline__ void p12_final(Frame& F, const Args& A) {
    const int gw = F.vcu * NWAVES + F.wave, NGW = F.G * NWAVES, lane = F.lane;
    const float* XR = WSP(float, WS_XR); const float* SSQ = WSP(float, WS_SSQ) + (size_t)4 * M * NSSQ; const float* g = INP(I_FING);
    for (int m = gw; m < M; m += NGW) {
        const float p = lane < 32 ? SSQ[(size_t)m * NSSQ + lane] : 0.f; const float rs = __builtin_amdgcn_rsqf(wave_sum(p) * (1.0f / 2048.0f) + EPS);
        const GAS f32x4* xr = (const GAS f32x4*)(XR + (size_t)m * D) + lane; const GAS f32x4* gg = (const GAS f32x4*)g + lane; GAS f32x4* o = (GAS f32x4*)(F.out + O_Y + (size_t)m * D) + lane;
#pragma unroll
        for (int j = 0; j < 8; ++j) o[64 * j] = xr[64 * j] * rs * gg[64 * j];
    }
}

__device__ __forceinline__ bf16x8 pack8(const f32x4 a, const f32x4 b) { v4u w; w.x = pg8::cvt_pk_bf16(a[0], a[1]); w.y = pg8::cvt_pk_bf16(a[2], a[3]); w.z = pg8::cvt_pk_bf16(b[0], b[1]); w.w = pg8::cvt_pk_bf16(b[2], b[3]); return __builtin_bit_cast(bf16x8, w); }
template <bool SAMPLE>
__device__ __forceinline__ void attn_item(Frame& F, const Args& A, int b, int h, int qt) {
    const int lane = F.lane, c16 = lane & 15, g = lane >> 4;
    const int R = SAMPLE ? MP + b * TS + (c16 & 7) : b * TP + qt * 16 + c16; const bool qvalid = SAMPLE ? (c16 < 8) : true;
    const bf16* Q = WSP(bf16, WS_Q) + (size_t)R * D + h * 512;
    bf16x8 qf[16];
#pragma unroll
    for (int ks = 0; ks < 16; ++ks) qf[ks] = *(const GAS bf16x8*)(Q + ks * 32 + 8 * g);
    f32x4 s[16];
#pragma unroll
    for (int kt = 0; kt < 16; ++kt) { s[kt] = (f32x4){0.f, 0.f, 0.f, 0.f}; const int key = kt * 16 + c16;
        if (!SAMPLE) { const bf16* kp = WSP(bf16, WS_KM) + (size_t)(b * NMEM + key) * D + h * 512 + 8 * g;
#pragma unroll
            for (int ks = 0; ks < 16; ++ks) { const bf16x8 kf = *(const GAS bf16x8*)(kp + ks * 32); s[kt] = MFMA16(kf, qf[ks], s[kt]); } }
        else { const float* kp = INP(I_CK) + (size_t)(b * NMEM + key) * D + h * 512 + 8 * g;
#pragma unroll
            for (int ks = 0; ks < 16; ++ks) { const f32x4 x0 = *(const GAS f32x4*)(kp + ks * 32), x1 = *(const GAS f32x4*)(kp + ks * 32 + 4); s[kt] = MFMA16(pack8(x0, x1), qf[ks], s[kt]); } }
    }
    float mx = -3.0e38f;
#pragma unroll
    for (int kt = 0; kt < 16; ++kt) mx = fmaxf(mx, fmaxf(fmaxf(s[kt][0], s[kt][1]), fmaxf(s[kt][2], s[kt][3])));
    mx = fmaxf(mx, __shfl_xor(mx, 16)); mx = fmaxf(mx, __shfl_xor(mx, 32));
    float sum = 0.f;
#pragma unroll
    for (int kt = 0; kt < 16; ++kt) {
#pragma unroll
        for (int j = 0; j < 4; ++j) { const float e = __expf(s[kt][j] - mx); s[kt][j] = e; sum += e; } }
    sum += __shfl_xor(sum, 16); sum += __shfl_xor(sum, 32);
    const float inv = 1.0f / sum;
    bf16x8 pf[8];
#pragma unroll
    for (int kk = 0; kk < 8; ++kk) pf[kk] = pack8(s[2 * kk], s[2 * kk + 1]);
    bf16* O = WSP(bf16, WS_O) + (size_t)R * D + h * 512 + 4 * g;
    for (int dt = 0; dt < 32; ++dt) { const int d = dt * 16 + c16; f32x4 o = (f32x4){0.f, 0.f, 0.f, 0.f};
        if (!SAMPLE) { const bf16* vp = WSP(bf16, WS_VT) + (size_t)(b * D + h * 512 + d) * NMEM + 4 * g;
#pragma unroll
            for (int kk = 0; kk < 8; ++kk) { const v2u lo = *(const GAS v2u*)(vp + kk * 32), hi = *(const GAS v2u*)(vp + kk * 32 + 16); v4u w; w.x = lo.x; w.y = lo.y; w.z = hi.x; w.w = hi.y;
                o = MFMA16(__builtin_bit_cast(bf16x8, w), pf[kk], o); } }
        else { const float* vp = INP(I_CV) + (size_t)(b * NMEM + 4 * g) * D + h * 512 + d;
#pragma unroll
            for (int kk = 0; kk < 8; ++kk) { const float* v0 = vp + (size_t)(kk * 32) * D; f32x4 x0, x1;
                x0[0] = v0[0]; x0[1] = v0[D]; x0[2] = v0[2 * D]; x0[3] = v0[3 * D]; x1[0] = v0[16 * D]; x1[1] = v0[17 * D]; x1[2] = v0[18 * D]; x1[3] = v0[19 * D];
                o = MFMA16(pack8(x0, x1), pf[kk], o); } }
        o = o * inv;
        if (qvalid) { v2u w; w.x = pg8::cvt_pk_bf16(o[0], o[1]); w.y = pg8::cvt_pk_bf16(o[2], o[3]); *(GAS v2u*)(O + dt * 16) = w; }
    }
}
__device__ __forceinline__ void p8_attention(Frame& F, const Args& A) {
    const int f = F.wave * F.G + F.vcu, NF = F.G * NWAVES;
    for (int it = f; it < NBS * 4; it += NF) attn_item<true>(F, A, it >> 2, it & 3, 0);
    for (int it = f; it < NBP * 4 * (TP / 16); it += NF) attn_item<false>(F, A, it >> 9, (it >> 7) & 3, it & 127);
}

__device__ __forceinline__ float conv4(const float* cur, int t, const float* st, int sp, float w0, float w1, float w2, float w3, float bias) {
    const float x3 = cur[0];
    const float x2 = t >= 1 ? cur[-(ptrdiff_t)DINP] : (st ? st[2 * sp] : 0.f);
    const float x1 = t >= 2 ? cur[-(ptrdiff_t)2 * DINP] : (st ? st[(t + 1) * sp] : 0.f);
    const float x0 = t >= 3 ? cur[-(ptrdiff_t)3 * DINP] : (st ? st[t * sp] : 0.f);
    return bias + w0 * x0 + w1 * x1 + w2 * x2 + w3 * x3;
}
constexpr int LR_U32 = 0, LR_A32 = 32768, LR_UB = 65536, LR_UBP = 136;
template <bool SAMPLE>
__device__ __forceinline__ void lru_item(Frame& F, const Args& A, int sidx, int h) {
    LAS float* U32 = (LAS float*)(F.lds + LR_U32); LAS float* A32 = (LAS float*)(F.lds + LR_A32); LAS bf16* UB = (LAS bf16*)(F.lds + LR_UB);
    const int tid = F.tid, lane = F.lane, w = F.wave, c16 = lane & 15, g = lane >> 4;
    const float* P = WSP(float, WS_PROJ);
    const bf16* WL = WSP(bf16, WS_WL) + (size_t)h * 256 * 128;
    bf16x8 ba[4], bx[4];
#pragma unroll
    for (int ks = 0; ks < 4; ++ks) { ba[ks] = *(const GAS bf16x8*)(WL + (size_t)(16 * w + c16) * 128 + ks * 32 + 8 * g); bx[ks] = *(const GAS bf16x8*)(WL + (size_t)(128 + 16 * w + c16) * 128 + ks * 32 + 8 * g); }
    const int mcol = 16 * w + c16, mch = h * 128 + mcol;
    const float b_a = INP(I_LBA)[mch], b_x = INP(I_LBX)[mch], cl = -8.0f * softplus_f(-INP(I_LLAM)[mch]);
    const int tq = w >> 1, cc = (w & 1) * 64 + lane, ch = h * 128 + cc;
    const unsigned voffx = (unsigned)(C_XL + ch) * 4u, voffg = (unsigned)(C_GL + h * 128 + 2 * lane) * 4u;
    const float cw0 = INP(I_LCW)[ch], cw1 = INP(I_LCW)[D + ch], cw2 = INP(I_LCW)[2 * D + ch], cw3 = INP(I_LCW)[3 * D + ch], cb = INP(I_LCB)[ch];
    float hstate = 0.f;
    const int nchunk = SAMPLE ? 1 : TP / 64;
    float raw[22];
#define LDG_F32(base_, voff_) (*(const GAS float*)((const GAS char*)(base_) + (voff_)))
#define LRU_ISSUE(chunk_) do { \
        if (SAMPLE) { \
            _Pragma("unroll") for (int q = 0; q < 2; ++q) { const int sq_ = sidx * 8 + tq * 2 + q; \
                _Pragma("unroll") for (int k = 0; k < 3; ++k) raw[q * 11 + k] = LDG_F32(INP(I_SLC) + (size_t)(sq_ * 3 + k) * D, (unsigned)ch * 4u); \
                _Pragma("unroll") for (int t = 0; t < 8; ++t) raw[q * 11 + 3 + t] = LDG_F32(P + (size_t)(MP + sq_ * 8 + t) * DINP, voffx); } \
        } else { \
            const int R0_ = sidx * TP + (chunk_) * 64 + tq * 16; \
            _Pragma("unroll") for (int i = 0; i < 19; ++i) { const bool ok = ((chunk_) > 0 || tq > 0 || i >= 3); raw[i] = ok ? LDG_F32(P + (size_t)(R0_ - 3 + i) * DINP, voffx) : 0.f; } \
        } } while (0)
    LRU_ISSUE(0);
    for (int chunk = 0; chunk < nchunk; ++chunk) {
        int ln_ = lane; asm volatile("" : "+v"(ln_));
        const int lane = ln_, c16 = lane & 15, g = lane >> 4, cc = (w & 1) * 64 + lane, mcol = 16 * w + c16;
        const int R0 = SAMPLE ? MP + sidx * 64 : sidx * TP + chunk * 64;
        f32x2 gg[8];
#pragma unroll
        for (int i = 0; i < 8; ++i) gg[i] = *(const GAS f32x2*)((const GAS char*)(P + (size_t)(R0 + 8 * w + i) * DINP) + voffg);
#pragma unroll
        for (int i = 0; i < 16; ++i) { const int r = tq * 16 + i; const int o = SAMPLE ? (i >> 3) * 11 + (i & 7) : i;
            const float u = cb + cw0 * raw[o] + cw1 * raw[o + 1] + cw2 * raw[o + 2] + cw3 * raw[o + 3];
            U32[r * 128 + cc] = u; UB[r * LR_UBP + cc] = (bf16)f2bf(u); }
        if (chunk + 1 < nchunk) LRU_ISSUE(chunk + 1);
        __syncthreads();
        f32x4 ra[4], rx[4];
#pragma unroll
        for (int m = 0; m < 4; ++m) { ra[m] = (f32x4){0.f, 0.f, 0.f, 0.f}; rx[m] = (f32x4){0.f, 0.f, 0.f, 0.f};
#pragma unroll
            for (int ks = 0; ks < 4; ++ks) { const bf16x8 af = *(const LAS bf16x8*)(UB + (16 * m + c16) * LR_UBP + ks * 32 + 8 * g); ra[m] = MFMA16(af, ba[ks], ra[m]); rx[m] = MFMA16(af, bx[ks], rx[m]); } }
#pragma unroll
        for (int m = 0; m < 4; ++m)
#pragma unroll
            for (int j = 0; j < 4; ++j) { const int r = 16 * m + 4 * g + j; const float rr = sigmoid_f(ra[m][j] + b_a), ii = sigmoid_f(rx[m][j] + b_x), la = cl * rr;
                const float a = __expf(la), mult = sqrtf(-expm1f(2.0f * la)); const float u = U32[r * 128 + mcol]; A32[r * 128 + mcol] = a; U32[r * 128 + mcol] = mult * ii * u; }
        __syncthreads();
        if (tid < 128) {
#pragma unroll 8
            for (int r = 0; r < 64; ++r) {
                if (SAMPLE && (r & 7) == 0) hstate = INP(I_SLH)[(size_t)(sidx * 8 + (r >> 3)) * D + h * 128 + tid];
                hstate = A32[r * 128 + tid] * hstate + U32[r * 128 + tid]; U32[r * 128 + tid] = hstate;
                if (SAMPLE && (r & 7) == 7) F.out[O_SLH + (size_t)(sidx * 8 + (r >> 3)) * D + h * 128 + tid] = hstate; }
            if (!SAMPLE && chunk == nchunk - 1) F.out[O_PLH + (size_t)sidx * D + h * 128 + tid] = hstate;
        }
        __syncthreads();
#pragma unroll
        for (int i = 0; i < 8; ++i) { const int r = 8 * w + i, R = R0 + r;
            const float h0 = U32[r * 128 + 2 * lane], h1 = U32[r * 128 + 2 * lane + 1];
            const float v0 = h0 * gelu_tanh_f(gg[i].x), v1 = h1 * gelu_tanh_f(gg[i].y);
            *(GAS unsigned*)(WSP(bf16, WS_V) + (size_t)R * DMIX + h * 128 + 2 * lane) = pk2(v0, v1);
            const float q = wave_sum(v0 * v0 + v1 * v1); if (lane == 0) WSP(float, WS_SQV)[(size_t)R * NSQV + h] = q; }
        __syncthreads();
    }
}
constexpr int SD_CS = 0, SD_DT = 256, SD_WG = 512, SD_CM = 1024, SD_BM = 18432, SD_BT = 35840, SD_XT = 54272, SD_XS = 63488, SD_HB = 72704, SD_XF = 90112;
constexpr int SP136 = 136, SP72 = 72, SP68 = 68;
template <int L  >
__device__ __forceinline__ void ssd_item(Frame& F, const Args& A, int sq, int head) {
    constexpr bool SAMPLE = (L == 16); constexpr int LT = L / 16, KK = (L + 31) / 32, TV = SAMPLE ? TS : L;
    LAS float* CS = (LAS float*)(F.lds + SD_CS); LAS float* DT = (LAS float*)(F.lds + SD_DT); LAS float* WG = (LAS float*)(F.lds + SD_WG);
    LAS bf16* CM = (LAS bf16*)(F.lds + SD_CM); LAS bf16* BM = (LAS bf16*)(F.lds + SD_BM); LAS bf16* BT = (LAS bf16*)(F.lds + SD_BT);
    LAS bf16* XT = (LAS bf16*)(F.lds + SD_XT); LAS bf16* XS = (LAS bf16*)(F.lds + SD_XS); LAS bf16* HB = (LAS bf16*)(F.lds + SD_HB); LAS float* XF = (LAS float*)(F.lds + SD_XF);
    const int tid = F.tid, lane = F.lane, w = F.wave, c16 = lane & 15, g = lane >> 4, grp = head >> 4;
    const float* P = WSP(float, WS_PROJ);
    const float Aneg = -__expf(INP(I_SALOG)[head]), dtb = INP(I_SDTB)[head], Dh = INP(I_SD)[head];
    const int hpt = w & 3, hnt0 = 4 * (w >> 2);
    f32x4 Hacc[4];
    const size_t hbase = ((size_t)(sq * SSD_H + head) * SSD_P) * SSD_N;
#pragma unroll
    for (int i = 0; i < 4; ++i)
#pragma unroll
        for (int j = 0; j < 4; ++j) Hacc[i][j] = SAMPLE ? INP(I_SSH)[hbase + (size_t)(16 * hpt + 4 * g + j) * SSD_N + 16 * (hnt0 + i) + c16] : 0.f;
    const int cgb = lane, rbb = w, gx = lane & 15, rsub = lane >> 4, rp = 4 * w + rsub;
    const int xcb = 2048 + (cgb >> 5) * 256 + grp * 128 + 4 * (cgb & 31), xcx = head * 64 + 4 * gx;
    const bool actB = SAMPLE ? (w < 2) : true, actX = SAMPLE ? (w < 2) : true;
    const unsigned voffb = (unsigned)(C_XBC + xcb) * 4u, voffxx = (unsigned)(rsub * 2 * DINP + C_XBC + xcx) * 4u, voffxs = (unsigned)(rsub * 2 * XBC + xcx) * 4u;
    f32x4 wB[4], wX[4], bB, bX;
#pragma unroll
    for (int k = 0; k < 4; ++k) { wB[k] = *(const GAS f32x4*)(INP(I_SCW) + (size_t)k * XBC + xcb); wX[k] = *(const GAS f32x4*)(INP(I_SCW) + (size_t)k * XBC + xcx); }
    bB = *(const GAS f32x4*)(INP(I_SCB) + xcb); bX = *(const GAS f32x4*)(INP(I_SCB) + xcx);
    f32x4 rawB[11], rawX[5]; float rawdt = 0.f;
#define SSD_LDROW(dst_, chunk_, rr_, rl_, vp_, vs_) do { const int rr__ = (rr_); const int tu__ = SAMPLE ? rr__ : (chunk_) * 64 + rr__; const int tl__ = SAMPLE ? (rl_) : (chunk_) * 64 + (rl_); \
        const GAS char* pb__ = (const GAS char*)(P + (size_t)((SAMPLE ? MP + sq * TS : sq * TP + (chunk_) * 64) + rr__) * DINP); \
        const GAS char* sb__ = (const GAS char*)(INP(I_SSC) + (size_t)(sq * 3 + 3 + tu__) * XBC); \
        if ((rl_) >= TV) dst_ = (f32x4){0.f, 0.f, 0.f, 0.f}; \
        else if (tl__ >= 0) dst_ = *(const GAS f32x4*)(pb__ + (vp_)); \
        else if (SAMPLE) dst_ = *(const GAS f32x4*)(sb__ + (vs_)); \
        else dst_ = (f32x4){0.f, 0.f, 0.f, 0.f}; } while (0)
#define SSD_ISSUE(chunk_) do { \
        if (actB) { _Pragma("unroll") for (int i = 0; i < 11; ++i) SSD_LDROW(rawB[i], chunk_, 8 * rbb - 3 + i, 8 * rbb - 3 + i, voffb, (unsigned)xcb * 4u); } \
        if (actX) { _Pragma("unroll") for (int i = 0; i < 5; ++i) SSD_LDROW(rawX[i], chunk_, 8 * w - 3 + i, 2 * rp - 3 + i, voffxx, voffxs); } \
        if (w == 0) { const int r_ = lane; const int R_ = SAMPLE ? MP + sq * TS + r_ : sq * TP + (chunk_) * 64 + r_; rawdt = (r_ < TV) ? P[(size_t)R_ * DINP + C_DT + head] : 0.f; } } while (0)
    SSD_ISSUE(0);
#pragma unroll
    for (int i = 0; i < 4; ++i)
#pragma unroll
        for (int j = 0; j < 4; ++j) HB[(16 * hpt + 4 * g + j) * SP136 + 16 * (hnt0 + i) + c16] = (bf16)f2bf(Hacc[i][j]);
    if (SAMPLE) {
        for (int e = tid; e < 64 * 16; e += 512) { const int p = e >> 4, c = 16 + (e & 15); XT[p * SP72 + c] = 0; XS[p * SP72 + c] = 0; }
        for (int e = tid; e < 128 * 16; e += 512) { const int n = e >> 4, c = 16 + (e & 15); BT[n * SP72 + c] = 0; }
    }
    const int nchunk = SAMPLE ? 1 : TP / 64;
    for (int chunk = 0; chunk < nchunk; ++chunk) {
        int ln_ = lane; asm volatile("" : "+v"(ln_));
        const int lane = ln_, c16 = lane & 15, g = lane >> 4, cgb = lane, gx = lane & 15, rsub = lane >> 4, rp = 4 * w + rsub;
        const int R0 = SAMPLE ? MP + sq * TS : sq * TP + chunk * 64;
        const int lt_ = (L == 64) ? (w & 3) : 0, l_ = 16 * lt_ + c16; constexpr int NPT = (L == 64) ? 2 : 1; const int pt0_ = (L == 64) ? 2 * (w >> 2) : (w & 3);
        f32x4 z4[NPT];
#pragma unroll
        for (int pi = 0; pi < NPT; ++pi) { z4[pi] = (f32x4){0.f, 0.f, 0.f, 0.f}; if (l_ < TV) z4[pi] = *(const GAS f32x4*)(P + (size_t)(R0 + l_) * DINP + C_Z + head * 64 + 16 * (pt0_ + pi) + 4 * g); }
        if (actB) {
#pragma unroll
            for (int i = 0; i < 8; ++i) { const int r = 8 * rbb + i; f32x4 v = bB + wB[0] * rawB[i] + wB[1] * rawB[i + 1] + wB[2] * rawB[i + 2] + wB[3] * rawB[i + 3];
                if (r >= TV) v = (f32x4){0.f, 0.f, 0.f, 0.f}; else { v[0] = siluf_(v[0]); v[1] = siluf_(v[1]); v[2] = siluf_(v[2]); v[3] = siluf_(v[3]); }
                v2u pk; pk.x = pk2(v[0], v[1]); pk.y = pk2(v[2], v[3]); const int n = 4 * (cgb & 31);
                if (cgb < 32) { *(LAS v2u*)(BM + r * SP136 + n) = pk; BT[(n + 0) * SP72 + r] = (bf16)(pk.x & 0xffffu); BT[(n + 1) * SP72 + r] = (bf16)(pk.x >> 16); BT[(n + 2) * SP72 + r] = (bf16)(pk.y & 0xffffu); BT[(n + 3) * SP72 + r] = (bf16)(pk.y >> 16); }
                else *(LAS v2u*)(CM + r * SP136 + n) = pk; } }
        if (actX) {
#pragma unroll
            for (int i = 0; i < 2; ++i) { const int r = 2 * rp + i; f32x4 v = bX + wX[0] * rawX[i] + wX[1] * rawX[i + 1] + wX[2] * rawX[i + 2] + wX[3] * rawX[i + 3];
                if (r >= TV) v = (f32x4){0.f, 0.f, 0.f, 0.f}; else { v[0] = siluf_(v[0]); v[1] = siluf_(v[1]); v[2] = siluf_(v[2]); v[3] = siluf_(v[3]); }
                *(LAS f32x4*)(XF + r * SP68 + 4 * gx) = v; const unsigned p0 = pk2(v[0], v[1]), p1 = pk2(v[2], v[3]); const int p = 4 * gx;
                XT[(p + 0) * SP72 + r] = (bf16)(p0 & 0xffffu); XT[(p + 1) * SP72 + r] = (bf16)(p0 >> 16); XT[(p + 2) * SP72 + r] = (bf16)(p1 & 0xffffu); XT[(p + 3) * SP72 + r] = (bf16)(p1 >> 16); } }
        if (w == 0) { const int r = lane; float dt = 0.f;
            if (r < TV) dt = softplus_f(rawdt + dtb);
            float cs = dt * Aneg;
#pragma unroll
            for (int o = 1; o < 64; o <<= 1) { const float up = __shfl_up(cs, o); if (lane >= o) cs += up; }
            const float csl = __shfl(cs, L - 1);
            if (r < L) { CS[r] = cs; DT[r] = dt; WG[r] = __expf(csl - cs) * dt; } }
        if (chunk + 1 < nchunk) SSD_ISSUE(chunk + 1);
        __syncthreads();
        for (int e = tid; e < 64 * L; e += 512) { const int p = e & 63, l = e >> 6; XS[p * SP72 + l] = (bf16)f2bf(XF[l * SP68 + p] * WG[l]); }
        __syncthreads();
        if (L == 64 || w < 4) {
            const int l = l_, pt0 = pt0_;
            bf16x8 cf[4];
#pragma unroll
            for (int ks = 0; ks < 4; ++ks) cf[ks] = *(const LAS bf16x8*)(CM + l * SP136 + ks * 32 + 8 * g);
            const float cs_l = CS[l];
            f32x4 gt[2 * KK];
#pragma unroll
            for (int st = 0; st < 2 * KK; ++st) { gt[st] = (f32x4){0.f, 0.f, 0.f, 0.f};
                if (st < LT) {
#pragma unroll
                    for (int ks = 0; ks < 4; ++ks) { const bf16x8 af = *(const LAS bf16x8*)(BM + (16 * st + c16) * SP136 + ks * 32 + 8 * g); gt[st] = MFMA16(af, cf[ks], gt[st]); }
#pragma unroll
                    for (int j = 0; j < 4; ++j) { const int s = 16 * st + 4 * g + j; gt[st][j] = (s <= l) ? gt[st][j] * __expf(cs_l - CS[s]) * DT[s] : 0.f; } } }
            bf16x8 wf[KK];
#pragma unroll
            for (int kk = 0; kk < KK; ++kk) wf[kk] = pack8(gt[2 * kk], gt[2 * kk + 1]);
            const float ecl = __expf(cs_l); const bool valid = (l < TV); const int R = R0 + l;
#pragma unroll
            for (int pi = 0; pi < NPT; ++pi) { const int pt = pt0 + pi; f32x4 a1 = (f32x4){0.f, 0.f, 0.f, 0.f}, a2 = (f32x4){0.f, 0.f, 0.f, 0.f};
#pragma unroll
                for (int kk = 0; kk < KK; ++kk) { const v2u lo = *(const LAS v2u*)(XT + (16 * pt + c16) * SP72 + 32 * kk + 4 * g), hi = *(const LAS v2u*)(XT + (16 * pt + c16) * SP72 + 32 * kk + 16 + 4 * g);
                    v4u wv; wv.x = lo.x; wv.y = lo.y; wv.z = hi.x; wv.w = hi.y; a1 = MFMA16(__builtin_bit_cast(bf16x8, wv), wf[kk], a1); }
#pragma unroll
                for (int ks = 0; ks < 4; ++ks) { const bf16x8 af = *(const LAS bf16x8*)(HB + (16 * pt + c16) * SP136 + ks * 32 + 8 * g); a2 = MFMA16(af, cf[ks], a2); }
                const f32x4 x4 = *(const LAS f32x4*)(XF + l * SP68 + 16 * pt + 4 * g);
                float v[4], q = 0.f;
#pragma unroll
                for (int j = 0; j < 4; ++j) { const float y = a1[j] + ecl * a2[j] + Dh * x4[j]; v[j] = y * siluf_(z4[pi][j]); q += v[j] * v[j]; }
                q += __shfl_xor(q, 16); q += __shfl_xor(q, 32);
                if (valid) { v2u o; o.x = pk2(v[0], v[1]); o.y = pk2(v[2], v[3]); *(GAS v2u*)(WSP(bf16, WS_V) + (size_t)R * DMIX + 2048 + head * 64 + 16 * pt + 4 * g) = o;
                    if (g == 0) WSP(float, WS_SQV)[(size_t)R * NSQV + 16 + head * 4 + pt] = q; } }
        }
        __syncthreads();
        { const float dec = __expf(CS[L - 1]);
#pragma unroll
          for (int i = 0; i < 4; ++i) Hacc[i] = Hacc[i] * dec;
#pragma unroll
          for (int kk = 0; kk < KK; ++kk) { const bf16x8 af = *(const LAS bf16x8*)(XS + (16 * hpt + c16) * SP72 + 32 * kk + 8 * g);
#pragma unroll
              for (int i = 0; i < 4; ++i) { const bf16x8 bfr = *(const LAS bf16x8*)(BT + (16 * (hnt0 + i) + c16) * SP72 + 32 * kk + 8 * g); Hacc[i] = MFMA16(af, bfr, Hacc[i]); } }
          if (chunk + 1 < nchunk) {
#pragma unroll
              for (int i = 0; i < 4; ++i)
#pragma unroll
                  for (int j = 0; j < 4; ++j) HB[(16 * hpt + 4 * g + j) * SP136 + 16 * (hnt0 + i) + c16] = (bf16)f2bf(Hacc[i][j]); } }
        __syncthreads();
    }
    float* ho = F.out + (SAMPLE ? O_SSH : O_PSH) + hbase;
#pragma unroll
    for (int i = 0; i < 4; ++i)
#pragma unroll
        for (int j = 0; j < 4; ++j) ho[(size_t)(16 * hpt + 4 * g + j) * SSD_N + 16 * (hnt0 + i) + c16] = Hacc[i][j];
}
__device__ __forceinline__ void p4_mixer(Frame& F, const Args& A, int qoff) {
    const int bid = blockIdx.x;
    for (int it = bid; it < 64 + 128; it += F.G) {
        if (it < 64) lru_item<false>(F, A, it >> 4, it & 15); else ssd_item<64>(F, A, (it - 64) >> 5, (it - 64) & 31);
    }
    for (;;) {
        __syncthreads();
        if (F.tid == 0) F.MISC[0] = __hip_atomic_fetch_add(F.ctl + CW_QUEUE + qoff, 1u, RLX_AGENT);
        __syncthreads();
        const int it = (int)F.MISC[0];
        if (it >= 256 + NBS * SSD_H) break;
        if (it < 256) lru_item<true>(F, A, it >> 4, it & 15); else ssd_item<16>(F, A, (it - 256) >> 5, (it - 256) & 31);
    }
}

#ifndef DUP_PHASE
#define DUP_PHASE -1
#endif
#ifndef MK_PER_PHASE
#define MK_PER_PHASE 0
#endif
constexpr int N_PHASES = 13;
template <class Epi> __device__ __forceinline__ void run_gemm(Frame& F, const bf16* Aop, const bf16* Bt, int Mr, int N, int K, const Epi& E, int c) {
    pg8::Gemm g{Aop, Bt, Mr, N, K}; pg8::StaticOrder S; S.init(Mr, N, F.G, c);
    pg8::gemm_phase<Epi, pg8::StaticOrder, PG8_ALIGN, PG8_SP2>(F.lds + RING_OFF, g, S, E);
}
__global__ void __launch_bounds__(NWAVES * 64, 2) hymba_fwd(Args args) {
    extern __shared__ __attribute__((aligned(16))) unsigned char lds[];
    const Args& A = args;
    Frame F;
    F.lds = (LAS unsigned char*)lds;
    F.MISC = (volatile LAS unsigned*)(F.lds + MISC_OFF);
    F.tid = threadIdx.x; F.lane = F.tid & 63; F.wave = __builtin_amdgcn_readfirstlane(F.tid >> 6);
    F.G = gridDim.x; { const int bx = blockIdx.x; F.vcu = (F.G % 8 == 0) ? (bx % 8) * (F.G / 8) + bx / 8 : bx; }
    F.ws = args.ws; F.out = args.out; F.ctl = (gu32*)(args.ws + WS_CTL);
    for (int u = F.tid; u < (LDS_BYTES - LDSCTL_OFF) / 4; u += NWAVES * 64) ((LAS unsigned*)(F.lds + LDSCTL_OFF))[u] = 0u;
    __syncthreads();
    XcdBarrier bar; bar.bar = (unsigned*)(F.ctl + CW_BAR); bar.x = 0; bar.st = nullptr;
    if (!MK_PER_PHASE) bar = xcd_barrier_post((unsigned*)(F.ctl + CW_BAR), F.MISC + 8);
#define GRID_BAR() do { if (!MK_PER_PHASE) xcd_barrier(bar); } while (0)
    const int lo = args.ph_lo, hi = args.ph_hi;
#define IN(k) (lo <= (k) && (k) < hi)
#define BOTH(k) (IN(k) && IN((k) + 1))
    const int bid = blockIdx.x;
    float* SSQ0 = WSP(float, WS_SSQ); float* SSQ1 = SSQ0 + (size_t)M * NSSQ; float* SSQ2 = SSQ1 + (size_t)M * NSSQ; float* SSQ3 = SSQ2 + (size_t)M * NSSQ; float* SSQ4 = SSQ3 + (size_t)M * NSSQ;

    if (IN(0)) { p0_prologue(F, A); if (BOTH(0)) GRID_BAR(); }
#if DUP_PHASE == 0
    { p0_prologue(F, A); GRID_BAR(); }
#endif
    if (IN(1)) {
        { pg8::EpiSwiglu E{WSP(bf16, WS_ACT), FF, SSQ0}; run_gemm(F, WSP(bf16, WS_XBA), WSP(bf16, WS_W1GU), M, NGU, D, E, bid); }
        { pg8::EpiKV E{F.out + O_PMK, F.out + O_PMV, WSP(bf16, WS_KM), WSP(bf16, WS_VT), WSP(float, WS_SSQM)}; run_gemm(F, WSP(bf16, WS_MEMB), WSP(bf16, WS_WKV), MMEM, 2 * D, D, E, (bid + F.G - (F.G * 3) / 4) % F.G); }
        if (BOTH(1)) GRID_BAR(); }
    if (IN(2)) {
        pg8::EpiRes<true, true> E{INP(I_XP), INP(I_XS), WSP(float, WS_XR), WSP(bf16, WS_XBB), SSQ1, 0.5f}; run_gemm(F, WSP(bf16, WS_ACT), WSP(bf16, WS_W1D), M, D, FF, E, bid);
        if (BOTH(2)) GRID_BAR(); }
    if (IN(3)) {
        pg8::EpiProj E{WSP(float, WS_PROJ), DINP, SSQ1}; run_gemm(F, WSP(bf16, WS_XBB), WSP(bf16, WS_WIN), M, DINP, D, E, bid);
        if (BOTH(3)) GRID_BAR(); }
    if (IN(4)) { p4_mixer(F, A, 0); if (BOTH(4)) GRID_BAR(); }
#if DUP_PHASE == 4
    { p4_mixer(F, A, 64); GRID_BAR(); }
#endif
    if (IN(5)) { p5_normalize(F, A); if (BOTH(5)) GRID_BAR(); }
    if (IN(6)) {
        pg8::EpiRes<false, true> E{nullptr, nullptr, WSP(float, WS_XR), WSP(bf16, WS_XBA), SSQ2, 1.0f}; run_gemm(F, WSP(bf16, WS_V), WSP(bf16, WS_WOUT), M, D, DMIX, E, bid);
        if (BOTH(6)) GRID_BAR(); }
    if (IN(7)) {
        pg8::EpiQ E{WSP(bf16, WS_Q), SSQ2, 0.04419417382415922f}; run_gemm(F, WSP(bf16, WS_XBA), WSP(bf16, WS_WQ), M, D, D, E, bid);
        if (BOTH(7)) GRID_BAR(); }
    if (IN(8)) { p8_attention(F, A); if (BOTH(8)) GRID_BAR(); }
#if DUP_PHASE == 8
    { p8_attention(F, A); GRID_BAR(); }
#endif
    if (IN(9)) {
        pg8::EpiRes<false, true> E{nullptr, nullptr, WSP(float, WS_XR), WSP(bf16, WS_XBB), SSQ3, 1.0f}; run_gemm(F, WSP(bf16, WS_O), WSP(bf16, WS_WO), M, D, D, E, bid);
        if (BOTH(9)) GRID_BAR(); }
    if (IN(10)) {
        pg8::EpiSwiglu E{WSP(bf16, WS_ACT), FF, SSQ3}; run_gemm(F, WSP(bf16, WS_XBB), WSP(bf16, WS_W2GU), M, NGU, D, E, bid);
        if (BOTH(10)) GRID_BAR(); }
    if (IN(11)) {
        pg8::EpiRes<false, false> E{nullptr, nullptr, WSP(float, WS_XR), nullptr, SSQ4, 0.5f}; run_gemm(F, WSP(bf16, WS_ACT), WSP(bf16, WS_W2D), M, D, FF, E, bid);
        if (BOTH(11)) GRID_BAR(); }
    if (IN(12)) { p12_final(F, A); }
#undef IN
#undef BOTH
}

extern "C" void kernel_launch(void* const* d_in, const int* in_sizes, int n_in, void* d_out, int out_size, void* d_ws, size_t ws_size, hipStream_t stream) {
    static int grid = 0;
    if (grid == 0) {
        if (n_in != N_IN || (size_t)out_size != O_END || ws_size < WS_END) { fprintf(stderr, "kernel_launch: shape mismatch: n_in %d out %d ws %zu (need %zu)\n", n_in, out_size, ws_size, (size_t)WS_END); grid = -1; return; }
        int dev = 0, cus = 0, per_cu = 0;
        if (hipGetDevice(&dev) != hipSuccess || hipDeviceGetAttribute(&cus, hipDeviceAttributeMultiprocessorCount, dev) != hipSuccess) { grid = -1; return; }
        if (hipFuncSetAttribute((const void*)hymba_fwd, hipFuncAttributeMaxDynamicSharedMemorySize, LDS_BYTES) != hipSuccess) { fprintf(stderr, "kernel_launch: hipFuncSetAttribute failed\n"); grid = -1; return; }
        if (hipOccupancyMaxActiveBlocksPerMultiprocessor(&per_cu, (const void*)hymba_fwd, NWAVES * 64, LDS_BYTES) != hipSuccess || per_cu < 1) { fprintf(stderr, "kernel_launch: occupancy query says %d blocks per CU\n", per_cu); (void)hipGetLastError(); grid = -1; return; }
        grid = cus;
    }
    if (grid < 0) return;
    if (hipMemsetAsync((char*)d_ws + WS_CTL, 0, CTL_ZERO_BYTES, stream) != hipSuccess) return;
    Args a{};
    for (int i = 0; i < N_IN; ++i) a.in[i] = (const float*)d_in[i];
    a.out = (float*)d_out; a.ws = (unsigned char*)d_ws;
#if MK_PER_PHASE
    for (int p = 0; p < N_PHASES; ++p) { a.ph_lo = p; a.ph_hi = p + 1; hipLaunchKernelGGL(hymba_fwd, dim3(grid), dim3(NWAVES * 64), LDS_BYTES, stream, a); }
#else
    a.ph_lo = 0; a.ph_hi = N_PHASES; hipLaunchKernelGGL(hymba_fwd, dim3(grid), dim3(NWAVES * 64), LDS_BYTES, stream, a);
#endif
}
```

```cpp
#include <hip/hip_runtime.h>
#include <cstdio>
#include <cstdint>

constexpr int NWAVES = 8;
constexpr int D = 2048, MP = 8192, MS = 1024, M = MP + MS, TP = 2048, TS = 8, NBP = 4, NBS = 128;
constexpr int FF = 5632, NGU = 2 * FF, DIN = 8736, DINP = 8960, DMIX = 4096, NMEM = 256, MMEM = NBP * NMEM;
constexpr int LRU_H = 16, LRU_B = 128, SSD_H = 32, SSD_P = 64, SSD_N = 128, XBC = 2560;
constexpr int C_XL = 0, C_GL = 2048, C_Z = 4096, C_XBC = 6144, C_DT = 8704;
constexpr float EPS = 1e-6f;
constexpr int NSSQ = 32;
constexpr int NSQV = 144;
constexpr size_t O_Y = 0, O_PLC = (size_t)M * D, O_PLH = O_PLC + (size_t)NBP * 3 * D, O_PSC = O_PLH + (size_t)NBP * D, O_PSH = O_PSC + (size_t)NBP * 3 * XBC,
                 O_PMK = O_PSH + (size_t)NBP * SSD_H * SSD_P * SSD_N, O_PMV = O_PMK + (size_t)MMEM * D, O_SLC = O_PMV + (size_t)MMEM * D, O_SLH = O_SLC + (size_t)NBS * 3 * D,
                 O_SSC = O_SLH + (size_t)NBS * D, O_SSH = O_SSC + (size_t)NBS * 3 * XBC, O_END = O_SSH + (size_t)NBS * SSD_H * SSD_P * SSD_N;
static_assert(O_END == 59766784, "d_out size");
enum { I_XP = 0, I_MEMP, I_XS, I_CK, I_CV, I_SLC, I_SLH, I_SSC, I_SSH, I_F1G, I_F1WG, I_F1WU, I_F1WD, I_MIXG, I_WIN, I_LCW, I_LCB, I_LWA, I_LBA, I_LWX, I_LBX, I_LLAM, I_LOG,
       I_SCW, I_SCB, I_SDTB, I_SALOG, I_SD, I_SOG, I_WOUT, I_XAG, I_MEMG, I_WQ, I_WK, I_WV, I_WO, I_F2G, I_F2WG, I_F2WU, I_F2WD, I_FING, N_IN };
static_assert(N_IN == 41, "inputs");

constexpr size_t MiB = 1u << 20;
constexpr size_t al(size_t x) { return (x + 4095) & ~(size_t)4095; }
constexpr size_t WS_CTL = 0, CTL_ZERO_BYTES = 1 * MiB;
constexpr size_t WS_W1GU = 2 * MiB;
constexpr size_t WS_W1D  = WS_W1GU + al((size_t)NGU * D * 2);
constexpr size_t WS_WIN  = WS_W1D + al((size_t)D * FF * 2);
constexpr size_t WS_WOUT = WS_WIN + al((size_t)DINP * D * 2);
constexpr size_t WS_WQ   = WS_WOUT + al((size_t)D * DMIX * 2);
constexpr size_t WS_WKV  = WS_WQ + al((size_t)D * D * 2);
constexpr size_t WS_WO   = WS_WKV + al((size_t)2 * D * D * 2);
constexpr size_t WS_W2GU = WS_WO + al((size_t)D * D * 2);
constexpr size_t WS_W2D  = WS_W2GU + al((size_t)NGU * D * 2);
constexpr size_t WS_WL   = WS_W2D + al((size_t)D * FF * 2);
constexpr size_t WS_XBA  = WS_WL + al((size_t)LRU_H * 256 * 128 * 2);
constexpr size_t WS_XBB  = WS_XBA + al((size_t)M * D * 2);
constexpr size_t WS_MEMB = WS_XBB + al((size_t)M * D * 2);
constexpr size_t WS_ACT  = WS_MEMB + al((size_t)MMEM * D * 2);
constexpr size_t WS_XR   = WS_ACT + al((size_t)M * FF * 2);
constexpr size_t WS_PROJ = WS_XR + al((size_t)M * D * 4);
constexpr size_t WS_V    = WS_PROJ + al((size_t)M * DINP * 4);
constexpr size_t WS_Q    = WS_V + al((size_t)M * DMIX * 2);
constexpr size_t WS_O    = WS_Q + al((size_t)M * D * 2);
constexpr size_t WS_KM   = WS_O + al((size_t)M * D * 2);
constexpr size_t WS_VT   = WS_KM + al((size_t)MMEM * D * 2);
constexpr size_t WS_SSQ  = WS_VT + al((size_t)MMEM * D * 2);
constexpr size_t WS_SSQM = WS_SSQ + al((size_t)4 * M * NSSQ * 4);
constexpr size_t WS_SQV  = WS_SSQM + al((size_t)MMEM * NSSQ * 4);
constexpr size_t WS_END  = WS_SQV + al((size_t)M * NSQV * 4);
constexpr int CW_TMO = 0, CW_CODE = 1, CW_QUEUE = 64, CW_BAR = 4096;

namespace pg8 {
#define PG8_LAS __attribute__((address_space(3)))
typedef unsigned short bf16_t;
typedef short bf16x8 __attribute__((ext_vector_type(8)));
typedef float f32x4 __attribute__((ext_vector_type(4)));
typedef unsigned u32x4 __attribute__((ext_vector_type(4)));
constexpr int BM = 256, BK = 64, HALF = 128, HTB = HALF * BK * 2  , STAGE_BYTES = 8 * HTB, NXCD = 8, WGM = 8;

__host__ __device__ __forceinline__ int lds_byte(int r, int c) { const int st = (r >> 4) * 2 + (c >> 5), rr = r & 15, cc = c & 31, ob = rr * 64 + cc * 2; return st * 1024 + (ob ^ (((ob >> 9) & 1) << 5)); }
__host__ __device__ __forceinline__ void stage_rc(int b, int& R, int& C) { const int st = b / 1024, sb = b % 1024, swz = sb ^ (((sb >> 9) & 1) << 5); R = (st >> 1) * 16 + swz / 64; C = (st & 1) * 32 + (swz % 64) / 2; }
__host__ __device__ __forceinline__ int perm32(int rho) { const int n = rho >> 4, i = rho & 15; return 8 * (i >> 2) + 4 * n + (i & 3); }

struct Unit { int pm, pn; };
struct Gemm { const bf16_t* A; const bf16_t* Bt; int M, N, K; };

struct StaticOrder {
    int nM, nN, nwg, G, c;
    __host__ __device__ void init(int M, int N, int G_, int c_) { nM = M / BM; nN = N / BM; nwg = nM * nN; G = G_; c = c_; }
    __host__ __device__ bool next(int i, Unit& u) const {
        const long L = (long)i * G + c; if (L >= nwg) return false;
        int wgid = (int)L; { const int q = nwg / NXCD, r = nwg % NXCD, xcd = wgid % NXCD, off = wgid / NXCD; wgid = (xcd < r ? xcd * (q + 1) : r * (q + 1) + (xcd - r) * q) + off; }
        const int nig = WGM * nN, gid = wgid / nig, fm = gid * WGM, gsz = (nM - fm) < WGM ? (nM - fm) : WGM;
        u.pm = fm + ((wgid % nig) % gsz); u.pn = (wgid % nig) / gsz; return true;
    }
    __device__ __forceinline__ void a_ready(const Unit&) const {}
    __device__ __forceinline__ void done(const Unit&) const {}
};

__device__ __forceinline__ unsigned cvt_pk_bf16(float lo, float hi) { unsigned r; asm volatile("v_cvt_pk_bf16_f32 %0, %1, %2" : "=v"(r) : "v"(lo), "v"(hi)); return r; }
typedef unsigned u32x2 __attribute__((ext_vector_type(2)));
constexpr float EPS_ = 1e-6f;
__device__ __forceinline__ float row_rstd(const float* ssq, int row, int fq) {
    const f32x4* p = (const f32x4*)(ssq + (size_t)row * 32 + fq * 8);
    const f32x4 a = p[0], b = p[1];
    float s = ((a[0] + a[1]) + (a[2] + a[3])) + ((b[0] + b[1]) + (b[2] + b[3]));
    s += __shfl_xor(s, 16); s += __shfl_xor(s, 32);
    return __builtin_amdgcn_rsqf(s * (1.0f / 2048.0f) + EPS_);
}
__device__ __forceinline__ float silu_f(float x) { return x * __builtin_amdgcn_rcpf(1.0f + __expf(-x)); }

struct EpiSwiglu {
    static constexpr bool PERM = true, AFTER_DRAIN = false;
    bf16_t* O; int ldc; const float* ssq;
    __device__ __forceinline__ void operator()(const f32x4 (&acc)[2][2][4][2], const Unit& u, int wr, int wc, int fr, int fq) const {
        const int row0 = u.pm * BM + wr * 64 + fr, col0 = u.pn * HALF + wc * 32 + 8 * fq;
#pragma unroll
        for (int ai = 0; ai < 2; ++ai)
#pragma unroll
            for (int m = 0; m < 4; ++m) { const int row = row0 + ai * HALF + m * 16; const float rs = row_rstd(ssq, row, fq);
                u32x4 w; float o[8];
#pragma unroll
                for (int n = 0; n < 2; ++n)
#pragma unroll
                    for (int i = 0; i < 4; ++i) { const float g = acc[ai][0][m][n][i] * rs, up = acc[ai][1][m][n][i] * rs; o[4 * n + i] = silu_f(g) * up; }
                w.x = cvt_pk_bf16(o[0], o[1]); w.y = cvt_pk_bf16(o[2], o[3]); w.z = cvt_pk_bf16(o[4], o[5]); w.w = cvt_pk_bf16(o[6], o[7]);
                *(u32x4*)(O + (size_t)row * ldc + col0) = w; }
    }
};
struct EpiKV {
    static constexpr bool PERM = false, AFTER_DRAIN = false;
    float* ko; float* vo; bf16_t* km; bf16_t* vt; const float* ssq;
    __device__ __forceinline__ void operator()(const f32x4 (&acc)[2][2][4][2], const Unit& u, int wr, int wc, int fr, int fq) const {
        const int row0 = u.pm * BM + wr * 64 + fr;
#pragma unroll
        for (int ai = 0; ai < 2; ++ai)
#pragma unroll
            for (int m = 0; m < 4; ++m) { const int row = row0 + ai * HALF + m * 16; const float rs = row_rstd(ssq, row, fq);
#pragma unroll
                for (int bj = 0; bj < 2; ++bj)
#pragma unroll
                    for (int n = 0; n < 2; ++n) { const int col = u.pn * BM + bj * HALF + wc * 32 + n * 16 + 4 * fq; const f32x4 v = acc[ai][bj][m][n] * rs;
                        if (u.pn < 8) { *(f32x4*)(ko + (size_t)row * 2048 + col) = v; u32x2 w; w.x = cvt_pk_bf16(v[0], v[1]); w.y = cvt_pk_bf16(v[2], v[3]); *(u32x2*)(km + (size_t)row * 2048 + col) = w; }
                        else { const int c2 = col - 2048; *(f32x4*)(vo + (size_t)row * 2048 + c2) = v; const int b = row >> 8, key = row & 255;
                            const unsigned w0 = cvt_pk_bf16(v[0], v[1]), w1 = cvt_pk_bf16(v[2], v[3]); bf16_t* t = vt + ((size_t)(b * 2048 + c2)) * 256 + key;
                            t[0] = (bf16_t)(w0 & 0xffffu); t[256] = (bf16_t)(w0 >> 16); t[512] = (bf16_t)(w1 & 0xffffu); t[768] = (bf16_t)(w1 >> 16); } } }
    }
};
template <bool FIRST, bool WRITE_XB> struct EpiRes {
    static constexpr bool PERM = false, AFTER_DRAIN = false;
    const float* xp; const float* xs; float* xr; bf16_t* xb; float* ssq_out; float alpha;
    __device__ __forceinline__ void operator()(const f32x4 (&acc)[2][2][4][2], const Unit& u, int wr, int wc, int fr, int fq) const {
        const int row0 = u.pm * BM + wr * 64 + fr;
#pragma unroll
        for (int ai = 0; ai < 2; ++ai)
#pragma unroll
            for (int m = 0; m < 4; ++m) { const int row = row0 + ai * HALF + m * 16; float q = 0.f;
                const float* base = FIRST ? (row < 8192 ? xp + (size_t)row * 2048 : xs + (size_t)(row - 8192) * 2048) : xr + (size_t)row * 2048;
#pragma unroll
                for (int bj = 0; bj < 2; ++bj)
#pragma unroll
                    for (int n = 0; n < 2; ++n) { const int col = u.pn * BM + bj * HALF + wc * 32 + n * 16 + 4 * fq; const f32x4 b = *(const f32x4*)(base + col); const f32x4 o = b + acc[ai][bj][m][n] * alpha;
                        *(f32x4*)(xr + (size_t)row * 2048 + col) = o; q += (o[0] * o[0] + o[1] * o[1]) + (o[2] * o[2] + o[3] * o[3]);
                        if (WRITE_XB) { u32x2 w; w.x = cvt_pk_bf16(o[0], o[1]); w.y = cvt_pk_bf16(o[2], o[3]); *(u32x2*)(xb + (size_t)row * 2048 + col) = w; } }
                q += __shfl_xor(q, 16); q += __shfl_xor(q, 32);
                if (fq == 0) ssq_out[(size_t)row * 32 + u.pn * 4 + wc] = q; }
    }
};
struct EpiProj {
    static constexpr bool PERM = false, AFTER_DRAIN = false;
    float* C; int ldc; const float* ssq;
    __device__ __forceinline__ void operator()(const f32x4 (&acc)[2][2][4][2], const Unit& u, int wr, int wc, int fr, int fq) const {
        const int row0 = u.pm * BM + wr * 64 + fr;
#pragma unroll
        for (int ai = 0; ai < 2; ++ai)
#pragma unroll
            for (int m = 0; m < 4; ++m) { const int row = row0 + ai * HALF + m * 16; const float rs = row_rstd(ssq, row, fq);
#pragma unroll
                for (int bj = 0; bj < 2; ++bj)
#pragma unroll
                    for (int n = 0; n < 2; ++n) { const int col = u.pn * BM + bj * HALF + wc * 32 + n * 16 + 4 * fq; *(f32x4*)(C + (size_t)row * ldc + col) = acc[ai][bj][m][n] * rs; } }
    }
};
struct EpiQ {
    static constexpr bool PERM = true, AFTER_DRAIN = false;
    bf16_t* O; const float* ssq; float scale;
    __device__ __forceinline__ void operator()(const f32x4 (&acc)[2][2][4][2], const Unit& u, int wr, int wc, int fr, int fq) const {
        const int row0 = u.pm * BM + wr * 64 + fr, col0 = u.pn * BM + wc * 32 + 8 * fq;
#pragma unroll
        for (int ai = 0; ai < 2; ++ai)
#pragma unroll
            for (int m = 0; m < 4; ++m) { const int row = row0 + ai * HALF + m * 16; const float rs = row_rstd(ssq, row, fq) * scale;
#pragma unroll
                for (int bj = 0; bj < 2; ++bj) { const f32x4 v0 = acc[ai][bj][m][0] * rs, v1 = acc[ai][bj][m][1] * rs;
                    u32x4 w; w.x = cvt_pk_bf16(v0[0], v0[1]); w.y = cvt_pk_bf16(v0[2], v0[3]); w.z = cvt_pk_bf16(v1[0], v1[1]); w.w = cvt_pk_bf16(v1[2], v1[3]);
                    *(u32x4*)(O + (size_t)row * 2048 + col0 + bj * HALF) = w; } }
    }
};

template <class Epi, class Sched, bool ALIGN_EPI = false, bool SP2 = false>
__device__ __forceinline__ void gemm_phase(PG8_LAS unsigned char* lds, const Gemm g, const Sched& S, const Epi& E) {
    const int tid = threadIdx.x, wid = __builtin_amdgcn_readfirstlane(tid >> 6), lane = tid & 63, wr = wid >> 2, wc = wid & 3, fr = lane & 15, fq = lane >> 4;
    const int K = g.K, nt = K / BK;
    unsigned voffA[2], voffB[2];
#pragma unroll
    for (int i = 0; i < 2; ++i) { int R, C; stage_rc(tid * 16 + i * 8192, R, C); const int Rb = Epi::PERM ? ((R & ~31) + perm32(R & 31)) : R;
        voffA[i] = (unsigned)(R * K + C) * 2u; voffB[i] = (unsigned)(Rb * K + C) * 2u; }
    const size_t kstep = (size_t)(BK * 2);
    const size_t hstep = (size_t)HALF * K * 2;
    const size_t tstep = 2 * hstep;
    const unsigned ldsw = (unsigned)wid * 1024u;
    const int aoff = lds_byte(wr * 64 + fr, fq * 8), boff = lds_byte(wc * 32 + fr, fq * 8);
#define PG8_SA(b, h) (((b) * 2 + (h)) * HTB)
#define PG8_SB(b, h) ((4 + (b) * 2 + (h)) * HTB)
#define PG8_STAGE(bufoff, gbase, voff) do { _Pragma("unroll") for (int _i = 0; _i < 2; ++_i) \
        __builtin_amdgcn_global_load_lds((const unsigned*)((const char*)(gbase) + (voff)[_i]), (PG8_LAS unsigned*)(lds + (bufoff) + ldsw + _i * 8192), 16, 0, 0); } while (0)
#define PG8_LDA(dst, b, h) do { _Pragma("unroll") for (int m = 0; m < 4; ++m) _Pragma("unroll") for (int k = 0; k < 2; ++k) dst[m][k] = *(const PG8_LAS bf16x8*)(lds + PG8_SA(b, h) + aoff + m * 2048 + k * 1024); } while (0)
#define PG8_LDB(dst, b, h) do { _Pragma("unroll") for (int n = 0; n < 2; ++n) _Pragma("unroll") for (int k = 0; k < 2; ++k) dst[n][k] = *(const PG8_LAS bf16x8*)(lds + PG8_SB(b, h) + boff + n * 2048 + k * 1024); } while (0)
#define PG8_MMA(ai, bj, At, Bt) do { __builtin_amdgcn_s_setprio(1); _Pragma("unroll") for (int m = 0; m < 4; ++m) _Pragma("unroll") for (int n = 0; n < 2; ++n) _Pragma("unroll") for (int k = 0; k < 2; ++k) \
        acc[ai][bj][m][n] = __builtin_amdgcn_mfma_f32_16x16x32_bf16(Bt[n][k], At[m][k], acc[ai][bj][m][n], 0, 0, 0); __builtin_amdgcn_s_setprio(0); } while (0)
#define PG8_WAIT_V(n) asm volatile("s_waitcnt vmcnt(" #n ")" ::: "memory")
#define PG8_WAIT_L(n) asm volatile("s_waitcnt lgkmcnt(" #n ")" ::: "memory")
#define PG8_BAR __builtin_amdgcn_s_barrier()
#define PG8_SCHED __builtin_amdgcn_sched_barrier(0)
    Unit cur, nxt; int ui = 0;
    if (!S.next(0, cur)) return;
    f32x4 acc[2][2][4][2];
#pragma unroll
    for (int a = 0; a < 2; ++a)
#pragma unroll
        for (int b = 0; b < 2; ++b)
#pragma unroll
            for (int m = 0; m < 4; ++m)
#pragma unroll
                for (int n = 0; n < 2; ++n) acc[a][b][m][n] = (f32x4){0.f, 0.f, 0.f, 0.f};
    bf16x8 At[4][2], B0[2][2], B1[2][2];
    const char* cA = (const char*)g.A + (size_t)cur.pm * tstep; const char* cB = (const char*)g.Bt + (size_t)cur.pn * tstep;
    S.a_ready(cur);
    if constexpr (SP2) {
        PG8_STAGE(PG8_SB(0, 0), cB, voffB); PG8_STAGE(PG8_SB(0, 1), cB + hstep, voffB); PG8_STAGE(PG8_SA(0, 0), cA, voffA); PG8_STAGE(PG8_SA(0, 1), cA + hstep, voffA);
        if (wr == 1) PG8_BAR;
        PG8_WAIT_V(2); PG8_BAR;
        PG8_STAGE(PG8_SB(1, 0), cB + kstep, voffB); PG8_STAGE(PG8_SA(1, 0), cA + kstep, voffA); PG8_STAGE(PG8_SB(1, 1), cB + hstep + kstep, voffB);
        PG8_WAIT_V(6); PG8_BAR;
    } else {
        PG8_STAGE(PG8_SB(0, 0), cB, voffB); PG8_STAGE(PG8_SA(0, 0), cA, voffA); PG8_STAGE(PG8_SB(0, 1), cB + hstep, voffB); PG8_STAGE(PG8_SA(0, 1), cA + hstep, voffA);
        if (wr == 1) PG8_BAR;
        PG8_WAIT_V(4); PG8_BAR;
        PG8_STAGE(PG8_SB(1, 0), cB + kstep, voffB); PG8_STAGE(PG8_SA(1, 0), cA + kstep, voffA); PG8_STAGE(PG8_SB(1, 1), cB + hstep + kstep, voffB);
        PG8_WAIT_V(6); PG8_BAR;
    }
    for (;;) {
        const bool has_next = S.next(ui + 1, nxt);
        const char* nA = has_next ? (const char*)g.A + (size_t)nxt.pm * tstep : cA; const char* nB = has_next ? (const char*)g.Bt + (size_t)nxt.pn * tstep : cB;
        for (int t = 0; t < nt; t += 2) {
            const bool last = (t == nt - 2);
            const char* a1 = cA + (size_t)(t + 1) * kstep;
            const char* a2 = last ? nA : cA + (size_t)(t + 2) * kstep; const char* b2 = last ? nB : cB + (size_t)(t + 2) * kstep;
            const char* a3 = a2 + kstep; const char* b3 = b2 + kstep;
            if (last && has_next) S.a_ready(nxt);
            if constexpr (SP2) {
            PG8_LDB(B0, 0, 0); PG8_LDB(B1, 0, 1); PG8_SCHED; PG8_LDA(At, 0, 0); PG8_STAGE(PG8_SA(1, 1), a1 + hstep, voffA);
            PG8_WAIT_V(8); PG8_WAIT_L(0); PG8_BAR; PG8_MMA(0, 0, At, B0); PG8_MMA(0, 1, At, B1); PG8_BAR; PG8_SCHED;
            PG8_LDA(At, 0, 1); PG8_STAGE(PG8_SB(0, 0), b2, voffB); PG8_STAGE(PG8_SB(0, 1), b2 + hstep, voffB); PG8_STAGE(PG8_SA(0, 0), a2, voffA);
            PG8_WAIT_V(8); PG8_WAIT_L(0); PG8_BAR; PG8_MMA(1, 0, At, B0); PG8_MMA(1, 1, At, B1); PG8_BAR; PG8_SCHED;
            PG8_LDB(B0, 1, 0); PG8_LDB(B1, 1, 1); PG8_SCHED; PG8_LDA(At, 1, 0); PG8_STAGE(PG8_SA(0, 1), a2 + hstep, voffA);
            PG8_WAIT_V(8); PG8_WAIT_L(0); PG8_BAR; PG8_MMA(0, 0, At, B0); PG8_MMA(0, 1, At, B1); PG8_BAR; PG8_SCHED;
            PG8_LDA(At, 1, 1); PG8_STAGE(PG8_SB(1, 0), b3, voffB); PG8_STAGE(PG8_SB(1, 1), b3 + hstep, voffB); PG8_STAGE(PG8_SA(1, 0), a3, voffA);
            PG8_WAIT_V(8); PG8_WAIT_L(0); PG8_BAR; PG8_MMA(1, 0, At, B0); PG8_MMA(1, 1, At, B1); PG8_BAR; PG8_SCHED;
            } else {
            PG8_LDB(B0, 0, 0); PG8_SCHED; PG8_LDA(At, 0, 0); PG8_STAGE(PG8_SA(1, 1), a1 + hstep, voffA);
            PG8_WAIT_L(8); PG8_BAR; PG8_WAIT_L(0); PG8_MMA(0, 0, At, B0); PG8_BAR; PG8_SCHED;
            PG8_LDB(B1, 0, 1); PG8_STAGE(PG8_SB(0, 0), b2, voffB);
            PG8_BAR; PG8_WAIT_L(0); PG8_MMA(0, 1, At, B1); PG8_BAR;
            PG8_LDA(At, 0, 1); PG8_STAGE(PG8_SA(0, 0), a2, voffA);
            PG8_BAR; PG8_WAIT_L(0); PG8_MMA(1, 0, At, B0); PG8_BAR; PG8_SCHED;
            PG8_STAGE(PG8_SB(0, 1), b2 + hstep, voffB);
            PG8_WAIT_V(6); PG8_BAR; PG8_MMA(1, 1, At, B1); PG8_BAR;
            PG8_LDB(B0, 1, 0); PG8_SCHED; PG8_LDA(At, 1, 0); PG8_STAGE(PG8_SA(0, 1), a2 + hstep, voffA);
            PG8_WAIT_L(8); PG8_BAR; PG8_WAIT_L(0); PG8_MMA(0, 0, At, B0); PG8_BAR; PG8_SCHED;
            PG8_LDB(B1, 1, 1); PG8_STAGE(PG8_SB(1, 0), b3, voffB);
            PG8_BAR; PG8_WAIT_L(0); PG8_MMA(0, 1, At, B1); PG8_BAR;
            PG8_LDA(At, 1, 1); PG8_STAGE(PG8_SA(1, 0), a3, voffA);
            PG8_BAR; PG8_WAIT_L(0); PG8_MMA(1, 0, At, B0); PG8_BAR; PG8_SCHED;
            PG8_STAGE(PG8_SB(1, 1), b3 + hstep, voffB);
            PG8_WAIT_V(6); PG8_BAR; PG8_MMA(1, 1, At, B1); PG8_BAR;
            }
        }
        if constexpr (ALIGN_EPI) { if (wr == 0) PG8_BAR; }
        if constexpr (!Epi::AFTER_DRAIN) { E(acc, cur, wr, wc, fr, fq); S.done(cur); }
        if (!has_next) break;
#pragma unroll
        for (int a = 0; a < 2; ++a)
#pragma unroll
            for (int b = 0; b < 2; ++b)
#pragma unroll
                for (int m = 0; m < 4; ++m)
#pragma unroll
                    for (int n = 0; n < 2; ++n) acc[a][b][m][n] = (f32x4){0.f, 0.f, 0.f, 0.f};
        cur = nxt; cA = nA; cB = nB; ++ui;
        if constexpr (ALIGN_EPI) { if (wr == 1) PG8_BAR; }
    }
    PG8_WAIT_V(0);
    if constexpr (!ALIGN_EPI) { if (wr == 0) PG8_BAR; }
    PG8_BAR;
    if constexpr (Epi::AFTER_DRAIN) { E.fused(acc, cur, wr, wc, fr, fq, lds, wid, lane); S.done(cur); }
#undef PG8_SA
#undef PG8_SB
#undef PG8_STAGE
#undef PG8_LDA
#undef PG8_LDB
#undef PG8_MMA
#undef PG8_WAIT_V
#undef PG8_WAIT_L
#undef PG8_BAR
#undef PG8_SCHED
}
}
#ifndef PG8_SP2
#define PG8_SP2 true
#endif
#ifndef PG8_ALIGN
#define PG8_ALIGN true
#endif
constexpr int RING_OFF = 0, RING_BYTES = 131072;
constexpr int LDSCTL_OFF = RING_BYTES, MISC_OFF = LDSCTL_OFF + 320;
constexpr int LDS_BYTES = 147456;
static_assert(MISC_OFF + 128 <= LDS_BYTES, "LDS map");

#define GAS __attribute__((address_space(1)))
#define LAS __attribute__((address_space(3)))
typedef unsigned short bf16;
typedef unsigned v4u __attribute__((ext_vector_type(4)));
typedef unsigned v2u __attribute__((ext_vector_type(2)));
typedef float f32x4 __attribute__((ext_vector_type(4)));
typedef float f32x2 __attribute__((ext_vector_type(2)));
typedef short bf16x8 __attribute__((ext_vector_type(8)));
typedef short bf16x4 __attribute__((ext_vector_type(4)));
typedef GAS unsigned gu32;
#define RLX_AGENT __ATOMIC_RELAXED, __HIP_MEMORY_SCOPE_AGENT
#define LDS_WAIT() asm volatile("s_waitcnt lgkmcnt(0)" ::: "memory")
#define VM_WAIT() asm volatile("s_waitcnt vmcnt(0)" ::: "memory")
__device__ __forceinline__ unsigned f2bf(float f) { unsigned u = __builtin_bit_cast(unsigned, f); return (u + 0x7fffu + ((u >> 16) & 1u)) >> 16; }
__device__ __forceinline__ unsigned pk2(float lo, float hi) { return f2bf(lo) | (f2bf(hi) << 16); }
__device__ __forceinline__ float bf2f(unsigned b) { return __builtin_bit_cast(float, b << 16); }
__device__ __forceinline__ float wave_sum(float v) {
#pragma unroll
    for (int o = 1; o < 64; o <<= 1) v += __shfl_xor(v, o);
    return v;
}
__device__ __forceinline__ float sigmoid_f(float x) { return __builtin_amdgcn_rcpf(1.0f + __expf(-x)); }
__device__ __forceinline__ float siluf_(float x) { return x * sigmoid_f(x); }
__device__ __forceinline__ float softplus_f(float x) { return x > 20.f ? x : log1pf(__expf(x)); }
__device__ __forceinline__ float gelu_tanh_f(float x) { const float t = 0.7978845608028654f * (x + 0.044715f * x * x * x); return x * sigmoid_f(2.0f * t); }
#define MFMA16(a, b, c) __builtin_amdgcn_mfma_f32_16x16x32_bf16((a), (b), (c), 0, 0, 0)

#define XB_TMO      128
#define XB_XCNT(j)  (256  + 64 * (j))
#define XB_XSUB(j)  (1280 + 64 * (j))
#define XB_XGEN(j)  (2304 + 64 * (j))
#define XB_TOP      3328
#define XB_TOPGEN   3392
#define XCD_BAR_WORDS 3456
#define XB_SPIN_CAP (1u << 18)

__device__ __forceinline__ unsigned xb_ld(unsigned* p)              { return __hip_atomic_load(p, __ATOMIC_RELAXED, __HIP_MEMORY_SCOPE_AGENT); }
__device__ __forceinline__ unsigned xb_add(unsigned* p, unsigned v) { return __hip_atomic_fetch_add(p, v, __ATOMIC_RELAXED, __HIP_MEMORY_SCOPE_AGENT); }
__device__ __forceinline__ unsigned xb_xcc_id() { return (unsigned)__builtin_amdgcn_s_getreg((3 << 11) | 20) & 0xFu; }
#define XB_SPIN(cond, bar) do { unsigned _sp = 0; while (cond) { __builtin_amdgcn_s_sleep(1); \
    if ((++_sp & 255u) == 0u) { if (xb_ld(&(bar)[XB_TMO])) break; if (_sp > XB_SPIN_CAP) { atomicAdd(&(bar)[XB_TMO], 1u); break; } } } } while (0)

struct XcdBarrier {
    unsigned* bar; unsigned x;
    volatile LAS unsigned* st;
};

__device__ __forceinline__ XcdBarrier xcd_barrier_post(unsigned* bar, volatile LAS unsigned* st) {
    XcdBarrier b; b.bar = bar; b.x = xb_xcc_id(); b.st = st;
    if (threadIdx.x == 0) (void)xb_add(&bar[XB_XCNT(b.x)], 1u);
    return b;
}
__device__ __forceinline__ void xcd_barrier_complete(unsigned* bar, unsigned x, unsigned& nloc, unsigned& nx) {
    const unsigned G = gridDim.x * gridDim.y * gridDim.z;
    unsigned sum, cnt, mine, sp = 0u;
    for (;;) {
        sum = 0u; cnt = 0u; mine = 0u;
#pragma unroll
        for (unsigned j = 0; j < 16; ++j) { const unsigned c = xb_ld(&bar[XB_XCNT(j)]); sum += c; cnt += (c > 0u) ? 1u : 0u; mine = (j == x) ? c : mine; }
        if (sum == G) break;
        __builtin_amdgcn_s_sleep(1);
        if ((++sp & 255u) == 0u) { if (xb_ld(&bar[XB_TMO])) break; if (sp > XB_SPIN_CAP) { atomicAdd(&bar[XB_TMO], 1u); break; } }
    }
    nloc = mine > 0u ? mine : 1u; nx = cnt > 0u ? cnt : 1u;
}

__device__ __forceinline__ void xcd_barrier(const XcdBarrier& b) {
    asm volatile("s_waitcnt vmcnt(0)" ::: "memory");
    __syncthreads();
    if (threadIdx.x == 0) {
        unsigned* bar = b.bar;
        __builtin_amdgcn_s_waitcnt(0);
        unsigned nloc = b.st[0], nx = b.st[1];
        if (nloc == 0u) { xcd_barrier_complete(bar, b.x, nloc, nx); b.st[0] = nloc; b.st[1] = nx; }
        const unsigned old = xb_add(&bar[XB_XSUB(b.x)], 1u);
        const unsigned gen = old / nloc;
        if (old + 1u == (gen + 1u) * nloc) {
            __builtin_amdgcn_fence(__ATOMIC_RELEASE, "agent");
            asm volatile("s_waitcnt vmcnt(0)" ::: "memory");
            const unsigned og = xb_add(&bar[XB_TOP], 1u);
            const unsigned tg = og / nx;
            if (og + 1u == (tg + 1u) * nx) xb_add(&bar[XB_TOPGEN], 1u);
            else XB_SPIN(xb_ld(&bar[XB_TOPGEN]) == tg, bar);
            __builtin_amdgcn_fence(__ATOMIC_ACQUIRE, "agent");
            xb_add(&bar[XB_XGEN(b.x)], 1u);
            asm volatile("s_waitcnt vmcnt(0)" ::: "memory");
        } else {
            XB_SPIN(xb_ld(&bar[XB_XGEN(b.x)]) == gen, bar);
            __builtin_amdgcn_fence(__ATOMIC_ACQUIRE, "agent");
            asm volatile("s_waitcnt vmcnt(0)" ::: "memory");
        }
    }
    __syncthreads();
}
struct Args { const float* in[41]; float* out; unsigned char* ws; int ph_lo, ph_hi; };
struct Frame {
    LAS unsigned char* lds;
    volatile LAS unsigned* MISC;
    gu32* ctl;
    int tid, lane, wave;
    int vcu, G;
    float* out;
    unsigned char* ws;
};
#define WSP(T, off) ((T*)(F.ws + (off)))
#define INP(i) (A.in[(i)])

__device__ __forceinline__ void p0_transpose_item(const float* W, int N, bf16* WT, int ldt, int kdst, int dst_row0, const float* gain, LAS float* scr, int k0, int n0, int lane) {
    const int rs = lane >> 3, c4 = (lane & 7) * 4; f32x4 v[8]; float gn[8];
    const GAS float* src = (const GAS float*)W + (size_t)(k0 + rs) * N + n0 + c4;
#pragma unroll
    for (int i = 0; i < 8; ++i) { v[i] = *(const GAS f32x4*)(src + (size_t)(8 * i) * N); gn[i] = gain ? gain[k0 + 8 * i + rs] : 1.0f; }
#pragma unroll
    for (int i = 0; i < 8; ++i) { LAS float* d = scr + (8 * i + rs) * 33 + c4; d[0] = v[i].x * gn[i]; d[1] = v[i].y * gn[i]; d[2] = v[i].z * gn[i]; d[3] = v[i].w * gn[i]; }
    LDS_WAIT(); asm volatile("" ::: "memory");
    const int c = lane & 7;
#pragma unroll
    for (int j = 0; j < 4; ++j) { const int n = (lane >> 3) + 8 * j; const LAS float* s = scr + (8 * c) * 33 + n;
        v4u o; o.x = pk2(s[0 * 33], s[1 * 33]); o.y = pk2(s[2 * 33], s[3 * 33]); o.z = pk2(s[4 * 33], s[5 * 33]); o.w = pk2(s[6 * 33], s[7 * 33]);
        *(GAS v4u*)(WT + (size_t)(dst_row0 + n) * ldt + kdst + k0 + 8 * c) = o; }
    LDS_WAIT(); asm volatile("" ::: "memory");
}
__device__ __forceinline__ void p0_tr(const float* W, int K, int N, bf16* WT, int ldt, int kdst, int row_base, int mode  , const float* gain, LAS float* scr, int item, int lane) {
    const int nblk = N / 32, kb = item / nblk, nb = item % nblk, k0 = 64 * kb, n0 = 32 * nb; (void)K;
    const int dr = mode == 0 ? row_base + n0 : (n0 / 128) * 256 + (n0 % 128) + (mode == 2 ? 128 : 0);
    p0_transpose_item(W, N, WT, ldt, kdst, dr, gain, scr, k0, n0, lane);
}
__device__ __forceinline__ void row_to_bf16_ssq(const float* xrow, bf16* orow, float* ssq32, int lane) {
    const GAS f32x4* xr = (const GAS f32x4*)xrow + lane; GAS v2u* o8 = (GAS v2u*)orow + lane; float s = 0.f;
#pragma unroll
    for (int j = 0; j < 8; ++j) { const f32x4 v = xr[64 * j]; s += (v.x * v.x + v.y * v.y) + (v.z * v.z + v.w * v.w); v2u w; w.x = pk2(v.x, v.y); w.y = pk2(v.z, v.w); o8[64 * j] = w; }
    s = wave_sum(s);
    if (lane < 32) ssq32[lane] = lane == 0 ? s : 0.f;
}
__device__ __forceinline__ void p0_prologue(Frame& F, const Args& A) {
    LAS float* scr = (LAS float*)(F.lds + RING_OFF + F.wave * 16384);
    const int gw = F.vcu * NWAVES + F.wave, NGW = F.G * NWAVES;
    constexpr int I_GU = (D / 64) * (FF / 32), I_DN = (FF / 64) * (D / 32), I_IN = (D / 64) * (DIN / 32), I_SQ = (D / 64) * (D / 32), I_L = 16 * 8;
    constexpr int NITEMS = 4 * I_GU + 2 * I_DN + I_IN + 6 * I_SQ + 2 * I_L;
    for (int it = gw; it < NITEMS; it += NGW) {
        int r = it;
        if (r < I_GU) { p0_tr(INP(I_F1WG), D, FF, WSP(bf16, WS_W1GU), D, 0, 0, 1, INP(I_F1G), scr, r, F.lane); continue; } r -= I_GU;
        if (r < I_GU) { p0_tr(INP(I_F1WU), D, FF, WSP(bf16, WS_W1GU), D, 0, 0, 2, INP(I_F1G), scr, r, F.lane); continue; } r -= I_GU;
        if (r < I_DN) { p0_tr(INP(I_F1WD), FF, D, WSP(bf16, WS_W1D), FF, 0, 0, 0, nullptr, scr, r, F.lane); continue; } r -= I_DN;
        if (r < I_IN) { p0_tr(INP(I_WIN), D, DIN, WSP(bf16, WS_WIN), D, 0, 0, 0, INP(I_MIXG), scr, r, F.lane); continue; } r -= I_IN;
        if (r < I_SQ) { p0_tr(INP(I_WOUT), D, D, WSP(bf16, WS_WOUT), DMIX, 0, 0, 0, INP(I_LOG), scr, r, F.lane); continue; } r -= I_SQ;
        if (r < I_SQ) { p0_tr(INP(I_WOUT) + (size_t)D * D, D, D, WSP(bf16, WS_WOUT), DMIX, D, 0, 0, INP(I_SOG), scr, r, F.lane); continue; } r -= I_SQ;
        if (r < I_SQ) { p0_tr(INP(I_WQ), D, D, WSP(bf16, WS_WQ), D, 0, 0, 0, INP(I_XAG), scr, r, F.lane); continue; } r -= I_SQ;
        if (r < I_SQ) { p0_tr(INP(I_WK), D, D, WSP(bf16, WS_WKV), D, 0, 0, 0, INP(I_MEMG), scr, r, F.lane); continue; } r -= I_SQ;
        if (r < I_SQ) { p0_tr(INP(I_WV), D, D, WSP(bf16, WS_WKV), D, 0, D, 0, INP(I_MEMG), scr, r, F.lane); continue; } r -= I_SQ;
        if (r < I_SQ) { p0_tr(INP(I_WO), D, D, WSP(bf16, WS_WO), D, 0, 0, 0, nullptr, scr, r, F.lane); continue; } r -= I_SQ;
        if (r < I_GU) { p0_tr(INP(I_F2WG), D, FF, WSP(bf16, WS_W2GU), D, 0, 0, 1, INP(I_F2G), scr, r, F.lane); continue; } r -= I_GU;
        if (r < I_GU) { p0_tr(INP(I_F2WU), D, FF, WSP(bf16, WS_W2GU), D, 0, 0, 2, INP(I_F2G), scr, r, F.lane); continue; } r -= I_GU;
        if (r < I_DN) { p0_tr(INP(I_F2WD), FF, D, WSP(bf16, WS_W2D), FF, 0, 0, 0, nullptr, scr, r, F.lane); continue; } r -= I_DN;
        if (r < I_L) { const int h = r >> 3; p0_tr(INP(I_LWA) + (size_t)h * 16384, 128, 128, WSP(bf16, WS_WL), 128, 0, h * 256, 0, nullptr, scr, r & 7, F.lane); continue; } r -= I_L;
        { const int h = r >> 3; p0_tr(INP(I_LWX) + (size_t)h * 16384, 128, 128, WSP(bf16, WS_WL), 128, 0, h * 256 + 128, 0, nullptr, scr, r & 7, F.lane); }
    }
    for (int m = gw; m < M; m += NGW) { const float* src = m < MP ? INP(I_XP) + (size_t)m * D : INP(I_XS) + (size_t)(m - MP) * D;
        row_to_bf16_ssq(src, WSP(bf16, WS_XBA) + (size_t)m * D, WSP(float, WS_SSQ) + (size_t)m * NSSQ, F.lane); }
    for (int m = gw; m < MMEM; m += NGW) row_to_bf16_ssq(INP(I_MEMP) + (size_t)m * D, WSP(bf16, WS_MEMB) + (size_t)m * D, WSP(float, WS_SSQM) + (size_t)m * NSSQ, F.lane);
    { GAS v4u* z = (GAS v4u*)(WSP(bf16, WS_WIN) + (size_t)DIN * D); const int nz = (DINP - DIN) * D * 2 / 16;
      for (int i = gw * 64 + F.lane; i < nz; i += NGW * 64) z[i] = (v4u){0u, 0u, 0u, 0u}; }
}

__device__ __forceinline__ void p5_normalize(Frame& F, const Args& A) {
    const int gw = F.vcu * NWAVES + F.wave, NGW = F.G * NWAVES, lane = F.lane;
    bf16* V = WSP(bf16, WS_V); const float* SQ = WSP(float, WS_SQV);
    for (int m = gw; m < M; m += NGW) {
        const float* sq = SQ + (size_t)m * NSQV;
        const float pl = lane < 16 ? sq[lane] : 0.f, p0 = sq[16 + lane], p1 = sq[80 + lane];
        const float rl = __builtin_amdgcn_rsqf(wave_sum(pl) * (1.0f / 2048.0f) + EPS), r0 = __builtin_amdgcn_rsqf(wave_sum(p0) * (1.0f / 1024.0f) + EPS), r1 = __builtin_amdgcn_rsqf(wave_sum(p1) * (1.0f / 1024.0f) + EPS);
        GAS v4u* row = (GAS v4u*)(V + (size_t)m * DMIX) + lane;
#pragma unroll
        for (int i = 0; i < 8; ++i) { const float rs = i < 4 ? rl : (i < 6 ? r0 : r1); v4u w = row[64 * i];
            w.x = pk2(bf2f(w.x & 0xffffu) * rs, bf2f(w.x >> 16) * rs); w.y = pk2(bf2f(w.y & 0xffffu) * rs, bf2f(w.y >> 16) * rs);
            w.z = pk2(bf2f(w.z & 0xffffu) * rs, bf2f(w.z >> 16) * rs); w.w = pk2(bf2f(w.w & 0xffffu) * rs, bf2f(w.w >> 16) * rs); row[64 * i] = w; }
    }
    const float* P = WSP(float, WS_PROJ);
    for (int it = gw; it < (NBP + NBS) * 3; it += NGW) { const int sq = it / 3, k = it % 3;
        const int row = sq < NBP ? sq * TP + TP - 3 + k : MP + (sq - NBP) * TS + TS - 3 + k;
        float* lc = sq < NBP ? F.out + O_PLC + (size_t)(sq * 3 + k) * D : F.out + O_SLC + (size_t)((sq - NBP) * 3 + k) * D;
        float* sc = sq < NBP ? F.out + O_PSC + (size_t)(sq * 3 + k) * XBC : F.out + O_SSC + (size_t)((sq - NBP) * 3 + k) * XBC;
        const float* src = P + (size_t)row * DINP;
        for (int c = lane * 4; c < D; c += 256) *(GAS f32x4*)(lc + c) = *(const GAS f32x4*)(src + C_XL + c);
        for (int c = lane * 4; c < XBC; c += 256) *(GAS f32x4*)(sc + c) = *(const GAS f32x4*)(src + C_XBC + c);
    }
}
__device__ __forceinline__ void p12_final(Frame& F, const Args& A) {
    const int gw = F.vcu * NWAVES + F.wave, NGW = F.G * NWAVES, lane = F.lane;
    const float* XR = WSP(float, WS_XR); const float* SSQ = WSP(float, WS_SSQ) + (size_t)4 * M * NSSQ; const float* g = INP(I_FING);
    for (int m = gw; m < M; m += NGW) {
        const float p = lane < 32 ? SSQ[(size_t)m * NSSQ + lane] : 0.f; const float rs = __builtin_amdgcn_rsqf(wave_sum(p) * (1.0f / 2048.0f) + EPS);
        const GAS f32x4* xr = (const GAS f32x4*)(XR + (size_t)m * D) + lane; const GAS f32x4* gg = (const GAS f32x4*)g + lane; GAS f32x4* o = (GAS f32x4*)(F.out + O_Y + (size_t)m * D) + lane;
#pragma unroll
        for (int j = 0; j < 8; ++j) o[64 * j] = xr[64 * j] * rs * gg[64 * j];
    }
}

__device__ __forceinline__ bf16x8 pack8(const f32x4 a, const f32x4 b) { v4u w; w.x = pg8::cvt_pk_bf16(a[0], a[1]); w.y = pg8::cvt_pk_bf16(a[2], a[3]); w.z = pg8::cvt_pk_bf16(b[0], b[1]); w.w = pg8::cvt_pk_bf16(b[2], b[3]); return __builtin_bit_cast(bf16x8, w); }
#define SCHED_FENCE() __builtin_amdgcn_sched_barrier(0)
__device__ __forceinline__ void attn_prompt_item(Frame& F, const Args& A, int b, int h, int qt) {
    const int lane = F.lane, c16 = lane & 15, g = lane >> 4;
    const int R = b * TP + qt * 16 + c16;
    const bf16* Q = WSP(bf16, WS_Q) + (size_t)R * D + h * 512;
    bf16x8 qf[16];
#pragma unroll
    for (int ks = 0; ks < 16; ++ks) qf[ks] = *(const GAS bf16x8*)(Q + ks * 32 + 8 * g);
    const GAS char* kb = (const GAS char*)(WSP(bf16, WS_KM) + (size_t)(b * NMEM) * D + h * 512); const unsigned ko = (unsigned)(c16 * D + 8 * g) * 2u;
    f32x4 s[16]; bf16x8 kbuf[2][8];
#define KLOAD(step_) do { const int kt_ = (step_) >> 1, hf_ = (step_) & 1; _Pragma("unroll") for (int i = 0; i < 8; ++i) kbuf[(step_) & 1][i] = *(const GAS bf16x8*)(kb + (size_t)kt_ * 16 * D * 2 + ko + (hf_ * 8 + i) * 64); } while (0)
    KLOAD(0);
#pragma unroll
    for (int step = 0; step < 32; ++step) { const int kt = step >> 1, hf = step & 1;
        if (step + 1 < 32) KLOAD(step + 1);
        SCHED_FENCE();
        if (hf == 0) s[kt] = (f32x4){0.f, 0.f, 0.f, 0.f};
#pragma unroll
        for (int i = 0; i < 8; ++i) s[kt] = MFMA16(kbuf[step & 1][i], qf[hf * 8 + i], s[kt]);
        SCHED_FENCE(); }
#undef KLOAD
    const GAS char* vb = (const GAS char*)(WSP(bf16, WS_VT) + (size_t)(b * D + h * 512) * NMEM); const unsigned vo = (unsigned)(c16 * NMEM + 4 * g) * 2u;
    v2u vbuf[2][16];
#define VLOAD(dt_) do { _Pragma("unroll") for (int kk = 0; kk < 8; ++kk) { vbuf[(dt_) & 1][2 * kk] = *(const GAS v2u*)(vb + (size_t)(dt_) * 16 * NMEM * 2 + vo + kk * 64); vbuf[(dt_) & 1][2 * kk + 1] = *(const GAS v2u*)(vb + (size_t)(dt_) * 16 * NMEM * 2 + vo + kk * 64 + 32); } } while (0)
    VLOAD(0);
    float mx = -3.0e38f;
#pragma unroll
    for (int kt = 0; kt < 16; ++kt) mx = fmaxf(mx, fmaxf(fmaxf(s[kt][0], s[kt][1]), fmaxf(s[kt][2], s[kt][3])));
    mx = fmaxf(mx, __shfl_xor(mx, 16)); mx = fmaxf(mx, __shfl_xor(mx, 32));
    float sum = 0.f;
#pragma unroll
    for (int kt = 0; kt < 16; ++kt) {
#pragma unroll
        for (int j = 0; j < 4; ++j) { const float e = __expf(s[kt][j] - mx); s[kt][j] = e; sum += e; } }
    sum += __shfl_xor(sum, 16); sum += __shfl_xor(sum, 32);
    const float inv = 1.0f / sum;
    bf16x8 pf[8];
#pragma unroll
    for (int kk = 0; kk < 8; ++kk) pf[kk] = pack8(s[2 * kk], s[2 * kk + 1]);
    bf16* O = WSP(bf16, WS_O) + (size_t)R * D + h * 512 + 4 * g;
#pragma unroll
    for (int dt = 0; dt < 32; ++dt) { f32x4 o = (f32x4){0.f, 0.f, 0.f, 0.f};
        if (dt + 1 < 32) VLOAD(dt + 1);
        SCHED_FENCE();
#pragma unroll
        for (int kk = 0; kk < 8; ++kk) { v4u w; w.x = vbuf[dt & 1][2 * kk].x; w.y = vbuf[dt & 1][2 * kk].y; w.z = vbuf[dt & 1][2 * kk + 1].x; w.w = vbuf[dt & 1][2 * kk + 1].y; o = MFMA16(__builtin_bit_cast(bf16x8, w), pf[kk], o); }
        o = o * inv;
        { v2u w; w.x = pg8::cvt_pk_bf16(o[0], o[1]); w.y = pg8::cvt_pk_bf16(o[2], o[3]); *(GAS v2u*)(O + dt * 16) = w; }
        SCHED_FENCE(); }
#undef VLOAD
}
constexpr int AT_ML = 0, AT_PF = 1024;
__device__ __forceinline__ void attn_sample_wg(Frame& F, const Args& A, int b, int h) {
    const int lane = F.lane, w = F.wave, c16 = lane & 15, g = lane >> 4;
    LAS float* ML = (LAS float*)(F.lds + AT_ML); LAS v4u* PF = (LAS v4u*)(F.lds + AT_PF);
    const int R = MP + b * TS + (c16 & 7); const bool qvalid = c16 < 8;
    const bf16* Q = WSP(bf16, WS_Q) + (size_t)R * D + h * 512;
    bf16x8 qf[16];
#pragma unroll
    for (int ks = 0; ks < 16; ++ks) qf[ks] = *(const GAS bf16x8*)(Q + ks * 32 + 8 * g);
    const GAS char* kb = (const GAS char*)(INP(I_CK) + (size_t)(b * NMEM + 32 * w) * D + h * 512); const unsigned ko = (unsigned)(c16 * D + 8 * g) * 4u;
    f32x4 s[2]; f32x4 kbuf[2][16];
#define KLOAD(step_) do { const int t_ = (step_) >> 1, hf_ = (step_) & 1; _Pragma("unroll") for (int i = 0; i < 8; ++i) { \
        kbuf[(step_) & 1][2 * i] = *(const GAS f32x4*)(kb + (size_t)t_ * 16 * D * 4 + ko + (hf_ * 8 + i) * 128); kbuf[(step_) & 1][2 * i + 1] = *(const GAS f32x4*)(kb + (size_t)t_ * 16 * D * 4 + ko + (hf_ * 8 + i) * 128 + 16); } } while (0)
    KLOAD(0);
#pragma unroll
    for (int step = 0; step < 4; ++step) { const int t = step >> 1, hf = step & 1;
        if (step + 1 < 4) KLOAD(step + 1);
        SCHED_FENCE();
        if (hf == 0) s[t] = (f32x4){0.f, 0.f, 0.f, 0.f};
#pragma unroll
        for (int i = 0; i < 8; ++i) s[t] = MFMA16(pack8(kbuf[step & 1][2 * i], kbuf[step & 1][2 * i + 1]), qf[hf * 8 + i], s[t]);
        SCHED_FENCE(); }
#undef KLOAD
    const GAS char* vb = (const GAS char*)(INP(I_CV) + (size_t)(b * NMEM) * D + h * 512); const unsigned vo2 = (unsigned)(4 * g * D + c16) * 4u;
    float vbuf[2][64];
#define VLOAD(i_) do { const int dt_ = 4 * w + (i_); _Pragma("unroll") for (int kk = 0; kk < 8; ++kk) { const GAS char* v0 = vb + (size_t)(kk * 32) * D * 4 + dt_ * 64 + vo2; \
        _Pragma("unroll") for (int j = 0; j < 4; ++j) { vbuf[(i_) & 1][kk * 8 + j] = *(const GAS float*)(v0 + (size_t)j * D * 4); vbuf[(i_) & 1][kk * 8 + 4 + j] = *(const GAS float*)(v0 + (size_t)(16 + j) * D * 4); } } } while (0)
    VLOAD(0);
    float mx = fmaxf(fmaxf(fmaxf(s[0][0], s[0][1]), fmaxf(s[0][2], s[0][3])), fmaxf(fmaxf(s[1][0], s[1][1]), fmaxf(s[1][2], s[1][3])));
    mx = fmaxf(mx, __shfl_xor(mx, 16)); mx = fmaxf(mx, __shfl_xor(mx, 32));
    float sum = 0.f;
#pragma unroll
    for (int t = 0; t < 2; ++t)
#pragma unroll
        for (int j = 0; j < 4; ++j) { const float e = __expf(s[t][j] - mx); s[t][j] = e; sum += e; }
    sum += __shfl_xor(sum, 16); sum += __shfl_xor(sum, 32);
    if (g == 0) { ML[(w * 16 + c16) * 2] = mx; ML[(w * 16 + c16) * 2 + 1] = sum; }
    __syncthreads();
    float gm = -3.0e38f;
#pragma unroll
    for (int ww = 0; ww < 8; ++ww) gm = fmaxf(gm, ML[(ww * 16 + c16) * 2]);
    float tot = 0.f;
#pragma unroll
    for (int ww = 0; ww < 8; ++ww) tot += ML[(ww * 16 + c16) * 2 + 1] * __expf(ML[(ww * 16 + c16) * 2] - gm);
    const float f = __expf(mx - gm), inv = 1.0f / tot;
    { const bf16x8 pk = pack8(s[0] * f, s[1] * f); PF[w * 64 + lane] = __builtin_bit_cast(v4u, pk); }
    __syncthreads();
    bf16x8 pf[8];
#pragma unroll
    for (int kk = 0; kk < 8; ++kk) pf[kk] = __builtin_bit_cast(bf16x8, PF[kk * 64 + lane]);
    bf16* O = WSP(bf16, WS_O) + (size_t)R * D + h * 512 + 4 * g;
#pragma unroll
    for (int i = 0; i < 4; ++i) { const int dt = 4 * w + i; f32x4 o = (f32x4){0.f, 0.f, 0.f, 0.f};
        if (i + 1 < 4) VLOAD(i + 1);
        SCHED_FENCE();
#pragma unroll
        for (int kk = 0; kk < 8; ++kk) { const float* vv = &vbuf[i & 1][kk * 8]; o = MFMA16(pack8((f32x4){vv[0], vv[1], vv[2], vv[3]}, (f32x4){vv[4], vv[5], vv[6], vv[7]}), pf[kk], o); }
        o = o * inv;
        if (qvalid) { v2u wv; wv.x = pg8::cvt_pk_bf16(o[0], o[1]); wv.y = pg8::cvt_pk_bf16(o[2], o[3]); *(GAS v2u*)(O + dt * 16) = wv; }
        SCHED_FENCE(); }
#undef VLOAD
    __syncthreads();
}
__device__ __forceinline__ void p8_attention(Frame& F, const Args& A) {
    const int f = F.wave * F.G + F.vcu, NF = F.G * NWAVES;
    for (int it = blockIdx.x; it < NBS * 4; it += F.G) attn_sample_wg(F, A, it >> 2, it & 3);
    for (int it = f; it < NBP * 4 * (TP / 16); it += NF) attn_prompt_item(F, A, it >> 9, (it >> 7) & 3, it & 127);
}

__device__ __forceinline__ float conv4(const float* cur, int t, const float* st, int sp, float w0, float w1, float w2, float w3, float bias) {
    const float x3 = cur[0];
    const float x2 = t >= 1 ? cur[-(ptrdiff_t)DINP] : (st ? st[2 * sp] : 0.f);
    const float x1 = t >= 2 ? cur[-(ptrdiff_t)2 * DINP] : (st ? st[(t + 1) * sp] : 0.f);
    const float x0 = t >= 3 ? cur[-(ptrdiff_t)3 * DINP] : (st ? st[t * sp] : 0.f);
    return bias + w0 * x0 + w1 * x1 + w2 * x2 + w3 * x3;
}
constexpr int LR_U32 = 0, LR_A32 = 32768, LR_UB = 65536, LR_UBP = 136;
template <bool SAMPLE>
__device__ __forceinline__ void lru_item(Frame& F, const Args& A, int sidx, int h) {
    LAS float* U32 = (LAS float*)(F.lds + LR_U32); LAS float* A32 = (LAS float*)(F.lds + LR_A32); LAS bf16* UB = (LAS bf16*)(F.lds + LR_UB);
    const int tid = F.tid, lane = F.lane, w = F.wave, c16 = lane & 15, g = lane >> 4;
    const float* P = WSP(float, WS_PROJ);
    const bf16* WL = WSP(bf16, WS_WL) + (size_t)h * 256 * 128;
    bf16x8 ba[4], bx[4];
#pragma unroll
    for (int ks = 0; ks < 4; ++ks) { ba[ks] = *(const GAS bf16x8*)(WL + (size_t)(16 * w + c16) * 128 + ks * 32 + 8 * g); bx[ks] = *(const GAS bf16x8*)(WL + (size_t)(128 + 16 * w + c16) * 128 + ks * 32 + 8 * g); }
    const int mcol = 16 * w + c16, mch = h * 128 + mcol;
    const float b_a = INP(I_LBA)[mch], b_x = INP(I_LBX)[mch], cl = -8.0f * softplus_f(-INP(I_LLAM)[mch]);
    const int tq = w >> 1, cc = (w & 1) * 64 + lane, ch = h * 128 + cc;
    const unsigned voffx = (unsigned)(C_XL + ch) * 4u, voffg = (unsigned)(C_GL + h * 128 + 2 * lane) * 4u;
    const float cw0 = INP(I_LCW)[ch], cw1 = INP(I_LCW)[D + ch], cw2 = INP(I_LCW)[2 * D + ch], cw3 = INP(I_LCW)[3 * D + ch], cb = INP(I_LCB)[ch];
    float hstate = 0.f;
    const int nchunk = SAMPLE ? 1 : TP / 64;
    float raw[22];
#define LDG_F32(base_, voff_) (*(const GAS float*)((const GAS char*)(base_) + (voff_)))
#define LRU_ISSUE(chunk_) do { \
        if (SAMPLE) { \
            _Pragma("unroll") for (int q = 0; q < 2; ++q) { const int sq_ = sidx * 8 + tq * 2 + q; \
                _Pragma("unroll") for (int k = 0; k < 3; ++k) raw[q * 11 + k] = LDG_F32(INP(I_SLC) + (size_t)(sq_ * 3 + k) * D, (unsigned)ch * 4u); \
                _Pragma("unroll") for (int t = 0; t < 8; ++t) raw[q * 11 + 3 + t] = LDG_F32(P + (size_t)(MP + sq_ * 8 + t) * DINP, voffx); } \
        } else { \
            const int R0_ = sidx * TP + (chunk_) * 64 + tq * 16; \
            _Pragma("unroll") for (int i = 0; i < 19; ++i) { const bool ok = ((chunk_) > 0 || tq > 0 || i >= 3); raw[i] = ok ? LDG_F32(P + (size_t)(R0_ - 3 + i) * DINP, voffx) : 0.f; } \
        } } while (0)
    LRU_ISSUE(0);
    for (int chunk = 0; chunk < nchunk; ++chunk) {
        int ln_ = lane; asm volatile("" : "+v"(ln_));
        const int lane = ln_, c16 = lane & 15, g = lane >> 4, cc = (w & 1) * 64 + lane, mcol = 16 * w + c16;
        const int R0 = SAMPLE ? MP + sidx * 64 : sidx * TP + chunk * 64;
        f32x2 gg[8];
#pragma unroll
        for (int i = 0; i < 8; ++i) gg[i] = *(const GAS f32x2*)((const GAS char*)(P + (size_t)(R0 + 8 * w + i) * DINP) + voffg);
#pragma unroll
        for (int i = 0; i < 16; ++i) { const int r = tq * 16 + i; const int o = SAMPLE ? (i >> 3) * 11 + (i & 7) : i;
            const float u = cb + cw0 * raw[o] + cw1 * raw[o + 1] + cw2 * raw[o + 2] + cw3 * raw[o + 3];
            U32[r * 128 + cc] = u; UB[r * LR_UBP + cc] = (bf16)f2bf(u); }
        if (chunk + 1 < nchunk) LRU_ISSUE(chunk + 1);
        __syncthreads();
        f32x4 ra[4], rx[4];
#pragma unroll
        for (int m = 0; m < 4; ++m) { ra[m] = (f32x4){0.f, 0.f, 0.f, 0.f}; rx[m] = (f32x4){0.f, 0.f, 0.f, 0.f};
#pragma unroll
            for (int ks = 0; ks < 4; ++ks) { const bf16x8 af = *(const LAS bf16x8*)(UB + (16 * m + c16) * LR_UBP + ks * 32 + 8 * g); ra[m] = MFMA16(af, ba[ks], ra[m]); rx[m] = MFMA16(af, bx[ks], rx[m]); } }
#pragma unroll
        for (int m = 0; m < 4; ++m)
#pragma unroll
            for (int j = 0; j < 4; ++j) { const int r = 16 * m + 4 * g + j; const float rr = sigmoid_f(ra[m][j] + b_a), ii = sigmoid_f(rx[m][j] + b_x), la = cl * rr;
                const float a = __expf(la), mult = sqrtf(-expm1f(2.0f * la)); const float u = U32[r * 128 + mcol]; A32[r * 128 + mcol] = a; U32[r * 128 + mcol] = mult * ii * u; }
        __syncthreads();
        if (tid < 128) {
#pragma unroll 8
            for (int r = 0; r < 64; ++r) {
                if (SAMPLE && (r & 7) == 0) hstate = INP(I_SLH)[(size_t)(sidx * 8 + (r >> 3)) * D + h * 128 + tid];
                hstate = A32[r * 128 + tid] * hstate + U32[r * 128 + tid]; U32[r * 128 + tid] = hstate;
                if (SAMPLE && (r & 7) == 7) F.out[O_SLH + (size_t)(sidx * 8 + (r >> 3)) * D + h * 128 + tid] = hstate; }
            if (!SAMPLE && chunk == nchunk - 1) F.out[O_PLH + (size_t)sidx * D + h * 128 + tid] = hstate;
        }
        __syncthreads();
#pragma unroll
        for (int i = 0; i < 8; ++i) { const int r = 8 * w + i, R = R0 + r;
            const float h0 = U32[r * 128 + 2 * lane], h1 = U32[r * 128 + 2 * lane + 1];
            const float v0 = h0 * gelu_tanh_f(gg[i].x), v1 = h1 * gelu_tanh_f(gg[i].y);
            *(GAS unsigned*)(WSP(bf16, WS_V) + (size_t)R * DMIX + h * 128 + 2 * lane) = pk2(v0, v1);
            const float q = wave_sum(v0 * v0 + v1 * v1); if (lane == 0) WSP(float, WS_SQV)[(size_t)R * NSQV + h] = q; }
        __syncthreads();
    }
}
constexpr int SD_CS = 0, SD_DT = 256, SD_WG = 512, SD_CM = 1024, SD_BM = 18432, SD_BT = 35840, SD_XT = 54272, SD_XS = 63488, SD_HB = 72704, SD_XF = 90112;
constexpr int SP136 = 136, SP72 = 72, SP68 = 68;
template <int L  >
__device__ __forceinline__ void ssd_item(Frame& F, const Args& A, int sq, int head) {
    constexpr bool SAMPLE = (L == 16); constexpr int LT = L / 16, KK = (L + 31) / 32, TV = SAMPLE ? TS : L;
    LAS float* CS = (LAS float*)(F.lds + SD_CS); LAS float* DT = (LAS float*)(F.lds + SD_DT); LAS float* WG = (LAS float*)(F.lds + SD_WG);
    LAS bf16* CM = (LAS bf16*)(F.lds + SD_CM); LAS bf16* BM = (LAS bf16*)(F.lds + SD_BM); LAS bf16* BT = (LAS bf16*)(F.lds + SD_BT);
    LAS bf16* XT = (LAS bf16*)(F.lds + SD_XT); LAS bf16* XS = (LAS bf16*)(F.lds + SD_XS); LAS bf16* HB = (LAS bf16*)(F.lds + SD_HB); LAS float* XF = (LAS float*)(F.lds + SD_XF);
    const int tid = F.tid, lane = F.lane, w = F.wave, c16 = lane & 15, g = lane >> 4, grp = head >> 4;
    const float* P = WSP(float, WS_PROJ);
    const float Aneg = -__expf(INP(I_SALOG)[head]), dtb = INP(I_SDTB)[head], Dh = INP(I_SD)[head];
    const int hpt = w & 3, hnt0 = 4 * (w >> 2);
    f32x4 Hacc[4];
    const size_t hbase = ((size_t)(sq * SSD_H + head) * SSD_P) * SSD_N;
#pragma unroll
    for (int i = 0; i < 4; ++i)
#pragma unroll
        for (int j = 0; j < 4; ++j) Hacc[i][j] = SAMPLE ? INP(I_SSH)[hbase + (size_t)(16 * hpt + 4 * g + j) * SSD_N + 16 * (hnt0 + i) + c16] : 0.f;
    const int cgb = lane, rbb = w, gx = lane & 15, rsub = lane >> 4, rp = 4 * w + rsub;
    const int xcb = 2048 + (cgb >> 5) * 256 + grp * 128 + 4 * (cgb & 31), xcx = head * 64 + 4 * gx;
    const bool actB = SAMPLE ? (w < 2) : true, actX = SAMPLE ? (w < 2) : true;
    const unsigned voffb = (unsigned)(C_XBC + xcb) * 4u, voffxx = (unsigned)(rsub * 2 * DINP + C_XBC + xcx) * 4u, voffxs = (unsigned)(rsub * 2 * XBC + xcx) * 4u;
    f32x4 wB[4], wX[4], bB, bX;
#pragma unroll
    for (int k = 0; k < 4; ++k) { wB[k] = *(const GAS f32x4*)(INP(I_SCW) + (size_t)k * XBC + xcb); wX[k] = *(const GAS f32x4*)(INP(I_SCW) + (size_t)k * XBC + xcx); }
    bB = *(const GAS f32x4*)(INP(I_SCB) + xcb); bX = *(const GAS f32x4*)(INP(I_SCB) + xcx);
    f32x4 rawB[11], rawX[5]; float rawdt = 0.f;
#define SSD_LDROW(dst_, chunk_, rr_, rl_, vp_, vs_) do { const int rr__ = (rr_); const int tu__ = SAMPLE ? rr__ : (chunk_) * 64 + rr__; const int tl__ = SAMPLE ? (rl_) : (chunk_) * 64 + (rl_); \
        const GAS char* pb__ = (const GAS char*)(P + (size_t)((SAMPLE ? MP + sq * TS : sq * TP + (chunk_) * 64) + rr__) * DINP); \
        const GAS char* sb__ = (const GAS char*)(INP(I_SSC) + (size_t)(sq * 3 + 3 + tu__) * XBC); \
        if ((rl_) >= TV) dst_ = (f32x4){0.f, 0.f, 0.f, 0.f}; \
        else if (tl__ >= 0) dst_ = *(const GAS f32x4*)(pb__ + (vp_)); \
        else if (SAMPLE) dst_ = *(const GAS f32x4*)(sb__ + (vs_)); \
        else dst_ = (f32x4){0.f, 0.f, 0.f, 0.f}; } while (0)
#define SSD_ISSUE(chunk_) do { \
        if (actB) { _Pragma("unroll") for (int i = 0; i < 11; ++i) SSD_LDROW(rawB[i], chunk_, 8 * rbb - 3 + i, 8 * rbb - 3 + i, voffb, (unsigned)xcb * 4u); } \
        if (actX) { _Pragma("unroll") for (int i = 0; i < 5; ++i) SSD_LDROW(rawX[i], chunk_, 8 * w - 3 + i, 2 * rp - 3 + i, voffxx, voffxs); } \
        if (w == 0) { const int r_ = lane; const int R_ = SAMPLE ? MP + sq * TS + r_ : sq * TP + (chunk_) * 64 + r_; rawdt = (r_ < TV) ? P[(size_t)R_ * DINP + C_DT + head] : 0.f; } } while (0)
    SSD_ISSUE(0);
#pragma unroll
    for (int i = 0; i < 4; ++i)
#pragma unroll
        for (int j = 0; j < 4; ++j) HB[(16 * hpt + 4 * g + j) * SP136 + 16 * (hnt0 + i) + c16] = (bf16)f2bf(Hacc[i][j]);
    if (SAMPLE) {
        for (int e = tid; e < 64 * 16; e += 512) { const int p = e >> 4, c = 16 + (e & 15); XT[p * SP72 + c] = 0; XS[p * SP72 + c] = 0; }
        for (int e = tid; e < 128 * 16; e += 512) { const int n = e >> 4, c = 16 + (e & 15); BT[n * SP72 + c] = 0; }
    }
    const int nchunk = SAMPLE ? 1 : TP / 64;
    for (int chunk = 0; chunk < nchunk; ++chunk) {
        int ln_ = lane; asm volatile("" : "+v"(ln_));
        const int lane = ln_, c16 = lane & 15, g = lane >> 4, cgb = lane, gx = lane & 15, rsub = lane >> 4, rp = 4 * w + rsub;
        const int R0 = SAMPLE ? MP + sq * TS : sq * TP + chunk * 64;
        const int lt_ = (L == 64) ? (w & 3) : 0, l_ = 16 * lt_ + c16; constexpr int NPT = (L == 64) ? 2 : 1; const int pt0_ = (L == 64) ? 2 * (w >> 2) : (w & 3);
        f32x4 z4[NPT];
#pragma unroll
        for (int pi = 0; pi < NPT; ++pi) { z4[pi] = (f32x4){0.f, 0.f, 0.f, 0.f}; if (l_ < TV) z4[pi] = *(const GAS f32x4*)(P + (size_t)(R0 + l_) * DINP + C_Z + head * 64 + 16 * (pt0_ + pi) + 4 * g); }
        if (actB) {
#pragma unroll
            for (int i = 0; i < 8; ++i) { const int r = 8 * rbb + i; f32x4 v = bB + wB[0] * rawB[i] + wB[1] * rawB[i + 1] + wB[2] * rawB[i + 2] + wB[3] * rawB[i + 3];
                if (r >= TV) v = (f32x4){0.f, 0.f, 0.f, 0.f}; else { v[0] = siluf_(v[0]); v[1] = siluf_(v[1]); v[2] = siluf_(v[2]); v[3] = siluf_(v[3]); }
                v2u pk; pk.x = pk2(v[0], v[1]); pk.y = pk2(v[2], v[3]); const int n = 4 * (cgb & 31);
                if (cgb < 32) { *(LAS v2u*)(BM + r * SP136 + n) = pk; BT[(n + 0) * SP72 + r] = (bf16)(pk.x & 0xffffu); BT[(n + 1) * SP72 + r] = (bf16)(pk.x >> 16); BT[(n + 2) * SP72 + r] = (bf16)(pk.y & 0xffffu); BT[(n + 3) * SP72 + r] = (bf16)(pk.y >> 16); }
                else *(LAS v2u*)(CM + r * SP136 + n) = pk; } }
        if (actX) {
#pragma unroll
            for (int i = 0; i < 2; ++i) { const int r = 2 * rp + i; f32x4 v = bX + wX[0] * rawX[i] + wX[1] * rawX[i + 1] + wX[2] * rawX[i + 2] + wX[3] * rawX[i + 3];
                if (r >= TV) v = (f32x4){0.f, 0.f, 0.f, 0.f}; else { v[0] = siluf_(v[0]); v[1] = siluf_(v[1]); v[2] = siluf_(v[2]); v[3] = siluf_(v[3]); }
                *(LAS f32x4*)(XF + r * SP68 + 4 * gx) = v; const unsigned p0 = pk2(v[0], v[1]), p1 = pk2(v[2], v[3]); const int p = 4 * gx;
                XT[(p + 0) * SP72 + r] = (bf16)(p0 & 0xffffu); XT[(p + 1) * SP72 + r] = (bf16)(p0 >> 16); XT[(p + 2) * SP72 + r] = (bf16)(p1 & 0xffffu); XT[(p + 3) * SP72 + r] = (bf16)(p1 >> 16); } }
        if (w == 0) { const int r = lane; float dt = 0.f;
            if (r < TV) dt = softplus_f(rawdt + dtb);
            float cs = dt * Aneg;
#pragma unroll
            for (int o = 1; o < 64; o <<= 1) { const float up = __shfl_up(cs, o); if (lane >= o) cs += up; }
            const float csl = __shfl(cs, L - 1);
            if (r < L) { CS[r] = cs; DT[r] = dt; WG[r] = __expf(csl - cs) * dt; } }
        if (chunk + 1 < nchunk) SSD_ISSUE(chunk + 1);
        __syncthreads();
        for (int e = tid; e < 64 * L; e += 512) { const int p = e & 63, l = e >> 6; XS[p * SP72 + l] = (bf16)f2bf(XF[l * SP68 + p] * WG[l]); }
        __syncthreads();
        if (L == 64 || w < 4) {
            const int l = l_, pt0 = pt0_;
            bf16x8 cf[4];
#pragma unroll
            for (int ks = 0; ks < 4; ++ks) cf[ks] = *(const LAS bf16x8*)(CM + l * SP136 + ks * 32 + 8 * g);
            const float cs_l = CS[l];
            f32x4 gt[2 * KK];
#pragma unroll
            for (int st = 0; st < 2 * KK; ++st) { gt[st] = (f32x4){0.f, 0.f, 0.f, 0.f};
                if (st < LT) {
#pragma unroll
                    for (int ks = 0; ks < 4; ++ks) { const bf16x8 af = *(const LAS bf16x8*)(BM + (16 * st + c16) * SP136 + ks * 32 + 8 * g); gt[st] = MFMA16(af, cf[ks], gt[st]); }
#pragma unroll
                    for (int j = 0; j < 4; ++j) { const int s = 16 * st + 4 * g + j; gt[st][j] = (s <= l) ? gt[st][j] * __expf(cs_l - CS[s]) * DT[s] : 0.f; } } }
            bf16x8 wf[KK];
#pragma unroll
            for (int kk = 0; kk < KK; ++kk) wf[kk] = pack8(gt[2 * kk], gt[2 * kk + 1]);
            const float ecl = __expf(cs_l); const bool valid = (l < TV); const int R = R0 + l;
#pragma unroll
            for (int pi = 0; pi < NPT; ++pi) { const int pt = pt0 + pi; f32x4 a1 = (f32x4){0.f, 0.f, 0.f, 0.f}, a2 = (f32x4){0.f, 0.f, 0.f, 0.f};
#pragma unroll
                for (int kk = 0; kk < KK; ++kk) { const v2u lo = *(const LAS v2u*)(XT + (16 * pt + c16) * SP72 + 32 * kk + 4 * g), hi = *(const LAS v2u*)(XT + (16 * pt + c16) * SP72 + 32 * kk + 16 + 4 * g);
                    v4u wv; wv.x = lo.x; wv.y = lo.y; wv.z = hi.x; wv.w = hi.y; a1 = MFMA16(__builtin_bit_cast(bf16x8, wv), wf[kk], a1); }
#pragma unroll
                for (int ks = 0; ks < 4; ++ks) { const bf16x8 af = *(const LAS bf16x8*)(HB + (16 * pt + c16) * SP136 + ks * 32 + 8 * g); a2 = MFMA16(af, cf[ks], a2); }
                const f32x4 x4 = *(const LAS f32x4*)(XF + l * SP68 + 16 * pt + 4 * g);
                float v[4], q = 0.f;
#pragma unroll
                for (int j = 0; j < 4; ++j) { const float y = a1[j] + ecl * a2[j] + Dh * x4[j]; v[j] = y * siluf_(z4[pi][j]); q += v[j] * v[j]; }
                q += __shfl_xor(q, 16); q += __shfl_xor(q, 32);
                if (valid) { v2u o; o.x = pk2(v[0], v[1]); o.y = pk2(v[2], v[3]); *(GAS v2u*)(WSP(bf16, WS_V) + (size_t)R * DMIX + 2048 + head * 64 + 16 * pt + 4 * g) = o;
                    if (g == 0) WSP(float, WS_SQV)[(size_t)R * NSQV + 16 + head * 4 + pt] = q; } }
        }
        __syncthreads();
        { const float dec = __expf(CS[L - 1]);
#pragma unroll
          for (int i = 0; i < 4; ++i) Hacc[i] = Hacc[i] * dec;
#pragma unroll
          for (int kk = 0; kk < KK; ++kk) { const bf16x8 af = *(const LAS bf16x8*)(XS + (16 * hpt + c16) * SP72 + 32 * kk + 8 * g);
#pragma unroll
              for (int i = 0; i < 4; ++i) { const bf16x8 bfr = *(const LAS bf16x8*)(BT + (16 * (hnt0 + i) + c16) * SP72 + 32 * kk + 8 * g); Hacc[i] = MFMA16(af, bfr, Hacc[i]); } }
          if (chunk + 1 < nchunk) {
#pragma unroll
              for (int i = 0; i < 4; ++i)
#pragma unroll
                  for (int j = 0; j < 4; ++j) HB[(16 * hpt + 4 * g + j) * SP136 + 16 * (hnt0 + i) + c16] = (bf16)f2bf(Hacc[i][j]); } }
        __syncthreads();
    }
    float* ho = F.out + (SAMPLE ? O_SSH : O_PSH) + hbase;
#pragma unroll
    for (int i = 0; i < 4; ++i)
#pragma unroll
        for (int j = 0; j < 4; ++j) ho[(size_t)(16 * hpt + 4 * g + j) * SSD_N + 16 * (hnt0 + i) + c16] = Hacc[i][j];
}
__device__ __forceinline__ void p4_mixer(Frame& F, const Args& A, int qoff) {
    const int bid = blockIdx.x;
    for (int it = bid; it < 64 + 128; it += F.G) {
        if (it < 64) lru_item<false>(F, A, it >> 4, it & 15); else ssd_item<64>(F, A, (it - 64) >> 5, (it - 64) & 31);
    }
    for (;;) {
        __syncthreads();
        if (F.tid == 0) F.MISC[0] = __hip_atomic_fetch_add(F.ctl + CW_QUEUE + qoff, 1u, RLX_AGENT);
        __syncthreads();
        const int it = (int)F.MISC[0];
        if (it >= 256 + NBS * SSD_H) break;
        if (it < 256) lru_item<true>(F, A, it >> 4, it & 15); else ssd_item<16>(F, A, (it - 256) >> 5, (it - 256) & 31);
    }
}

#ifndef DUP_PHASE
#define DUP_PHASE -1
#endif
#ifndef MK_PER_PHASE
#define MK_PER_PHASE 0
#endif
constexpr int N_PHASES = 13;
template <class Epi> __device__ __forceinline__ void run_gemm(Frame& F, const bf16* Aop, const bf16* Bt, int Mr, int N, int K, const Epi& E, int c) {
    pg8::Gemm g{Aop, Bt, Mr, N, K}; pg8::StaticOrder S; S.init(Mr, N, F.G, c);
    pg8::gemm_phase<Epi, pg8::StaticOrder, PG8_ALIGN, PG8_SP2>(F.lds + RING_OFF, g, S, E);
}
__global__ void __launch_bounds__(NWAVES * 64, 2) hymba_fwd(Args args) {
    extern __shared__ __attribute__((aligned(16))) unsigned char lds[];
    const Args& A = args;
    Frame F;
    F.lds = (LAS unsigned char*)lds;
    F.MISC = (volatile LAS unsigned*)(F.lds + MISC_OFF);
    F.tid = threadIdx.x; F.lane = F.tid & 63; F.wave = __builtin_amdgcn_readfirstlane(F.tid >> 6);
    F.G = gridDim.x; { const int bx = blockIdx.x; F.vcu = (F.G % 8 == 0) ? (bx % 8) * (F.G / 8) + bx / 8 : bx; }
    F.ws = args.ws; F.out = args.out; F.ctl = (gu32*)(args.ws + WS_CTL);
    for (int u = F.tid; u < (LDS_BYTES - LDSCTL_OFF) / 4; u += NWAVES * 64) ((LAS unsigned*)(F.lds + LDSCTL_OFF))[u] = 0u;
    __syncthreads();
    XcdBarrier bar; bar.bar = (unsigned*)(F.ctl + CW_BAR); bar.x = 0; bar.st = nullptr;
    if (!MK_PER_PHASE) bar = xcd_barrier_post((unsigned*)(F.ctl + CW_BAR), F.MISC + 8);
#define GRID_BAR() do { if (!MK_PER_PHASE) xcd_barrier(bar); } while (0)
    const int lo = args.ph_lo, hi = args.ph_hi;
#define IN(k) (lo <= (k) && (k) < hi)
#define BOTH(k) (IN(k) && IN((k) + 1))
    const int bid = blockIdx.x;
    float* SSQ0 = WSP(float, WS_SSQ); float* SSQ1 = SSQ0 + (size_t)M * NSSQ; float* SSQ2 = SSQ1 + (size_t)M * NSSQ; float* SSQ3 = SSQ2 + (size_t)M * NSSQ; float* SSQ4 = SSQ3 + (size_t)M * NSSQ;

    if (IN(0)) { p0_prologue(F, A); if (BOTH(0)) GRID_BAR(); }
#if DUP_PHASE == 0
    { p0_prologue(F, A); GRID_BAR(); }
#endif
    if (IN(1)) {
        { pg8::EpiSwiglu E{WSP(bf16, WS_ACT), FF, SSQ0}; run_gemm(F, WSP(bf16, WS_XBA), WSP(bf16, WS_W1GU), M, NGU, D, E, bid); }
        { pg8::EpiKV E{F.out + O_PMK, F.out + O_PMV, WSP(bf16, WS_KM), WSP(bf16, WS_VT), WSP(float, WS_SSQM)}; run_gemm(F, WSP(bf16, WS_MEMB), WSP(bf16, WS_WKV), MMEM, 2 * D, D, E, (bid + F.G - (F.G * 3) / 4) % F.G); }
        if (BOTH(1)) GRID_BAR(); }
    if (IN(2)) {
        pg8::EpiRes<true, true> E{INP(I_XP), INP(I_XS), WSP(float, WS_XR), WSP(bf16, WS_XBB), SSQ1, 0.5f}; run_gemm(F, WSP(bf16, WS_ACT), WSP(bf16, WS_W1D), M, D, FF, E, bid);
        if (BOTH(2)) GRID_BAR(); }
    if (IN(3)) {
        pg8::EpiProj E{WSP(float, WS_PROJ), DINP, SSQ1}; run_gemm(F, WSP(bf16, WS_XBB), WSP(bf16, WS_WIN), M, DINP, D, E, bid);
        if (BOTH(3)) GRID_BAR(); }
    if (IN(4)) { p4_mixer(F, A, 0); if (BOTH(4)) GRID_BAR(); }
#if DUP_PHASE == 4
    { p4_mixer(F, A, 64); GRID_BAR(); }
#endif
    if (IN(5)) { p5_normalize(F, A); if (BOTH(5)) GRID_BAR(); }
    if (IN(6)) {
        pg8::EpiRes<false, true> E{nullptr, nullptr, WSP(float, WS_XR), WSP(bf16, WS_XBA), SSQ2, 1.0f}; run_gemm(F, WSP(bf16, WS_V), WSP(bf16, WS_WOUT), M, D, DMIX, E, bid);
        if (BOTH(6)) GRID_BAR(); }
    if (IN(7)) {
        pg8::EpiQ E{WSP(bf16, WS_Q), SSQ2, 0.04419417382415922f}; run_gemm(F, WSP(bf16, WS_XBA), WSP(bf16, WS_WQ), M, D, D, E, bid);
        if (BOTH(7)) GRID_BAR(); }
    if (IN(8)) { p8_attention(F, A); if (BOTH(8)) GRID_BAR(); }
#if DUP_PHASE == 8
    { p8_attention(F, A); GRID_BAR(); }
#endif
    if (IN(9)) {
        pg8::EpiRes<false, true> E{nullptr, nullptr, WSP(float, WS_XR), WSP(bf16, WS_XBB), SSQ3, 1.0f}; run_gemm(F, WSP(bf16, WS_O), WSP(bf16, WS_WO), M, D, D, E, bid);
        if (BOTH(9)) GRID_BAR(); }
    if (IN(10)) {
        pg8::EpiSwiglu E{WSP(bf16, WS_ACT), FF, SSQ3}; run_gemm(F, WSP(bf16, WS_XBB), WSP(bf16, WS_W2GU), M, NGU, D, E, bid);
        if (BOTH(10)) GRID_BAR(); }
    if (IN(11)) {
        pg8::EpiRes<false, false> E{nullptr, nullptr, WSP(float, WS_XR), nullptr, SSQ4, 0.5f}; run_gemm(F, WSP(bf16, WS_ACT), WSP(bf16, WS_W2D), M, D, FF, E, bid);
        if (BOTH(11)) GRID_BAR(); }
    if (IN(12)) { p12_final(F, A); }
#undef IN
#undef BOTH
}

extern "C" void kernel_launch(void* const* d_in, const int* in_sizes, int n_in, void* d_out, int out_size, void* d_ws, size_t ws_size, hipStream_t stream) {
    static int grid = 0;
    if (grid == 0) {
        if (n_in != N_IN || (size_t)out_size != O_END || ws_size < WS_END) { fprintf(stderr, "kernel_launch: shape mismatch: n_in %d out %d ws %zu (need %zu)\n", n_in, out_size, ws_size, (size_t)WS_END); grid = -1; return; }
        int dev = 0, cus = 0, per_cu = 0;
        if (hipGetDevice(&dev) != hipSuccess || hipDeviceGetAttribute(&cus, hipDeviceAttributeMultiprocessorCount, dev) != hipSuccess) { grid = -1; return; }
        if (hipFuncSetAttribute((const void*)hymba_fwd, hipFuncAttributeMaxDynamicSharedMemorySize, LDS_BYTES) != hipSuccess) { fprintf(stderr, "kernel_launch: hipFuncSetAttribute failed\n"); grid = -1; return; }
        if (hipOccupancyMaxActiveBlocksPerMultiprocessor(&per_cu, (const void*)hymba_fwd, NWAVES * 64, LDS_BYTES) != hipSuccess || per_cu < 1) { fprintf(stderr, "kernel_launch: occupancy query says %d blocks per CU\n", per_cu); (void)hipGetLastError(); grid = -1; return; }
        grid = cus;
    }
    if (grid < 0) return;
    if (hipMemsetAsync((char*)d_ws + WS_CTL, 0, CTL_ZERO_BYTES, stream) != hipSuccess) return;
    Args a{};
    for (int i = 0; i < N_IN; ++i) a.in[i] = (const float*)d_in[i];
    a.out = (float*)d_out; a.ws = (unsigned char*)d_ws;
#if MK_PER_PHASE
    for (int p = 0; p < N_PHASES; ++p) { a.ph_lo = p; a.ph_hi = p + 1; hipLaunchKernelGGL(hymba_fwd, dim3(grid), dim3(NWAVES * 64), LDS_BYTES, stream, a); }
#else
    a.ph_lo = 0; a.ph_hi = N_PHASES; hipLaunchKernelGGL(hymba_fwd, dim3(grid), dim3(NWAVES * 64), LDS_BYTES, stream, a);
#endif
}
```

```cpp
#include <hip/hip_runtime.h>
#include <cstdio>
#include <cstdint>

constexpr int NWAVES = 8;
constexpr int D = 2048, MP = 8192, MS = 1024, M = MP + MS, TP = 2048, TS = 8, NBP = 4, NBS = 128;
constexpr int FF = 5632, NGU = 2 * FF, DIN = 8736, DINP = 8960, DMIX = 4096, NMEM = 256, MMEM = NBP * NMEM;
constexpr int LRU_H = 16, LRU_B = 128, SSD_H = 32, SSD_P = 64, SSD_N = 128, XBC = 2560;
constexpr int C_XL = 0, C_GL = 2048, C_Z = 4096, C_XBC = 6144, C_DT = 8704;
constexpr float EPS = 1e-6f;
constexpr int NSSQ = 32;
constexpr int NSQV = 144;
constexpr size_t O_Y = 0, O_PLC = (size_t)M * D, O_PLH = O_PLC + (size_t)NBP * 3 * D, O_PSC = O_PLH + (size_t)NBP * D, O_PSH = O_PSC + (size_t)NBP * 3 * XBC,
                 O_PMK = O_PSH + (size_t)NBP * SSD_H * SSD_P * SSD_N, O_PMV = O_PMK + (size_t)MMEM * D, O_SLC = O_PMV + (size_t)MMEM * D, O_SLH = O_SLC + (size_t)NBS * 3 * D,
                 O_SSC = O_SLH + (size_t)NBS * D, O_SSH = O_SSC + (size_t)NBS * 3 * XBC, O_END = O_SSH + (size_t)NBS * SSD_H * SSD_P * SSD_N;
static_assert(O_END == 59766784, "d_out size");
enum { I_XP = 0, I_MEMP, I_XS, I_CK, I_CV, I_SLC, I_SLH, I_SSC, I_SSH, I_F1G, I_F1WG, I_F1WU, I_F1WD, I_MIXG, I_WIN, I_LCW, I_LCB, I_LWA, I_LBA, I_LWX, I_LBX, I_LLAM, I_LOG,
       I_SCW, I_SCB, I_SDTB, I_SALOG, I_SD, I_SOG, I_WOUT, I_XAG, I_MEMG, I_WQ, I_WK, I_WV, I_WO, I_F2G, I_F2WG, I_F2WU, I_F2WD, I_FING, N_IN };
static_assert(N_IN == 41, "inputs");

constexpr size_t MiB = 1u << 20;
constexpr size_t al(size_t x) { return (x + 4095) & ~(size_t)4095; }
constexpr size_t WS_CTL = 0, CTL_ZERO_BYTES = 1 * MiB;
constexpr size_t WS_W1GU = 2 * MiB;
constexpr size_t WS_W1D  = WS_W1GU + al((size_t)NGU * D * 2);
constexpr size_t WS_WIN  = WS_W1D + al((size_t)D * FF * 2);
constexpr size_t WS_WOUT = WS_WIN + al((size_t)DINP * D * 2);
constexpr size_t WS_WQ   = WS_WOUT + al((size_t)D * DMIX * 2);
constexpr size_t WS_WKV  = WS_WQ + al((size_t)D * D * 2);
constexpr size_t WS_WO   = WS_WKV + al((size_t)2 * D * D * 2);
constexpr size_t WS_W2GU = WS_WO + al((size_t)D * D * 2);
constexpr size_t WS_W2D  = WS_W2GU + al((size_t)NGU * D * 2);
constexpr size_t WS_WL   = WS_W2D + al((size_t)D * FF * 2);
constexpr size_t WS_XBA  = WS_WL + al((size_t)LRU_H * 256 * 128 * 2);
constexpr size_t WS_XBB  = WS_XBA + al((size_t)M * D * 2);
constexpr size_t WS_MEMB = WS_XBB + al((size_t)M * D * 2);
constexpr size_t WS_ACT  = WS_MEMB + al((size_t)MMEM * D * 2);
constexpr size_t WS_XR   = WS_ACT + al((size_t)M * FF * 2);
constexpr size_t WS_PROJ = WS_XR + al((size_t)M * D * 4);
constexpr size_t WS_V    = WS_PROJ + al((size_t)M * DINP * 4);
constexpr size_t WS_Q    = WS_V + al((size_t)M * DMIX * 2);
constexpr size_t WS_O    = WS_Q + al((size_t)M * D * 2);
constexpr size_t WS_KM   = WS_O + al((size_t)M * D * 2);
constexpr size_t WS_VT   = WS_KM + al((size_t)MMEM * D * 2);
constexpr size_t WS_SSQ  = WS_VT + al((size_t)MMEM * D * 2);
constexpr size_t WS_SSQM = WS_SSQ + al((size_t)4 * M * NSSQ * 4);
constexpr size_t WS_SQV  = WS_SSQM + al((size_t)MMEM * NSSQ * 4);
constexpr size_t WS_END  = WS_SQV + al((size_t)M * NSQV * 4);
constexpr int CW_TMO = 0, CW_CODE = 1, CW_QUEUE = 64, CW_BAR = 4096;

namespace pg8 {
#define PG8_LAS __attribute__((address_space(3)))
typedef unsigned short bf16_t;
typedef short bf16x8 __attribute__((ext_vector_type(8)));
typedef float f32x4 __attribute__((ext_vector_type(4)));
typedef unsigned u32x4 __attribute__((ext_vector_type(4)));
constexpr int BM = 256, BK = 64, HALF = 128, HTB = HALF * BK * 2  , STAGE_BYTES = 8 * HTB, NXCD = 8, WGM = 8;

__host__ __device__ __forceinline__ int lds_byte(int r, int c) { const int st = (r >> 4) * 2 + (c >> 5), rr = r & 15, cc = c & 31, ob = rr * 64 + cc * 2; return st * 1024 + (ob ^ (((ob >> 9) & 1) << 5)); }
__host__ __device__ __forceinline__ void stage_rc(int b, int& R, int& C) { const int st = b / 1024, sb = b % 1024, swz = sb ^ (((sb >> 9) & 1) << 5); R = (st >> 1) * 16 + swz / 64; C = (st & 1) * 32 + (swz % 64) / 2; }
__host__ __device__ __forceinline__ int perm32(int rho) { const int n = rho >> 4, i = rho & 15; return 8 * (i >> 2) + 4 * n + (i & 3); }

struct Unit { int pm, pn; };
struct Gemm { const bf16_t* A; const bf16_t* Bt; int M, N, K; };

struct StaticOrder {
    int nM, nN, nwg, G, c;
    __host__ __device__ void init(int M, int N, int G_, int c_) { nM = M / BM; nN = N / BM; nwg = nM * nN; G = G_; c = c_; }
    __host__ __device__ bool next(int i, Unit& u) const {
        const long L = (long)i * G + c; if (L >= nwg) return false;
        int wgid = (int)L; { const int q = nwg / NXCD, r = nwg % NXCD, xcd = wgid % NXCD, off = wgid / NXCD; wgid = (xcd < r ? xcd * (q + 1) : r * (q + 1) + (xcd - r) * q) + off; }
        const int nig = WGM * nN, gid = wgid / nig, fm = gid * WGM, gsz = (nM - fm) < WGM ? (nM - fm) : WGM;
        u.pm = fm + ((wgid % nig) % gsz); u.pn = (wgid % nig) / gsz; return true;
    }
    __device__ __forceinline__ void a_ready(const Unit&) const {}
    __device__ __forceinline__ void done(const Unit&) const {}
};

#define PG8_RLX __ATOMIC_RELAXED, __HIP_MEMORY_SCOPE_AGENT
struct QueueOrder {
    int nM, nN, cnt, base, S; unsigned cu;
    unsigned* qhead; volatile PG8_LAS unsigned* slots;
    mutable unsigned pend, taken;
    __device__ __forceinline__ void init(int M, int N, int xq, int& Sx, unsigned cu_, unsigned* qhead_, volatile PG8_LAS unsigned* slots_) {
        nM = M / BM; nN = N / BM; const int nwg = nM * nN;
        if (xq < 0) { base = 0; cnt = nwg; } else { const int q = nwg / NXCD, r = nwg % NXCD; cnt = q + (xq < r ? 1 : 0); base = xq < r ? xq * (q + 1) : r * (q + 1) + (xq - r) * q; }
        S = Sx; Sx += cnt; cu = cu_; qhead = qhead_; slots = slots_; pend = 0u; taken = 0u; }
    __device__ __forceinline__ bool next(int i, Unit& u) const {
        const int L = (int)__builtin_amdgcn_readfirstlane(slots[(cu + (unsigned)i) & 3u]) - S;
        if (L >= cnt) return false;
        const int wgid = base + L, nig = WGM * nN, gid = wgid / nig, fm = gid * WGM, gsz = (nM - fm) < WGM ? (nM - fm) : WGM, rem = wgid - gid * nig;
        u.pm = fm + rem % gsz; u.pn = rem / gsz;
        if (threadIdx.x == 0) pend = __hip_atomic_fetch_add(qhead, 1u, PG8_RLX);
        taken = (unsigned)i + 1u;
        return true;
    }
    __device__ __forceinline__ void a_ready(const Unit&) const {
        if (threadIdx.x == 0) slots[(cu + taken) & 3u] = pend;
        asm volatile("s_waitcnt lgkmcnt(0)" ::: "memory"); __builtin_amdgcn_s_barrier(); asm volatile("" ::: "memory");
    }
    __device__ __forceinline__ void done(const Unit&) const {}
};

struct RangeOrder {
    int nM, nN, lo, n, G, c;
    __device__ __forceinline__ void init(int M, int N, int lo_, int n_, int G_, int c_) { nM = M / BM; nN = N / BM; lo = lo_; n = n_; G = G_; c = c_; }
    __device__ __forceinline__ bool next(int i, Unit& u) const {
        const int Lr = i * G + c; if (c < 0 || c >= G || Lr >= n) return false;
        int w = Lr; { const int q = n / NXCD, r = n % NXCD, xcd = w % NXCD, off = w / NXCD; w = (xcd < r ? xcd * (q + 1) : r * (q + 1) + (xcd - r) * q) + off; }
        const int wgid = lo + w, nig = WGM * nN, gid = wgid / nig, fm = gid * WGM, gsz = (nM - fm) < WGM ? (nM - fm) : WGM, rem = wgid - gid * nig;
        u.pm = fm + rem % gsz; u.pn = rem / gsz; return true;
    }
    __device__ __forceinline__ void a_ready(const Unit&) const {}
    __device__ __forceinline__ void done(const Unit&) const {}
};

__device__ __forceinline__ unsigned cvt_pk_bf16(float lo, float hi) { unsigned r; asm volatile("v_cvt_pk_bf16_f32 %0, %1, %2" : "=v"(r) : "v"(lo), "v"(hi)); return r; }
typedef unsigned u32x2 __attribute__((ext_vector_type(2)));
constexpr float EPS_ = 1e-6f;
__device__ __forceinline__ float row_rstd(const float* ssq, int row, int fq) {
    const f32x4* p = (const f32x4*)(ssq + (size_t)row * 32 + fq * 8);
    const f32x4 a = p[0], b = p[1];
    float s = ((a[0] + a[1]) + (a[2] + a[3])) + ((b[0] + b[1]) + (b[2] + b[3]));
    s += __shfl_xor(s, 16); s += __shfl_xor(s, 32);
    return __builtin_amdgcn_rsqf(s * (1.0f / 2048.0f) + EPS_);
}
__device__ __forceinline__ float silu_f(float x) { return x * __builtin_amdgcn_rcpf(1.0f + __expf(-x)); }

struct EpiSwiglu {
    static constexpr bool PERM = true, AFTER_DRAIN = false;
    bf16_t* O; int ldc; const float* ssq; int rbase;
    __device__ __forceinline__ void operator()(const f32x4 (&acc)[2][2][4][2], const Unit& u, int wr, int wc, int fr, int fq) const {
        const int row0 = rbase + u.pm * BM + wr * 64 + fr, col0 = u.pn * HALF + wc * 32 + 8 * fq;
#pragma unroll
        for (int ai = 0; ai < 2; ++ai)
#pragma unroll
            for (int m = 0; m < 4; ++m) { const int row = row0 + ai * HALF + m * 16; const float rs = row_rstd(ssq, row, fq);
                u32x4 w; float o[8];
#pragma unroll
                for (int n = 0; n < 2; ++n)
#pragma unroll
                    for (int i = 0; i < 4; ++i) { const float g = acc[ai][0][m][n][i] * rs, up = acc[ai][1][m][n][i] * rs; o[4 * n + i] = silu_f(g) * up; }
                w.x = cvt_pk_bf16(o[0], o[1]); w.y = cvt_pk_bf16(o[2], o[3]); w.z = cvt_pk_bf16(o[4], o[5]); w.w = cvt_pk_bf16(o[6], o[7]);
                *(u32x4*)(O + (size_t)row * ldc + col0) = w; }
    }
};
struct EpiKV {
    static constexpr bool PERM = false, AFTER_DRAIN = false;
    float* ko; float* vo; bf16_t* km; bf16_t* vt; const float* ssq; int rbase;
    __device__ __forceinline__ void operator()(const f32x4 (&acc)[2][2][4][2], const Unit& u, int wr, int wc, int fr, int fq) const {
        const int row0 = rbase + u.pm * BM + wr * 64 + fr;
#pragma unroll
        for (int ai = 0; ai < 2; ++ai)
#pragma unroll
            for (int m = 0; m < 4; ++m) { const int row = row0 + ai * HALF + m * 16; const float rs = row_rstd(ssq, row, fq);
#pragma unroll
                for (int bj = 0; bj < 2; ++bj)
#pragma unroll
                    for (int n = 0; n < 2; ++n) { const int col = u.pn * BM + bj * HALF + wc * 32 + n * 16 + 4 * fq; const f32x4 v = acc[ai][bj][m][n] * rs;
                        if (u.pn < 8) { *(f32x4*)(ko + (size_t)row * 2048 + col) = v; u32x2 w; w.x = cvt_pk_bf16(v[0], v[1]); w.y = cvt_pk_bf16(v[2], v[3]); *(u32x2*)(km + (size_t)row * 2048 + col) = w; }
                        else { const int c2 = col - 2048; *(f32x4*)(vo + (size_t)row * 2048 + c2) = v; const int b = row >> 8, key = row & 255;
                            const unsigned w0 = cvt_pk_bf16(v[0], v[1]), w1 = cvt_pk_bf16(v[2], v[3]); bf16_t* t = vt + ((size_t)(b * 2048 + c2)) * 256 + key;
                            t[0] = (bf16_t)(w0 & 0xffffu); t[256] = (bf16_t)(w0 >> 16); t[512] = (bf16_t)(w1 & 0xffffu); t[768] = (bf16_t)(w1 >> 16); } } }
    }
};
template <bool FIRST, bool WRITE_XB> struct EpiRes {
    static constexpr bool PERM = false, AFTER_DRAIN = false;
    const float* xp; const float* xs; float* xr; bf16_t* xb; float* ssq_out; float alpha; int rbase;
    __device__ __forceinline__ void operator()(const f32x4 (&acc)[2][2][4][2], const Unit& u, int wr, int wc, int fr, int fq) const {
        const int row0 = rbase + u.pm * BM + wr * 64 + fr;
#pragma unroll
        for (int ai = 0; ai < 2; ++ai)
#pragma unroll
            for (int m = 0; m < 4; ++m) { const int row = row0 + ai * HALF + m * 16; float q = 0.f;
                const float* base = FIRST ? (row < 8192 ? xp + (size_t)row * 2048 : xs + (size_t)(row - 8192) * 2048) : xr + (size_t)row * 2048;
#pragma unroll
                for (int bj = 0; bj < 2; ++bj)
#pragma unroll
                    for (int n = 0; n < 2; ++n) { const int col = u.pn * BM + bj * HALF + wc * 32 + n * 16 + 4 * fq; const f32x4 b = *(const f32x4*)(base + col); const f32x4 o = b + acc[ai][bj][m][n] * alpha;
                        *(f32x4*)(xr + (size_t)row * 2048 + col) = o; q += (o[0] * o[0] + o[1] * o[1]) + (o[2] * o[2] + o[3] * o[3]);
                        if (WRITE_XB) { u32x2 w; w.x = cvt_pk_bf16(o[0], o[1]); w.y = cvt_pk_bf16(o[2], o[3]); *(u32x2*)(xb + (size_t)row * 2048 + col) = w; } }
                q += __shfl_xor(q, 16); q += __shfl_xor(q, 32);
                if (fq == 0) ssq_out[(size_t)row * 32 + u.pn * 4 + wc] = q; }
    }
};
struct EpiProj {
    static constexpr bool PERM = false, AFTER_DRAIN = false;
    float* C; int ldc; const float* ssq; int rbase;
    __device__ __forceinline__ void operator()(const f32x4 (&acc)[2][2][4][2], const Unit& u, int wr, int wc, int fr, int fq) const {
        const int row0 = rbase + u.pm * BM + wr * 64 + fr;
#pragma unroll
        for (int ai = 0; ai < 2; ++ai)
#pragma unroll
            for (int m = 0; m < 4; ++m) { const int row = row0 + ai * HALF + m * 16; const float rs = row_rstd(ssq, row, fq);
#pragma unroll
                for (int bj = 0; bj < 2; ++bj)
#pragma unroll
                    for (int n = 0; n < 2; ++n) { const int col = u.pn * BM + bj * HALF + wc * 32 + n * 16 + 4 * fq; *(f32x4*)(C + (size_t)row * ldc + col) = acc[ai][bj][m][n] * rs; } }
    }
};
struct EpiQ {
    static constexpr bool PERM = true, AFTER_DRAIN = false;
    bf16_t* O; const float* ssq; float scale; int rbase;
    __device__ __forceinline__ void operator()(const f32x4 (&acc)[2][2][4][2], const Unit& u, int wr, int wc, int fr, int fq) const {
        const int row0 = rbase + u.pm * BM + wr * 64 + fr, col0 = u.pn * BM + wc * 32 + 8 * fq;
#pragma unroll
        for (int ai = 0; ai < 2; ++ai)
#pragma unroll
            for (int m = 0; m < 4; ++m) { const int row = row0 + ai * HALF + m * 16; const float rs = row_rstd(ssq, row, fq) * scale;
#pragma unroll
                for (int bj = 0; bj < 2; ++bj) { const f32x4 v0 = acc[ai][bj][m][0] * rs, v1 = acc[ai][bj][m][1] * rs;
                    u32x4 w; w.x = cvt_pk_bf16(v0[0], v0[1]); w.y = cvt_pk_bf16(v0[2], v0[3]); w.z = cvt_pk_bf16(v1[0], v1[1]); w.w = cvt_pk_bf16(v1[2], v1[3]);
                    *(u32x4*)(O + (size_t)row * 2048 + col0 + bj * HALF) = w; } }
    }
};

template <class Epi, class Sched, bool ALIGN_EPI = false, bool SP2 = false>
__device__ __forceinline__ void gemm_phase(PG8_LAS unsigned char* lds, const Gemm g, const Sched& S, const Epi& E) {
    const int tid = threadIdx.x, wid = __builtin_amdgcn_readfirstlane(tid >> 6), lane = tid & 63, wr = wid >> 2, wc = wid & 3, fr = lane & 15, fq = lane >> 4;
    const int K = g.K, nt = K / BK;
    unsigned voffA[2], voffB[2];
#pragma unroll
    for (int i = 0; i < 2; ++i) { int R, C; stage_rc(tid * 16 + i * 8192, R, C); const int Rb = Epi::PERM ? ((R & ~31) + perm32(R & 31)) : R;
        voffA[i] = (unsigned)(R * K + C) * 2u; voffB[i] = (unsigned)(Rb * K + C) * 2u; }
    const size_t kstep = (size_t)(BK * 2);
    const size_t hstep = (size_t)HALF * K * 2;
    const size_t tstep = 2 * hstep;
    const unsigned ldsw = (unsigned)wid * 1024u;
    const int aoff = lds_byte(wr * 64 + fr, fq * 8), boff = lds_byte(wc * 32 + fr, fq * 8);
#define PG8_SA(b, h) (((b) * 2 + (h)) * HTB)
#define PG8_SB(b, h) ((4 + (b) * 2 + (h)) * HTB)
#define PG8_STAGE(bufoff, gbase, voff) do { _Pragma("unroll") for (int _i = 0; _i < 2; ++_i) \
        __builtin_amdgcn_global_load_lds((const unsigned*)((const char*)(gbase) + (voff)[_i]), (PG8_LAS unsigned*)(lds + (bufoff) + ldsw + _i * 8192), 16, 0, 0); } while (0)
#define PG8_LDA(dst, b, h) do { _Pragma("unroll") for (int m = 0; m < 4; ++m) _Pragma("unroll") for (int k = 0; k < 2; ++k) dst[m][k] = *(const PG8_LAS bf16x8*)(lds + PG8_SA(b, h) + aoff + m * 2048 + k * 1024); } while (0)
#define PG8_LDB(dst, b, h) do { _Pragma("unroll") for (int n = 0; n < 2; ++n) _Pragma("unroll") for (int k = 0; k < 2; ++k) dst[n][k] = *(const PG8_LAS bf16x8*)(lds + PG8_SB(b, h) + boff + n * 2048 + k * 1024); } while (0)
#define PG8_MMA(ai, bj, At, Bt) do { __builtin_amdgcn_s_setprio(1); _Pragma("unroll") for (int m = 0; m < 4; ++m) _Pragma("unroll") for (int n = 0; n < 2; ++n) _Pragma("unroll") for (int k = 0; k < 2; ++k) \
        acc[ai][bj][m][n] = __builtin_amdgcn_mfma_f32_16x16x32_bf16(Bt[n][k], At[m][k], acc[ai][bj][m][n], 0, 0, 0); __builtin_amdgcn_s_setprio(0); } while (0)
#define PG8_WAIT_V(n) asm volatile("s_waitcnt vmcnt(" #n ")" ::: "memory")
#define PG8_WAIT_L(n) asm volatile("s_waitcnt lgkmcnt(" #n ")" ::: "memory")
#define PG8_BAR __builtin_amdgcn_s_barrier()
#define PG8_SCHED __builtin_amdgcn_sched_barrier(0)
    Unit cur, nxt; int ui = 0;
    if (!S.next(0, cur)) return;
    f32x4 acc[2][2][4][2];
#pragma unroll
    for (int a = 0; a < 2; ++a)
#pragma unroll
        for (int b = 0; b < 2; ++b)
#pragma unroll
            for (int m = 0; m < 4; ++m)
#pragma unroll
                for (int n = 0; n < 2; ++n) acc[a][b][m][n] = (f32x4){0.f, 0.f, 0.f, 0.f};
    bf16x8 At[4][2], B0[2][2], B1[2][2];
    const char* cA = (const char*)g.A + (size_t)cur.pm * tstep; const char* cB = (const char*)g.Bt + (size_t)cur.pn * tstep;
    S.a_ready(cur);
    if constexpr (SP2) {
        PG8_STAGE(PG8_SB(0, 0), cB, voffB); PG8_STAGE(PG8_SB(0, 1), cB + hstep, voffB); PG8_STAGE(PG8_SA(0, 0), cA, voffA); PG8_STAGE(PG8_SA(0, 1), cA + hstep, voffA);
        if (wr == 1) PG8_BAR;
        PG8_WAIT_V(2); PG8_BAR;
        PG8_STAGE(PG8_SB(1, 0), cB + kstep, voffB); PG8_STAGE(PG8_SA(1, 0), cA + kstep, voffA); PG8_STAGE(PG8_SB(1, 1), cB + hstep + kstep, voffB);
        PG8_WAIT_V(6); PG8_BAR;
    } else {
        PG8_STAGE(PG8_SB(0, 0), cB, voffB); PG8_STAGE(PG8_SA(0, 0), cA, voffA); PG8_STAGE(PG8_SB(0, 1), cB + hstep, voffB); PG8_STAGE(PG8_SA(0, 1), cA + hstep, voffA);
        if (wr == 1) PG8_BAR;
        PG8_WAIT_V(4); PG8_BAR;
        PG8_STAGE(PG8_SB(1, 0), cB + kstep, voffB); PG8_STAGE(PG8_SA(1, 0), cA + kstep, voffA); PG8_STAGE(PG8_SB(1, 1), cB + hstep + kstep, voffB);
        PG8_WAIT_V(6); PG8_BAR;
    }
    for (;;) {
        const bool has_next = S.next(ui + 1, nxt);
        const char* nA = has_next ? (const char*)g.A + (size_t)nxt.pm * tstep : cA; const char* nB = has_next ? (const char*)g.Bt + (size_t)nxt.pn * tstep : cB;
        for (int t = 0; t < nt; t += 2) {
            const bool last = (t == nt - 2);
            const char* a1 = cA + (size_t)(t + 1) * kstep;
            const char* a2 = last ? nA : cA + (size_t)(t + 2) * kstep; const char* b2 = last ? nB : cB + (size_t)(t + 2) * kstep;
            const char* a3 = a2 + kstep; const char* b3 = b2 + kstep;
            if (last && has_next) S.a_ready(nxt);
            if constexpr (SP2) {
            PG8_LDB(B0, 0, 0); PG8_LDB(B1, 0, 1); PG8_SCHED; PG8_LDA(At, 0, 0); PG8_STAGE(PG8_SA(1, 1), a1 + hstep, voffA);
            PG8_WAIT_V(8); PG8_WAIT_L(0); PG8_BAR; PG8_MMA(0, 0, At, B0); PG8_MMA(0, 1, At, B1); PG8_BAR; PG8_SCHED;
            PG8_LDA(At, 0, 1); PG8_STAGE(PG8_SB(0, 0), b2, voffB); PG8_STAGE(PG8_SB(0, 1), b2 + hstep, voffB); PG8_STAGE(PG8_SA(0, 0), a2, voffA);
            PG8_WAIT_V(8); PG8_WAIT_L(0); PG8_BAR; PG8_MMA(1, 0, At, B0); PG8_MMA(1, 1, At, B1); PG8_BAR; PG8_SCHED;
            PG8_LDB(B0, 1, 0); PG8_LDB(B1, 1, 1); PG8_SCHED; PG8_LDA(At, 1, 0); PG8_STAGE(PG8_SA(0, 1), a2 + hstep, voffA);
            PG8_WAIT_V(8); PG8_WAIT_L(0); PG8_BAR; PG8_MMA(0, 0, At, B0); PG8_MMA(0, 1, At, B1); PG8_BAR; PG8_SCHED;
            PG8_LDA(At, 1, 1); PG8_STAGE(PG8_SB(1, 0), b3, voffB); PG8_STAGE(PG8_SB(1, 1), b3 + hstep, voffB); PG8_STAGE(PG8_SA(1, 0), a3, voffA);
            PG8_WAIT_V(8); PG8_WAIT_L(0); PG8_BAR; PG8_MMA(1, 0, At, B0); PG8_MMA(1, 1, At, B1); PG8_BAR; PG8_SCHED;
            } else {
            PG8_LDB(B0, 0, 0); PG8_SCHED; PG8_LDA(At, 0, 0); PG8_STAGE(PG8_SA(1, 1), a1 + hstep, voffA);
            PG8_WAIT_L(8); PG8_BAR; PG8_WAIT_L(0); PG8_MMA(0, 0, At, B0); PG8_BAR; PG8_SCHED;
            PG8_LDB(B1, 0, 1); PG8_STAGE(PG8_SB(0, 0), b2, voffB);
            PG8_BAR; PG8_WAIT_L(0); PG8_MMA(0, 1, At, B1); PG8_BAR;
            PG8_LDA(At, 0, 1); PG8_STAGE(PG8_SA(0, 0), a2, voffA);
            PG8_BAR; PG8_WAIT_L(0); PG8_MMA(1, 0, At, B0); PG8_BAR; PG8_SCHED;
            PG8_STAGE(PG8_SB(0, 1), b2 + hstep, voffB);
            PG8_WAIT_V(6); PG8_BAR; PG8_MMA(1, 1, At, B1); PG8_BAR;
            PG8_LDB(B0, 1, 0); PG8_SCHED; PG8_LDA(At, 1, 0); PG8_STAGE(PG8_SA(0, 1), a2 + hstep, voffA);
            PG8_WAIT_L(8); PG8_BAR; PG8_WAIT_L(0); PG8_MMA(0, 0, At, B0); PG8_BAR; PG8_SCHED;
            PG8_LDB(B1, 1, 1); PG8_STAGE(PG8_SB(1, 0), b3, voffB);
            PG8_BAR; PG8_WAIT_L(0); PG8_MMA(0, 1, At, B1); PG8_BAR;
            PG8_LDA(At, 1, 1); PG8_STAGE(PG8_SA(1, 0), a3, voffA);
            PG8_BAR; PG8_WAIT_L(0); PG8_MMA(1, 0, At, B0); PG8_BAR; PG8_SCHED;
            PG8_STAGE(PG8_SB(1, 1), b3 + hstep, voffB);
            PG8_WAIT_V(6); PG8_BAR; PG8_MMA(1, 1, At, B1); PG8_BAR;
            }
        }
        if constexpr (ALIGN_EPI) { if (wr == 0) PG8_BAR; }
        if constexpr (!Epi::AFTER_DRAIN) { E(acc, cur, wr, wc, fr, fq); S.done(cur); }
        if (!has_next) break;
#pragma unroll
        for (int a = 0; a < 2; ++a)
#pragma unroll
            for (int b = 0; b < 2; ++b)
#pragma unroll
                for (int m = 0; m < 4; ++m)
#pragma unroll
                    for (int n = 0; n < 2; ++n) acc[a][b][m][n] = (f32x4){0.f, 0.f, 0.f, 0.f};
        cur = nxt; cA = nA; cB = nB; ++ui;
        if constexpr (ALIGN_EPI) { if (wr == 1) PG8_BAR; }
    }
    PG8_WAIT_V(0);
    if constexpr (!ALIGN_EPI) { if (wr == 0) PG8_BAR; }
    PG8_BAR;
    if constexpr (Epi::AFTER_DRAIN) { E.fused(acc, cur, wr, wc, fr, fq, lds, wid, lane); S.done(cur); }
#undef PG8_SA
#undef PG8_SB
#undef PG8_STAGE
#undef PG8_LDA
#undef PG8_LDB
#undef PG8_MMA
#undef PG8_WAIT_V
#undef PG8_WAIT_L
#undef PG8_BAR
#undef PG8_SCHED
}
}
#ifndef PG8_SP2
#define PG8_SP2 true
#endif
#ifndef PG8_ALIGN
#define PG8_ALIGN true
#endif
constexpr int RING_OFF = 0, RING_BYTES = 131072;
constexpr int LDSCTL_OFF = RING_BYTES, MISC_OFF = LDSCTL_OFF + 320;
constexpr int LDS_BYTES = 147456;
static_assert(MISC_OFF + 128 <= LDS_BYTES, "LDS map");

#define GAS __attribute__((address_space(1)))
#define LAS __attribute__((address_space(3)))
typedef unsigned short bf16;
typedef unsigned v4u __attribute__((ext_vector_type(4)));
typedef unsigned v2u __attribute__((ext_vector_type(2)));
typedef float f32x4 __attribute__((ext_vector_type(4)));
typedef float f32x2 __attribute__((ext_vector_type(2)));
typedef short bf16x8 __attribute__((ext_vector_type(8)));
typedef short bf16x4 __attribute__((ext_vector_type(4)));
typedef GAS unsigned gu32;
#define RLX_AGENT __ATOMIC_RELAXED, __HIP_MEMORY_SCOPE_AGENT
#define LDS_WAIT() asm volatile("s_waitcnt lgkmcnt(0)" ::: "memory")
#define VM_WAIT() asm volatile("s_waitcnt vmcnt(0)" ::: "memory")
__device__ __forceinline__ unsigned f2bf(float f) { unsigned u = __builtin_bit_cast(unsigned, f); return (u + 0x7fffu + ((u >> 16) & 1u)) >> 16; }
__device__ __forceinline__ unsigned pk2(float lo, float hi) { return f2bf(lo) | (f2bf(hi) << 16); }
__device__ __forceinline__ float bf2f(unsigned b) { return __builtin_bit_cast(float, b << 16); }
__device__ __forceinline__ float wave_sum(float v) {
#pragma unroll
    for (int o = 1; o < 64; o <<= 1) v += __shfl_xor(v, o);
    return v;
}
__device__ __forceinline__ float sigmoid_f(float x) { return __builtin_amdgcn_rcpf(1.0f + __expf(-x)); }
__device__ __forceinline__ float siluf_(float x) { return x * sigmoid_f(x); }
__device__ __forceinline__ float softplus_f(float x) { return x > 20.f ? x : log1pf(__expf(x)); }
__device__ __forceinline__ float gelu_tanh_f(float x) { const float t = 0.7978845608028654f * (x + 0.044715f * x * x * x); return x * sigmoid_f(2.0f * t); }
#define MFMA16(a, b, c) __builtin_amdgcn_mfma_f32_16x16x32_bf16((a), (b), (c), 0, 0, 0)

#define XB_TMO      128
#define XB_XCNT(j)  (256  + 64 * (j))
#define XB_XSUB(j)  (1280 + 64 * (j))
#define XB_XGEN(j)  (2304 + 64 * (j))
#define XB_TOP      3328
#define XB_TOPGEN   3392
#define XCD_BAR_WORDS 3456
#define XB_SPIN_CAP (1u << 18)

__device__ __forceinline__ unsigned xb_ld(unsigned* p)              { return __hip_atomic_load(p, __ATOMIC_RELAXED, __HIP_MEMORY_SCOPE_AGENT); }
__device__ __forceinline__ unsigned xb_add(unsigned* p, unsigned v) { return __hip_atomic_fetch_add(p, v, __ATOMIC_RELAXED, __HIP_MEMORY_SCOPE_AGENT); }
__device__ __forceinline__ unsigned xb_xcc_id() { return (unsigned)__builtin_amdgcn_s_getreg((3 << 11) | 20) & 0xFu; }
#define XB_SPIN(cond, bar) do { unsigned _sp = 0; while (cond) { __builtin_amdgcn_s_sleep(1); \
    if ((++_sp & 255u) == 0u) { if (xb_ld(&(bar)[XB_TMO])) break; if (_sp > XB_SPIN_CAP) { atomicAdd(&(bar)[XB_TMO], 1u); break; } } } } while (0)

struct XcdBarrier {
    unsigned* bar; unsigned x;
    volatile LAS unsigned* st;
};

__device__ __forceinline__ XcdBarrier xcd_barrier_post(unsigned* bar, volatile LAS unsigned* st) {
    XcdBarrier b; b.bar = bar; b.x = xb_xcc_id(); b.st = st;
    if (threadIdx.x == 0) (void)xb_add(&bar[XB_XCNT(b.x)], 1u);
    return b;
}
__device__ __forceinline__ void xcd_barrier_complete(unsigned* bar, unsigned x, unsigned& nloc, unsigned& nx) {
    const unsigned G = gridDim.x * gridDim.y * gridDim.z;
    unsigned sum, cnt, mine, sp = 0u;
    for (;;) {
        sum = 0u; cnt = 0u; mine = 0u;
#pragma unroll
        for (unsigned j = 0; j < 16; ++j) { const unsigned c = xb_ld(&bar[XB_XCNT(j)]); sum += c; cnt += (c > 0u) ? 1u : 0u; mine = (j == x) ? c : mine; }
        if (sum == G) break;
        __builtin_amdgcn_s_sleep(1);
        if ((++sp & 255u) == 0u) { if (xb_ld(&bar[XB_TMO])) break; if (sp > XB_SPIN_CAP) { atomicAdd(&bar[XB_TMO], 1u); break; } }
    }
    nloc = mine > 0u ? mine : 1u; nx = cnt > 0u ? cnt : 1u;
}

__device__ __forceinline__ void xcd_barrier(const XcdBarrier& b) {
    asm volatile("s_waitcnt vmcnt(0)" ::: "memory");
    __syncthreads();
    if (threadIdx.x == 0) {
        unsigned* bar = b.bar;
        __builtin_amdgcn_s_waitcnt(0);
        unsigned nloc = b.st[0], nx = b.st[1];
        if (nloc == 0u) { xcd_barrier_complete(bar, b.x, nloc, nx); b.st[0] = nloc; b.st[1] = nx; }
        const unsigned old = xb_add(&bar[XB_XSUB(b.x)], 1u);
        const unsigned gen = old / nloc;
        if (old + 1u == (gen + 1u) * nloc) {
            __builtin_amdgcn_fence(__ATOMIC_RELEASE, "agent");
            asm volatile("s_waitcnt vmcnt(0)" ::: "memory");
            const unsigned og = xb_add(&bar[XB_TOP], 1u);
            const unsigned tg = og / nx;
            if (og + 1u == (tg + 1u) * nx) xb_add(&bar[XB_TOPGEN], 1u);
            else XB_SPIN(xb_ld(&bar[XB_TOPGEN]) == tg, bar);
            __builtin_amdgcn_fence(__ATOMIC_ACQUIRE, "agent");
            xb_add(&bar[XB_XGEN(b.x)], 1u);
            asm volatile("s_waitcnt vmcnt(0)" ::: "memory");
        } else {
            XB_SPIN(xb_ld(&bar[XB_XGEN(b.x)]) == gen, bar);
            __builtin_amdgcn_fence(__ATOMIC_ACQUIRE, "agent");
            asm volatile("s_waitcnt vmcnt(0)" ::: "memory");
        }
    }
    __syncthreads();
}
struct Args { const float* in[41]; float* out; unsigned char* ws; int ph_lo, ph_hi; };
struct Frame {
    LAS unsigned char* lds;
    volatile LAS unsigned* MISC;
    gu32* ctl;
    int tid, lane, wave;
    int vcu, G;
    float* out;
    unsigned char* ws;
};
#define WSP(T, off) ((T*)(F.ws + (off)))
#define INP(i) (A.in[(i)])

__device__ __forceinline__ void p0_transpose_item(const float* W, int N, bf16* WT, int ldt, int kdst, int dst_row0, const float* gain, LAS float* scr, int k0, int n0, int lane) {
    const int rs = lane >> 3, c4 = (lane & 7) * 4; f32x4 v[8]; float gn[8];
    const GAS float* src = (const GAS float*)W + (size_t)(k0 + rs) * N + n0 + c4;
#pragma unroll
    for (int i = 0; i < 8; ++i) { v[i] = *(const GAS f32x4*)(src + (size_t)(8 * i) * N); gn[i] = gain ? gain[k0 + 8 * i + rs] : 1.0f; }
#pragma unroll
    for (int i = 0; i < 8; ++i) { LAS float* d = scr + (8 * i + rs) * 33 + c4; d[0] = v[i].x * gn[i]; d[1] = v[i].y * gn[i]; d[2] = v[i].z * gn[i]; d[3] = v[i].w * gn[i]; }
    LDS_WAIT(); asm volatile("" ::: "memory");
    const int c = lane & 7;
#pragma unroll
    for (int j = 0; j < 4; ++j) { const int n = (lane >> 3) + 8 * j; const LAS float* s = scr + (8 * c) * 33 + n;
        v4u o; o.x = pk2(s[0 * 33], s[1 * 33]); o.y = pk2(s[2 * 33], s[3 * 33]); o.z = pk2(s[4 * 33], s[5 * 33]); o.w = pk2(s[6 * 33], s[7 * 33]);
        *(GAS v4u*)(WT + (size_t)(dst_row0 + n) * ldt + kdst + k0 + 8 * c) = o; }
    LDS_WAIT(); asm volatile("" ::: "memory");
}
__device__ __forceinline__ void p0_tr(const float* W, int K, int N, bf16* WT, int ldt, int kdst, int row_base, int mode  , const float* gain, LAS float* scr, int item, int lane) {
    const int nblk = N / 32, kb = item / nblk, nb = item % nblk, k0 = 64 * kb, n0 = 32 * nb; (void)K;
    const int dr = mode == 0 ? row_base + n0 : (n0 / 128) * 256 + (n0 % 128) + (mode == 2 ? 128 : 0);
    p0_transpose_item(W, N, WT, ldt, kdst, dr, gain, scr, k0, n0, lane);
}
__device__ __forceinline__ void row_to_bf16_ssq(const float* xrow, bf16* orow, float* ssq32, int lane) {
    const GAS f32x4* xr = (const GAS f32x4*)xrow + lane; GAS v2u* o8 = (GAS v2u*)orow + lane; float s = 0.f;
#pragma unroll
    for (int j = 0; j < 8; ++j) { const f32x4 v = xr[64 * j]; s += (v.x * v.x + v.y * v.y) + (v.z * v.z + v.w * v.w); v2u w; w.x = pk2(v.x, v.y); w.y = pk2(v.z, v.w); o8[64 * j] = w; }
    s = wave_sum(s);
    if (lane < 32) ssq32[lane] = lane == 0 ? s : 0.f;
}
__device__ __forceinline__ void p0_prologue(Frame& F, const Args& A) {
    LAS float* scr = (LAS float*)(F.lds + RING_OFF + F.wave * 16384);
    const int gw = F.vcu * NWAVES + F.wave, NGW = F.G * NWAVES;
    constexpr int I_GU = (D / 64) * (FF / 32), I_DN = (FF / 64) * (D / 32), I_IN = (D / 64) * (DIN / 32), I_SQ = (D / 64) * (D / 32), I_L = 16 * 8;
    constexpr int NITEMS = 4 * I_GU + 2 * I_DN + I_IN + 6 * I_SQ + 2 * I_L;
    for (int it = gw; it < NITEMS; it += NGW) {
        int r = it;
        if (r < I_GU) { p0_tr(INP(I_F1WG), D, FF, WSP(bf16, WS_W1GU), D, 0, 0, 1, INP(I_F1G), scr, r, F.lane); continue; } r -= I_GU;
        if (r < I_GU) { p0_tr(INP(I_F1WU), D, FF, WSP(bf16, WS_W1GU), D, 0, 0, 2, INP(I_F1G), scr, r, F.lane); continue; } r -= I_GU;
        if (r < I_DN) { p0_tr(INP(I_F1WD), FF, D, WSP(bf16, WS_W1D), FF, 0, 0, 0, nullptr, scr, r, F.lane); continue; } r -= I_DN;
        if (r < I_IN) { p0_tr(INP(I_WIN), D, DIN, WSP(bf16, WS_WIN), D, 0, 0, 0, INP(I_MIXG), scr, r, F.lane); continue; } r -= I_IN;
        if (r < I_SQ) { p0_tr(INP(I_WOUT), D, D, WSP(bf16, WS_WOUT), DMIX, 0, 0, 0, INP(I_LOG), scr, r, F.lane); continue; } r -= I_SQ;
        if (r < I_SQ) { p0_tr(INP(I_WOUT) + (size_t)D * D, D, D, WSP(bf16, WS_WOUT), DMIX, D, 0, 0, INP(I_SOG), scr, r, F.lane); continue; } r -= I_SQ;
        if (r < I_SQ) { p0_tr(INP(I_WQ), D, D, WSP(bf16, WS_WQ), D, 0, 0, 0, INP(I_XAG), scr, r, F.lane); continue; } r -= I_SQ;
        if (r < I_SQ) { p0_tr(INP(I_WK), D, D, WSP(bf16, WS_WKV), D, 0, 0, 0, INP(I_MEMG), scr, r, F.lane); continue; } r -= I_SQ;
        if (r < I_SQ) { p0_tr(INP(I_WV), D, D, WSP(bf16, WS_WKV), D, 0, D, 0, INP(I_MEMG), scr, r, F.lane); continue; } r -= I_SQ;
        if (r < I_SQ) { p0_tr(INP(I_WO), D, D, WSP(bf16, WS_WO), D, 0, 0, 0, nullptr, scr, r, F.lane); continue; } r -= I_SQ;
        if (r < I_GU) { p0_tr(INP(I_F2WG), D, FF, WSP(bf16, WS_W2GU), D, 0, 0, 1, INP(I_F2G), scr, r, F.lane); continue; } r -= I_GU;
        if (r < I_GU) { p0_tr(INP(I_F2WU), D, FF, WSP(bf16, WS_W2GU), D, 0, 0, 2, INP(I_F2G), scr, r, F.lane); continue; } r -= I_GU;
        if (r < I_DN) { p0_tr(INP(I_F2WD), FF, D, WSP(bf16, WS_W2D), FF, 0, 0, 0, nullptr, scr, r, F.lane); continue; } r -= I_DN;
        if (r < I_L) { const int h = r >> 3; p0_tr(INP(I_LWA) + (size_t)h * 16384, 128, 128, WSP(bf16, WS_WL), 128, 0, h * 256, 0, nullptr, scr, r & 7, F.lane); continue; } r -= I_L;
        { const int h = r >> 3; p0_tr(INP(I_LWX) + (size_t)h * 16384, 128, 128, WSP(bf16, WS_WL), 128, 0, h * 256 + 128, 0, nullptr, scr, r & 7, F.lane); }
    }
    for (int m = gw; m < M; m += NGW) { const float* src = m < MP ? INP(I_XP) + (size_t)m * D : INP(I_XS) + (size_t)(m - MP) * D;
        row_to_bf16_ssq(src, WSP(bf16, WS_XBA) + (size_t)m * D, WSP(float, WS_SSQ) + (size_t)m * NSSQ, F.lane); }
    for (int m = gw; m < MMEM; m += NGW) row_to_bf16_ssq(INP(I_MEMP) + (size_t)m * D, WSP(bf16, WS_MEMB) + (size_t)m * D, WSP(float, WS_SSQM) + (size_t)m * NSSQ, F.lane);
    { GAS v4u* z = (GAS v4u*)(WSP(bf16, WS_WIN) + (size_t)DIN * D); const int nz = (DINP - DIN) * D * 2 / 16;
      for (int i = gw * 64 + F.lane; i < nz; i += NGW * 64) z[i] = (v4u){0u, 0u, 0u, 0u}; }
}

__device__ __forceinline__ void p5_normalize(Frame& F, const Args& A, int m0, int m1, int q0, int q1, int gw, int NGW) {
    const int lane = F.lane;
    bf16* V = WSP(bf16, WS_V); const float* SQ = WSP(float, WS_SQV);
    for (int m = m0 + gw; m < m1; m += NGW) {
        const float* sq = SQ + (size_t)m * NSQV;
        const float pl = lane < 16 ? sq[lane] : 0.f, p0 = sq[16 + lane], p1 = sq[80 + lane];
        const float rl = __builtin_amdgcn_rsqf(wave_sum(pl) * (1.0f / 2048.0f) + EPS), r0 = __builtin_amdgcn_rsqf(wave_sum(p0) * (1.0f / 1024.0f) + EPS), r1 = __builtin_amdgcn_rsqf(wave_sum(p1) * (1.0f / 1024.0f) + EPS);
        GAS v4u* row = (GAS v4u*)(V + (size_t)m * DMIX) + lane;
#pragma unroll
        for (int i = 0; i < 8; ++i) { const float rs = i < 4 ? rl : (i < 6 ? r0 : r1); v4u w = row[64 * i];
            w.x = pk2(bf2f(w.x & 0xffffu) * rs, bf2f(w.x >> 16) * rs); w.y = pk2(bf2f(w.y & 0xffffu) * rs, bf2f(w.y >> 16) * rs);
            w.z = pk2(bf2f(w.z & 0xffffu) * rs, bf2f(w.z >> 16) * rs); w.w = pk2(bf2f(w.w & 0xffffu) * rs, bf2f(w.w >> 16) * rs); row[64 * i] = w; }
    }
    const float* P = WSP(float, WS_PROJ);
    for (int it = q0 * 3 + gw; it < q1 * 3; it += NGW) { const int sq = it / 3, k = it % 3;
        const int row = sq < NBP ? sq * TP + TP - 3 + k : MP + (sq - NBP) * TS + TS - 3 + k;
        float* lc = sq < NBP ? F.out + O_PLC + (size_t)(sq * 3 + k) * D : F.out + O_SLC + (size_t)((sq - NBP) * 3 + k) * D;
        float* sc = sq < NBP ? F.out + O_PSC + (size_t)(sq * 3 + k) * XBC : F.out + O_SSC + (size_t)((sq - NBP) * 3 + k) * XBC;
        const float* src = P + (size_t)row * DINP;
        for (int c = lane * 4; c < D; c += 256) *(GAS f32x4*)(lc + c) = *(const GAS f32x4*)(src + C_XL + c);
        for (int c = lane * 4; c < XBC; c += 256) *(GAS f32x4*)(sc + c) = *(const GAS f32x4*)(src + C_XBC + c);
    }
}
__device__ __forceinline__ void p12_final(Frame& F, const Args& A, int m0, int m1) {
    const int gw = F.vcu * NWAVES + F.wave, NGW = F.G * NWAVES, lane = F.lane;
    const float* XR = WSP(float, WS_XR); const float* SSQ = WSP(float, WS_SSQ) + (size_t)4 * M * NSSQ; const float* g = INP(I_FING);
    for (int m = m0 + gw; m < m1; m += NGW) {
        const float p = lane < 32 ? SSQ[(size_t)m * NSSQ + lane] : 0.f; const float rs = __builtin_amdgcn_rsqf(wave_sum(p) * (1.0f / 2048.0f) + EPS);
        const GAS f32x4* xr = (const GAS f32x4*)(XR + (size_t)m * D) + lane; const GAS f32x4* gg = (const GAS f32x4*)g + lane; GAS f32x4* o = (GAS f32x4*)(F.out + O_Y + (size_t)m * D) + lane;
#pragma unroll
        for (int j = 0; j < 8; ++j) o[64 * j] = xr[64 * j] * rs * gg[64 * j];
    }
}

__device__ __forceinline__ bf16x8 pack8(const f32x4 a, const f32x4 b) { v4u w; w.x = pg8::cvt_pk_bf16(a[0], a[1]); w.y = pg8::cvt_pk_bf16(a[2], a[3]); w.z = pg8::cvt_pk_bf16(b[0], b[1]); w.w = pg8::cvt_pk_bf16(b[2], b[3]); return __builtin_bit_cast(bf16x8, w); }
#define SCHED_FENCE() __builtin_amdgcn_sched_barrier(0)
__device__ __forceinline__ void attn_prompt_item(Frame& F, const Args& A, int b, int h, int qt) {
    const int lane = F.lane, c16 = lane & 15, g = lane >> 4;
    const int R = b * TP + qt * 16 + c16;
    const bf16* Q = WSP(bf16, WS_Q) + (size_t)R * D + h * 512;
    bf16x8 qf[16];
#pragma unroll
    for (int ks = 0; ks < 16; ++ks) qf[ks] = *(const GAS bf16x8*)(Q + ks * 32 + 8 * g);
    const GAS char* kb = (const GAS char*)(WSP(bf16, WS_KM) + (size_t)(b * NMEM) * D + h * 512); const unsigned ko = (unsigned)(c16 * D + 8 * g) * 2u;
    f32x4 s[16]; bf16x8 kbuf[2][8];
#define KLOAD(step_) do { const int kt_ = (step_) >> 1, hf_ = (step_) & 1; _Pragma("unroll") for (int i = 0; i < 8; ++i) kbuf[(step_) & 1][i] = *(const GAS bf16x8*)(kb + (size_t)kt_ * 16 * D * 2 + ko + (hf_ * 8 + i) * 64); } while (0)
    KLOAD(0);
#pragma unroll
    for (int step = 0; step < 32; ++step) { const int kt = step >> 1, hf = step & 1;
        if (step + 1 < 32) KLOAD(step + 1);
        SCHED_FENCE();
        if (hf == 0) s[kt] = (f32x4){0.f, 0.f, 0.f, 0.f};
#pragma unroll
        for (int i = 0; i < 8; ++i) s[kt] = MFMA16(kbuf[step & 1][i], qf[hf * 8 + i], s[kt]);
        SCHED_FENCE(); }
#undef KLOAD
    const GAS char* vb = (const GAS char*)(WSP(bf16, WS_VT) + (size_t)(b * D + h * 512) * NMEM); const unsigned vo = (unsigned)(c16 * NMEM + 4 * g) * 2u;
    v2u vbuf[2][16];
#define VLOAD(dt_) do { _Pragma("unroll") for (int kk = 0; kk < 8; ++kk) { vbuf[(dt_) & 1][2 * kk] = *(const GAS v2u*)(vb + (size_t)(dt_) * 16 * NMEM * 2 + vo + kk * 64); vbuf[(dt_) & 1][2 * kk + 1] = *(const GAS v2u*)(vb + (size_t)(dt_) * 16 * NMEM * 2 + vo + kk * 64 + 32); } } while (0)
    VLOAD(0);
    float mx = -3.0e38f;
#pragma unroll
    for (int kt = 0; kt < 16; ++kt) mx = fmaxf(mx, fmaxf(fmaxf(s[kt][0], s[kt][1]), fmaxf(s[kt][2], s[kt][3])));
    mx = fmaxf(mx, __shfl_xor(mx, 16)); mx = fmaxf(mx, __shfl_xor(mx, 32));
    float sum = 0.f;
#pragma unroll
    for (int kt = 0; kt < 16; ++kt) {
#pragma unroll
        for (int j = 0; j < 4; ++j) { const float e = __expf(s[kt][j] - mx); s[kt][j] = e; sum += e; } }
    sum += __shfl_xor(sum, 16); sum += __shfl_xor(sum, 32);
    const float inv = 1.0f / sum;
    bf16x8 pf[8];
#pragma unroll
    for (int kk = 0; kk < 8; ++kk) pf[kk] = pack8(s[2 * kk], s[2 * kk + 1]);
    bf16* O = WSP(bf16, WS_O) + (size_t)R * D + h * 512 + 4 * g;
#pragma unroll
    for (int dt = 0; dt < 32; ++dt) { f32x4 o = (f32x4){0.f, 0.f, 0.f, 0.f};
        if (dt + 1 < 32) VLOAD(dt + 1);
        SCHED_FENCE();
#pragma unroll
        for (int kk = 0; kk < 8; ++kk) { v4u w; w.x = vbuf[dt & 1][2 * kk].x; w.y = vbuf[dt & 1][2 * kk].y; w.z = vbuf[dt & 1][2 * kk + 1].x; w.w = vbuf[dt & 1][2 * kk + 1].y; o = MFMA16(__builtin_bit_cast(bf16x8, w), pf[kk], o); }
        o = o * inv;
        { v2u w; w.x = pg8::cvt_pk_bf16(o[0], o[1]); w.y = pg8::cvt_pk_bf16(o[2], o[3]); *(GAS v2u*)(O + dt * 16) = w; }
        SCHED_FENCE(); }
#undef VLOAD
}
constexpr int AT_ML = 0, AT_PF = 1024;
__device__ __forceinline__ void attn_sample_wg(Frame& F, const Args& A, int b, int h) {
    const int lane = F.lane, w = F.wave, c16 = lane & 15, g = lane >> 4;
    LAS float* ML = (LAS float*)(F.lds + AT_ML); LAS v4u* PF = (LAS v4u*)(F.lds + AT_PF);
    const int R = MP + b * TS + (c16 & 7); const bool qvalid = c16 < 8;
    const bf16* Q = WSP(bf16, WS_Q) + (size_t)R * D + h * 512;
    bf16x8 qf[16];
#pragma unroll
    for (int ks = 0; ks < 16; ++ks) qf[ks] = *(const GAS bf16x8*)(Q + ks * 32 + 8 * g);
    const GAS char* kb = (const GAS char*)(INP(I_CK) + (size_t)(b * NMEM + 32 * w) * D + h * 512); const unsigned ko = (unsigned)(c16 * D + 8 * g) * 4u;
    f32x4 s[2]; f32x4 kbuf[2][16];
#define KLOAD(step_) do { const int t_ = (step_) >> 1, hf_ = (step_) & 1; _Pragma("unroll") for (int i = 0; i < 8; ++i) { \
        kbuf[(step_) & 1][2 * i] = *(const GAS f32x4*)(kb + (size_t)t_ * 16 * D * 4 + ko + (hf_ * 8 + i) * 128); kbuf[(step_) & 1][2 * i + 1] = *(const GAS f32x4*)(kb + (size_t)t_ * 16 * D * 4 + ko + (hf_ * 8 + i) * 128 + 16); } } while (0)
    KLOAD(0);
#pragma unroll
    for (int step = 0; step < 4; ++step) { const int t = step >> 1, hf = step & 1;
        if (step + 1 < 4) KLOAD(step + 1);
        SCHED_FENCE();
        if (hf == 0) s[t] = (f32x4){0.f, 0.f, 0.f, 0.f};
#pragma unroll
        for (int i = 0; i < 8; ++i) s[t] = MFMA16(pack8(kbuf[step & 1][2 * i], kbuf[step & 1][2 * i + 1]), qf[hf * 8 + i], s[t]);
        SCHED_FENCE(); }
#undef KLOAD
    const GAS char* vb = (const GAS char*)(INP(I_CV) + (size_t)(b * NMEM) * D + h * 512); const unsigned vo2 = (unsigned)(4 * g * D + c16) * 4u;
    float vbuf[2][64];
#define VLOAD(i_) do { const int dt_ = 4 * w + (i_); _Pragma("unroll") for (int kk = 0; kk < 8; ++kk) { const GAS char* v0 = vb + (size_t)(kk * 32) * D * 4 + dt_ * 64 + vo2; \
        _Pragma("unroll") for (int j = 0; j < 4; ++j) { vbuf[(i_) & 1][kk * 8 + j] = *(const GAS float*)(v0 + (size_t)j * D * 4); vbuf[(i_) & 1][kk * 8 + 4 + j] = *(const GAS float*)(v0 + (size_t)(16 + j) * D * 4); } } } while (0)
    VLOAD(0);
    float mx = fmaxf(fmaxf(fmaxf(s[0][0], s[0][1]), fmaxf(s[0][2], s[0][3])), fmaxf(fmaxf(s[1][0], s[1][1]), fmaxf(s[1][2], s[1][3])));
    mx = fmaxf(mx, __shfl_xor(mx, 16)); mx = fmaxf(mx, __shfl_xor(mx, 32));
    float sum = 0.f;
#pragma unroll
    for (int t = 0; t < 2; ++t)
#pragma unroll
        for (int j = 0; j < 4; ++j) { const float e = __expf(s[t][j] - mx); s[t][j] = e; sum += e; }
    sum += __shfl_xor(sum, 16); sum += __shfl_xor(sum, 32);
    if (g == 0) { ML[(w * 16 + c16) * 2] = mx; ML[(w * 16 + c16) * 2 + 1] = sum; }
    __syncthreads();
    float gm = -3.0e38f;
#pragma unroll
    for (int ww = 0; ww < 8; ++ww) gm = fmaxf(gm, ML[(ww * 16 + c16) * 2]);
    float tot = 0.f;
#pragma unroll
    for (int ww = 0; ww < 8; ++ww) tot += ML[(ww * 16 + c16) * 2 + 1] * __expf(ML[(ww * 16 + c16) * 2] - gm);
    const float f = __expf(mx - gm), inv = 1.0f / tot;
    { const bf16x8 pk = pack8(s[0] * f, s[1] * f); PF[w * 64 + lane] = __builtin_bit_cast(v4u, pk); }
    __syncthreads();
    bf16x8 pf[8];
#pragma unroll
    for (int kk = 0; kk < 8; ++kk) pf[kk] = __builtin_bit_cast(bf16x8, PF[kk * 64 + lane]);
    bf16* O = WSP(bf16, WS_O) + (size_t)R * D + h * 512 + 4 * g;
#pragma unroll
    for (int i = 0; i < 4; ++i) { const int dt = 4 * w + i; f32x4 o = (f32x4){0.f, 0.f, 0.f, 0.f};
        if (i + 1 < 4) VLOAD(i + 1);
        SCHED_FENCE();
#pragma unroll
        for (int kk = 0; kk < 8; ++kk) { const float* vv = &vbuf[i & 1][kk * 8]; o = MFMA16(pack8((f32x4){vv[0], vv[1], vv[2], vv[3]}, (f32x4){vv[4], vv[5], vv[6], vv[7]}), pf[kk], o); }
        o = o * inv;
        if (qvalid) { v2u wv; wv.x = pg8::cvt_pk_bf16(o[0], o[1]); wv.y = pg8::cvt_pk_bf16(o[2], o[3]); *(GAS v2u*)(O + dt * 16) = wv; }
        SCHED_FENCE(); }
#undef VLOAD
    __syncthreads();
}
__device__ __forceinline__ void p8_attn_sample(Frame& F, const Args& A) {
    for (int it = blockIdx.x; it < NBS * 4; it += F.G) attn_sample_wg(F, A, it >> 2, it & 3);
}
__device__ __forceinline__ void p8_attn_prompt(Frame& F, const Args& A) {
    const int f = F.wave * F.G + F.vcu, NF = F.G * NWAVES;
    for (int it = f; it < NBP * 4 * (TP / 16); it += NF) attn_prompt_item(F, A, it >> 9, (it >> 7) & 3, it & 127);
}

__device__ __forceinline__ float conv4(const float* cur, int t, const float* st, int sp, float w0, float w1, float w2, float w3, float bias) {
    const float x3 = cur[0];
    const float x2 = t >= 1 ? cur[-(ptrdiff_t)DINP] : (st ? st[2 * sp] : 0.f);
    const float x1 = t >= 2 ? cur[-(ptrdiff_t)2 * DINP] : (st ? st[(t + 1) * sp] : 0.f);
    const float x0 = t >= 3 ? cur[-(ptrdiff_t)3 * DINP] : (st ? st[t * sp] : 0.f);
    return bias + w0 * x0 + w1 * x1 + w2 * x2 + w3 * x3;
}
constexpr int LR_U32 = 0, LR_A32 = 32768, LR_UB = 65536, LR_UBP = 136;
template <bool SAMPLE>
__device__ __forceinline__ void lru_item(Frame& F, const Args& A, int sidx, int h) {
    LAS float* U32 = (LAS float*)(F.lds + LR_U32); LAS float* A32 = (LAS float*)(F.lds + LR_A32); LAS bf16* UB = (LAS bf16*)(F.lds + LR_UB);
    const int tid = F.tid, lane = F.lane, w = F.wave, c16 = lane & 15, g = lane >> 4;
    const float* P = WSP(float, WS_PROJ);
    const bf16* WL = WSP(bf16, WS_WL) + (size_t)h * 256 * 128;
    bf16x8 ba[4], bx[4];
#pragma unroll
    for (int ks = 0; ks < 4; ++ks) { ba[ks] = *(const GAS bf16x8*)(WL + (size_t)(16 * w + c16) * 128 + ks * 32 + 8 * g); bx[ks] = *(const GAS bf16x8*)(WL + (size_t)(128 + 16 * w + c16) * 128 + ks * 32 + 8 * g); }
    const int mcol = 16 * w + c16, mch = h * 128 + mcol;
    const float b_a = INP(I_LBA)[mch], b_x = INP(I_LBX)[mch], cl = -8.0f * softplus_f(-INP(I_LLAM)[mch]);
    const int tq = w >> 1, cc = (w & 1) * 64 + lane, ch = h * 128 + cc;
    const unsigned voffx = (unsigned)(C_XL + ch) * 4u, voffg = (unsigned)(C_GL + h * 128 + 2 * lane) * 4u;
    const float cw0 = INP(I_LCW)[ch], cw1 = INP(I_LCW)[D + ch], cw2 = INP(I_LCW)[2 * D + ch], cw3 = INP(I_LCW)[3 * D + ch], cb = INP(I_LCB)[ch];
    float hstate = 0.f;
    const int nchunk = SAMPLE ? 1 : TP / 64;
    float raw[22];
#define LDG_F32(base_, voff_) (*(const GAS float*)((const GAS char*)(base_) + (voff_)))
#define LRU_ISSUE(chunk_) do { \
        if (SAMPLE) { \
            _Pragma("unroll") for (int q = 0; q < 2; ++q) { const int sq_ = sidx * 8 + tq * 2 + q; \
                _Pragma("unroll") for (int k = 0; k < 3; ++k) raw[q * 11 + k] = LDG_F32(INP(I_SLC) + (size_t)(sq_ * 3 + k) * D, (unsigned)ch * 4u); \
                _Pragma("unroll") for (int t = 0; t < 8; ++t) raw[q * 11 + 3 + t] = LDG_F32(P + (size_t)(MP + sq_ * 8 + t) * DINP, voffx); } \
        } else { \
            const int R0_ = sidx * TP + (chunk_) * 64 + tq * 16; \
            _Pragma("unroll") for (int i = 0; i < 19; ++i) { const bool ok = ((chunk_) > 0 || tq > 0 || i >= 3); raw[i] = ok ? LDG_F32(P + (size_t)(R0_ - 3 + i) * DINP, voffx) : 0.f; } \
        } } while (0)
    LRU_ISSUE(0);
    for (int chunk = 0; chunk < nchunk; ++chunk) {
        int ln_ = lane; asm volatile("" : "+v"(ln_));
        const int lane = ln_, c16 = lane & 15, g = lane >> 4, cc = (w & 1) * 64 + lane, mcol = 16 * w + c16;
        const int R0 = SAMPLE ? MP + sidx * 64 : sidx * TP + chunk * 64;
        f32x2 gg[8];
#pragma unroll
        for (int i = 0; i < 8; ++i) gg[i] = *(const GAS f32x2*)((const GAS char*)(P + (size_t)(R0 + 8 * w + i) * DINP) + voffg);
#pragma unroll
        for (int i = 0; i < 16; ++i) { const int r = tq * 16 + i; const int o = SAMPLE ? (i >> 3) * 11 + (i & 7) : i;
            const float u = cb + cw0 * raw[o] + cw1 * raw[o + 1] + cw2 * raw[o + 2] + cw3 * raw[o + 3];
            U32[r * 128 + cc] = u; UB[r * LR_UBP + cc] = (bf16)f2bf(u); }
        if (chunk + 1 < nchunk) LRU_ISSUE(chunk + 1);
        __syncthreads();
        f32x4 ra[4], rx[4];
#pragma unroll
        for (int m = 0; m < 4; ++m) { ra[m] = (f32x4){0.f, 0.f, 0.f, 0.f}; rx[m] = (f32x4){0.f, 0.f, 0.f, 0.f};
#pragma unroll
            for (int ks = 0; ks < 4; ++ks) { const bf16x8 af = *(const LAS bf16x8*)(UB + (16 * m + c16) * LR_UBP + ks * 32 + 8 * g); ra[m] = MFMA16(af, ba[ks], ra[m]); rx[m] = MFMA16(af, bx[ks], rx[m]); } }
#pragma unroll
        for (int m = 0; m < 4; ++m)
#pragma unroll
            for (int j = 0; j < 4; ++j) { const int r = 16 * m + 4 * g + j; const float rr = sigmoid_f(ra[m][j] + b_a), ii = sigmoid_f(rx[m][j] + b_x), la = cl * rr;
                const float a = __expf(la), mult = sqrtf(-expm1f(2.0f * la)); const float u = U32[r * 128 + mcol]; A32[r * 128 + mcol] = a; U32[r * 128 + mcol] = mult * ii * u; }
        __syncthreads();
        if (tid < 128) {
#pragma unroll 8
            for (int r = 0; r < 64; ++r) {
                if (SAMPLE && (r & 7) == 0) hstate = INP(I_SLH)[(size_t)(sidx * 8 + (r >> 3)) * D + h * 128 + tid];
                hstate = A32[r * 128 + tid] * hstate + U32[r * 128 + tid]; U32[r * 128 + tid] = hstate;
                if (SAMPLE && (r & 7) == 7) F.out[O_SLH + (size_t)(sidx * 8 + (r >> 3)) * D + h * 128 + tid] = hstate; }
            if (!SAMPLE && chunk == nchunk - 1) F.out[O_PLH + (size_t)sidx * D + h * 128 + tid] = hstate;
        }
        __syncthreads();
#pragma unroll
        for (int i = 0; i < 8; ++i) { const int r = 8 * w + i, R = R0 + r;
            const float h0 = U32[r * 128 + 2 * lane], h1 = U32[r * 128 + 2 * lane + 1];
            const float v0 = h0 * gelu_tanh_f(gg[i].x), v1 = h1 * gelu_tanh_f(gg[i].y);
            *(GAS unsigned*)(WSP(bf16, WS_V) + (size_t)R * DMIX + h * 128 + 2 * lane) = pk2(v0, v1);
            const float q = wave_sum(v0 * v0 + v1 * v1); if (lane == 0) WSP(float, WS_SQV)[(size_t)R * NSQV + h] = q; }
        __syncthreads();
    }
}
constexpr int SD_CS = 0, SD_DT = 256, SD_WG = 512, SD_CM = 1024, SD_BM = 18432, SD_BT = 35840, SD_XT = 54272, SD_XS = 63488, SD_HB = 72704, SD_XF = 90112;
constexpr int SP136 = 136, SP72 = 72, SP68 = 68;
template <int L  >
__device__ __forceinline__ void ssd_item(Frame& F, const Args& A, int sq, int head) {
    constexpr bool SAMPLE = (L == 16); constexpr int LT = L / 16, KK = (L + 31) / 32, TV = SAMPLE ? TS : L;
    LAS float* CS = (LAS float*)(F.lds + SD_CS); LAS float* DT = (LAS float*)(F.lds + SD_DT); LAS float* WG = (LAS float*)(F.lds + SD_WG);
    LAS bf16* CM = (LAS bf16*)(F.lds + SD_CM); LAS bf16* BM = (LAS bf16*)(F.lds + SD_BM); LAS bf16* BT = (LAS bf16*)(F.lds + SD_BT);
    LAS bf16* XT = (LAS bf16*)(F.lds + SD_XT); LAS bf16* XS = (LAS bf16*)(F.lds + SD_XS); LAS bf16* HB = (LAS bf16*)(F.lds + SD_HB); LAS float* XF = (LAS float*)(F.lds + SD_XF);
    const int tid = F.tid, lane = F.lane, w = F.wave, c16 = lane & 15, g = lane >> 4, grp = head >> 4;
    const float* P = WSP(float, WS_PROJ);
    const float Aneg = -__expf(INP(I_SALOG)[head]), dtb = INP(I_SDTB)[head], Dh = INP(I_SD)[head];
    const int hpt = w & 3, hnt0 = 4 * (w >> 2);
    f32x4 Hacc[4];
    const size_t hbase = ((size_t)(sq * SSD_H + head) * SSD_P) * SSD_N;
#pragma unroll
    for (int i = 0; i < 4; ++i)
#pragma unroll
        for (int j = 0; j < 4; ++j) Hacc[i][j] = SAMPLE ? INP(I_SSH)[hbase + (size_t)(16 * hpt + 4 * g + j) * SSD_N + 16 * (hnt0 + i) + c16] : 0.f;
    const int cgb = lane, rbb = w, gx = lane & 15, rsub = lane >> 4, rp = 4 * w + rsub;
    const int xcb = 2048 + (cgb >> 5) * 256 + grp * 128 + 4 * (cgb & 31), xcx = head * 64 + 4 * gx;
    const bool actB = SAMPLE ? (w < 2) : true, actX = SAMPLE ? (w < 2) : true;
    const unsigned voffb = (unsigned)(C_XBC + xcb) * 4u, voffxx = (unsigned)(rsub * 2 * DINP + C_XBC + xcx) * 4u, voffxs = (unsigned)(rsub * 2 * XBC + xcx) * 4u;
    f32x4 wB[4], wX[4], bB, bX;
#pragma unroll
    for (int k = 0; k < 4; ++k) { wB[k] = *(const GAS f32x4*)(INP(I_SCW) + (size_t)k * XBC + xcb); wX[k] = *(const GAS f32x4*)(INP(I_SCW) + (size_t)k * XBC + xcx); }
    bB = *(const GAS f32x4*)(INP(I_SCB) + xcb); bX = *(const GAS f32x4*)(INP(I_SCB) + xcx);
    f32x4 rawB[11], rawX[5]; float rawdt = 0.f;
#define SSD_LDROW(dst_, chunk_, rr_, rl_, vp_, vs_) do { const int rr__ = (rr_); const int tu__ = SAMPLE ? rr__ : (chunk_) * 64 + rr__; const int tl__ = SAMPLE ? (rl_) : (chunk_) * 64 + (rl_); \
        const GAS char* pb__ = (const GAS char*)(P + (size_t)((SAMPLE ? MP + sq * TS : sq * TP + (chunk_) * 64) + rr__) * DINP); \
        const GAS char* sb__ = (const GAS char*)(INP(I_SSC) + (size_t)(sq * 3 + 3 + tu__) * XBC); \
        if ((rl_) >= TV) dst_ = (f32x4){0.f, 0.f, 0.f, 0.f}; \
        else if (tl__ >= 0) dst_ = *(const GAS f32x4*)(pb__ + (vp_)); \
        else if (SAMPLE) dst_ = *(const GAS f32x4*)(sb__ + (vs_)); \
        else dst_ = (f32x4){0.f, 0.f, 0.f, 0.f}; } while (0)
#define SSD_ISSUE(chunk_) do { \
        if (actB) { _Pragma("unroll") for (int i = 0; i < 11; ++i) SSD_LDROW(rawB[i], chunk_, 8 * rbb - 3 + i, 8 * rbb - 3 + i, voffb, (unsigned)xcb * 4u); } \
        if (actX) { _Pragma("unroll") for (int i = 0; i < 5; ++i) SSD_LDROW(rawX[i], chunk_, 8 * w - 3 + i, 2 * rp - 3 + i, voffxx, voffxs); } \
        if (w == 0) { const int r_ = lane; const int R_ = SAMPLE ? MP + sq * TS + r_ : sq * TP + (chunk_) * 64 + r_; rawdt = (r_ < TV) ? P[(size_t)R_ * DINP + C_DT + head] : 0.f; } } while (0)
    SSD_ISSUE(0);
#pragma unroll
    for (int i = 0; i < 4; ++i)
#pragma unroll
        for (int j = 0; j < 4; ++j) HB[(16 * hpt + 4 * g + j) * SP136 + 16 * (hnt0 + i) + c16] = (bf16)f2bf(Hacc[i][j]);
    if (SAMPLE) {
        for (int e = tid; e < 64 * 16; e += 512) { const int p = e >> 4, c = 16 + (e & 15); XT[p * SP72 + c] = 0; XS[p * SP72 + c] = 0; }
        for (int e = tid; e < 128 * 16; e += 512) { const int n = e >> 4, c = 16 + (e & 15); BT[n * SP72 + c] = 0; }
    }
    const int nchunk = SAMPLE ? 1 : TP / 64;
    for (int chunk = 0; chunk < nchunk; ++chunk) {
        int ln_ = lane; asm volatile("" : "+v"(ln_));
        const int lane = ln_, c16 = lane & 15, g = lane >> 4, cgb = lane, gx = lane & 15, rsub = lane >> 4, rp = 4 * w + rsub;
        const int R0 = SAMPLE ? MP + sq * TS : sq * TP + chunk * 64;
        const int lt_ = (L == 64) ? (w & 3) : 0, l_ = 16 * lt_ + c16; constexpr int NPT = (L == 64) ? 2 : 1; const int pt0_ = (L == 64) ? 2 * (w >> 2) : (w & 3);
        f32x4 z4[NPT];
#pragma unroll
        for (int pi = 0; pi < NPT; ++pi) { z4[pi] = (f32x4){0.f, 0.f, 0.f, 0.f}; if (l_ < TV) z4[pi] = *(const GAS f32x4*)(P + (size_t)(R0 + l_) * DINP + C_Z + head * 64 + 16 * (pt0_ + pi) + 4 * g); }
        if (actB) {
#pragma unroll
            for (int i = 0; i < 8; ++i) { const int r = 8 * rbb + i; f32x4 v = bB + wB[0] * rawB[i] + wB[1] * rawB[i + 1] + wB[2] * rawB[i + 2] + wB[3] * rawB[i + 3];
                if (r >= TV) v = (f32x4){0.f, 0.f, 0.f, 0.f}; else { v[0] = siluf_(v[0]); v[1] = siluf_(v[1]); v[2] = siluf_(v[2]); v[3] = siluf_(v[3]); }
                v2u pk; pk.x = pk2(v[0], v[1]); pk.y = pk2(v[2], v[3]); const int n = 4 * (cgb & 31);
                if (cgb < 32) { *(LAS v2u*)(BM + r * SP136 + n) = pk; BT[(n + 0) * SP72 + r] = (bf16)(pk.x & 0xffffu); BT[(n + 1) * SP72 + r] = (bf16)(pk.x >> 16); BT[(n + 2) * SP72 + r] = (bf16)(pk.y & 0xffffu); BT[(n + 3) * SP72 + r] = (bf16)(pk.y >> 16); }
                else *(LAS v2u*)(CM + r * SP136 + n) = pk; } }
        if (actX) {
#pragma unroll
            for (int i = 0; i < 2; ++i) { const int r = 2 * rp + i; f32x4 v = bX + wX[0] * rawX[i] + wX[1] * rawX[i + 1] + wX[2] * rawX[i + 2] + wX[3] * rawX[i + 3];
                if (r >= TV) v = (f32x4){0.f, 0.f, 0.f, 0.f}; else { v[0] = siluf_(v[0]); v[1] = siluf_(v[1]); v[2] = siluf_(v[2]); v[3] = siluf_(v[3]); }
                *(LAS f32x4*)(XF + r * SP68 + 4 * gx) = v; const unsigned p0 = pk2(v[0], v[1]), p1 = pk2(v[2], v[3]); const int p = 4 * gx;
                XT[(p + 0) * SP72 + r] = (bf16)(p0 & 0xffffu); XT[(p + 1) * SP72 + r] = (bf16)(p0 >> 16); XT[(p + 2) * SP72 + r] = (bf16)(p1 & 0xffffu); XT[(p + 3) * SP72 + r] = (bf16)(p1 >> 16); } }
        if (w == 0) { const int r = lane; float dt = 0.f;
            if (r < TV) dt = softplus_f(rawdt + dtb);
            float cs = dt * Aneg;
#pragma unroll
            for (int o = 1; o < 64; o <<= 1) { const float up = __shfl_up(cs, o); if (lane >= o) cs += up; }
            const float csl = __shfl(cs, L - 1);
            if (r < L) { CS[r] = cs; DT[r] = dt; WG[r] = __expf(csl - cs) * dt; } }
        if (chunk + 1 < nchunk) SSD_ISSUE(chunk + 1);
        __syncthreads();
        for (int e = tid; e < 64 * L; e += 512) { const int p = e & 63, l = e >> 6; XS[p * SP72 + l] = (bf16)f2bf(XF[l * SP68 + p] * WG[l]); }
        __syncthreads();
        if (L == 64 || w < 4) {
            const int l = l_, pt0 = pt0_;
            bf16x8 cf[4];
#pragma unroll
            for (int ks = 0; ks < 4; ++ks) cf[ks] = *(const LAS bf16x8*)(CM + l * SP136 + ks * 32 + 8 * g);
            const float cs_l = CS[l];
            f32x4 gt[2 * KK];
#pragma unroll
            for (int st = 0; st < 2 * KK; ++st) { gt[st] = (f32x4){0.f, 0.f, 0.f, 0.f};
                if (st < LT) {
#pragma unroll
                    for (int ks = 0; ks < 4; ++ks) { const bf16x8 af = *(const LAS bf16x8*)(BM + (16 * st + c16) * SP136 + ks * 32 + 8 * g); gt[st] = MFMA16(af, cf[ks], gt[st]); }
#pragma unroll
                    for (int j = 0; j < 4; ++j) { const int s = 16 * st + 4 * g + j; gt[st][j] = (s <= l) ? gt[st][j] * __expf(cs_l - CS[s]) * DT[s] : 0.f; } } }
            bf16x8 wf[KK];
#pragma unroll
            for (int kk = 0; kk < KK; ++kk) wf[kk] = pack8(gt[2 * kk], gt[2 * kk + 1]);
            const float ecl = __expf(cs_l); const bool valid = (l < TV); const int R = R0 + l;
#pragma unroll
            for (int pi = 0; pi < NPT; ++pi) { const int pt = pt0 + pi; f32x4 a1 = (f32x4){0.f, 0.f, 0.f, 0.f}, a2 = (f32x4){0.f, 0.f, 0.f, 0.f};
#pragma unroll
                for (int kk = 0; kk < KK; ++kk) { const v2u lo = *(const LAS v2u*)(XT + (16 * pt + c16) * SP72 + 32 * kk + 4 * g), hi = *(const LAS v2u*)(XT + (16 * pt + c16) * SP72 + 32 * kk + 16 + 4 * g);
                    v4u wv; wv.x = lo.x; wv.y = lo.y; wv.z = hi.x; wv.w = hi.y; a1 = MFMA16(__builtin_bit_cast(bf16x8, wv), wf[kk], a1); }
#pragma unroll
                for (int ks = 0; ks < 4; ++ks) { const bf16x8 af = *(const LAS bf16x8*)(HB + (16 * pt + c16) * SP136 + ks * 32 + 8 * g); a2 = MFMA16(af, cf[ks], a2); }
                const f32x4 x4 = *(const LAS f32x4*)(XF + l * SP68 + 16 * pt + 4 * g);
                float v[4], q = 0.f;
#pragma unroll
                for (int j = 0; j < 4; ++j) { const float y = a1[j] + ecl * a2[j] + Dh * x4[j]; v[j] = y * siluf_(z4[pi][j]); q += v[j] * v[j]; }
                q += __shfl_xor(q, 16); q += __shfl_xor(q, 32);
                if (valid) { v2u o; o.x = pk2(v[0], v[1]); o.y = pk2(v[2], v[3]); *(GAS v2u*)(WSP(bf16, WS_V) + (size_t)R * DMIX + 2048 + head * 64 + 16 * pt + 4 * g) = o;
                    if (g == 0) WSP(float, WS_SQV)[(size_t)R * NSQV + 16 + head * 4 + pt] = q; } }
        }
        __syncthreads();
        { const float dec = __expf(CS[L - 1]);
#pragma unroll
          for (int i = 0; i < 4; ++i) Hacc[i] = Hacc[i] * dec;
#pragma unroll
          for (int kk = 0; kk < KK; ++kk) { const bf16x8 af = *(const LAS bf16x8*)(XS + (16 * hpt + c16) * SP72 + 32 * kk + 8 * g);
#pragma unroll
              for (int i = 0; i < 4; ++i) { const bf16x8 bfr = *(const LAS bf16x8*)(BT + (16 * (hnt0 + i) + c16) * SP72 + 32 * kk + 8 * g); Hacc[i] = MFMA16(af, bfr, Hacc[i]); } }
          if (chunk + 1 < nchunk) {
#pragma unroll
              for (int i = 0; i < 4; ++i)
#pragma unroll
                  for (int j = 0; j < 4; ++j) HB[(16 * hpt + 4 * g + j) * SP136 + 16 * (hnt0 + i) + c16] = (bf16)f2bf(Hacc[i][j]); } }
        __syncthreads();
    }
    float* ho = F.out + (SAMPLE ? O_SSH : O_PSH) + hbase;
#pragma unroll
    for (int i = 0; i < 4; ++i)
#pragma unroll
        for (int j = 0; j < 4; ++j) ho[(size_t)(16 * hpt + 4 * g + j) * SSD_N + 16 * (hnt0 + i) + c16] = Hacc[i][j];
}
__device__ __forceinline__ void p4_mixer_prompt(Frame& F, const Args& A) {
    for (int it = blockIdx.x; it < 64 + 128; it += F.G) {
        if (it < 64) lru_item<false>(F, A, it >> 4, it & 15); else ssd_item<64>(F, A, (it - 64) >> 5, (it - 64) & 31);
    }
}
__device__ __forceinline__ void p4_mixer_sample(Frame& F, const Args& A, int qoff) {
    for (;;) {
        __syncthreads();
        if (F.tid == 0) F.MISC[0] = __hip_atomic_fetch_add(F.ctl + CW_QUEUE + qoff, 1u, RLX_AGENT);
        __syncthreads();
        const int it = (int)F.MISC[0];
        if (it >= 256 + NBS * SSD_H) break;
        if (it < 256) lru_item<true>(F, A, it >> 4, it & 15); else ssd_item<16>(F, A, (it - 256) >> 5, (it - 256) & 31);
    }
}

#ifndef DUP_PHASE
#define DUP_PHASE -1
#endif
#ifndef MK_PER_PHASE
#define MK_PER_PHASE 0
#endif
constexpr int N_PHASES = 14;
constexpr int CW_QH = 20480;
template <class Epi> __device__ __forceinline__ void run_gemm_r(Frame& F, const bf16* Aop, const bf16* Bt, int Mr, int N, int K, const Epi& E, int lo, int n, int G, int c) {
    pg8::Gemm g{Aop, Bt, Mr, N, K}; pg8::RangeOrder R; R.init(Mr, N, lo, n, G, c);
    pg8::gemm_phase<Epi, pg8::RangeOrder, PG8_ALIGN, PG8_SP2>(F.lds + RING_OFF, g, R, E);
}
__global__ void __launch_bounds__(NWAVES * 64, 2) hymba_fwd(Args args) {
    extern __shared__ __attribute__((aligned(16))) unsigned char lds[];
    const Args& A = args;
    Frame F;
    F.lds = (LAS unsigned char*)lds;
    F.MISC = (volatile LAS unsigned*)(F.lds + MISC_OFF);
    F.tid = threadIdx.x; F.lane = F.tid & 63; F.wave = __builtin_amdgcn_readfirstlane(F.tid >> 6);
    F.G = gridDim.x; { const int bx = blockIdx.x; F.vcu = (F.G % 8 == 0) ? (bx % 8) * (F.G / 8) + bx / 8 : bx; }
    F.ws = args.ws; F.out = args.out; F.ctl = (gu32*)(args.ws + WS_CTL);
    for (int u = F.tid; u < (LDS_BYTES - LDSCTL_OFF) / 4; u += NWAVES * 64) ((LAS unsigned*)(F.lds + LDSCTL_OFF))[u] = 0u;
    __syncthreads();
    XcdBarrier bar = xcd_barrier_post((unsigned*)(F.ctl + CW_BAR), F.MISC + 8);
#define GRID_BAR() xcd_barrier(bar)
#define SLOT_BEGIN(slot_) do { cu = 0u; Sx = 0; if (xq == -2) { unsigned ok = 1u; for (int j = 0; j < 16; ++j) { const unsigned c_ = xb_ld((unsigned*)(F.ctl + CW_BAR) + XB_XCNT(j)); ok &= (j < 8) ? (c_ > 0u) : (c_ == 0u); } \
            xq = ok ? (int)(bar.x & 7u) : -1; } \
        __syncthreads(); if (F.tid == 0) F.MISC[16] = __hip_atomic_fetch_add(F.ctl + CW_QH + 64 * ((slot_) * 8 + (xq < 0 ? 0 : xq)), 1u, RLX_AGENT); __syncthreads(); } while (0)
    const int lo = args.ph_lo, hi = args.ph_hi;
#define IN(k) (lo <= (k) && (k) < hi)
#define BOTH(k) (IN(k) && IN((k) + 1))
    const int bid = blockIdx.x;
    float* SSQ0 = WSP(float, WS_SSQ); float* SSQ1 = SSQ0 + (size_t)M * NSSQ; float* SSQ2 = SSQ1 + (size_t)M * NSSQ; float* SSQ3 = SSQ2 + (size_t)M * NSSQ; float* SSQ4 = SSQ3 + (size_t)M * NSSQ;
    unsigned cu = 0u; int Sx = 0, xq = -2;
    bf16* XBA = WSP(bf16, WS_XBA); bf16* XBB = WSP(bf16, WS_XBB); bf16* ACT = WSP(bf16, WS_ACT); float* XR = WSP(float, WS_XR); bf16* VV = WSP(bf16, WS_V); bf16* QQ = WSP(bf16, WS_Q); bf16* OO = WSP(bf16, WS_O);
    constexpr float QSCALE = 0.04419417382415922f;

    if (IN(0)) { p0_prologue(F, A); if (BOTH(0)) GRID_BAR(); }
    constexpr int U_GU_P = (MP / 256) * (NGU / 256), U_GU_S = (MS / 256) * (NGU / 256), U_D_P = (MP / 256) * (D / 256), U_D_S = (MS / 256) * (D / 256), U_IN_P = (MP / 256) * (DINP / 256), U_IN_S = (MS / 256) * (DINP / 256), U_KV = (MMEM / 256) * (2 * D / 256);
    const int G = F.G, c32 = bid - 32;
    if (IN(1)) {
        { pg8::EpiKV E{F.out + O_PMK, F.out + O_PMV, WSP(bf16, WS_KM), WSP(bf16, WS_VT), WSP(float, WS_SSQM), 0}; run_gemm_r(F, WSP(bf16, WS_MEMB), WSP(bf16, WS_WKV), MMEM, 2 * D, D, E, 0, U_KV, G, bid); }
        { pg8::EpiSwiglu E{ACT, FF, SSQ0, MP}; run_gemm_r(F, XBA + (size_t)MP * D, WSP(bf16, WS_W1GU), MS, NGU, D, E, 0, U_GU_S, G, bid - 64 >= 0 ? bid - 64 : bid + G - 64); }
        if (BOTH(1)) GRID_BAR(); }
    if (IN(2)) {
        { pg8::EpiRes<true, true> E{INP(I_XP), INP(I_XS), XR, XBB, SSQ1, 0.5f, MP}; run_gemm_r(F, ACT + (size_t)MP * FF, WSP(bf16, WS_W1D), MS, D, FF, E, 0, U_D_S, 32, bid < 32 ? bid : -1); }
        { pg8::EpiSwiglu E{ACT, FF, SSQ0, 0}; if (bid < 32) run_gemm_r(F, XBA, WSP(bf16, WS_W1GU), MP, NGU, D, E, U_GU_P - 96, 96, 32, bid); else run_gemm_r(F, XBA, WSP(bf16, WS_W1GU), MP, NGU, D, E, 0, U_GU_P - 96, G - 32, c32); }
        if (BOTH(2)) GRID_BAR(); }
    if (IN(3)) {
        { pg8::EpiRes<true, true> E{INP(I_XP), INP(I_XS), XR, XBB, SSQ1, 0.5f, 0}; run_gemm_r(F, ACT, WSP(bf16, WS_W1D), MP, D, FF, E, 0, U_D_P, G, bid); }
        { pg8::EpiProj E{WSP(float, WS_PROJ), DINP, SSQ1, MP}; run_gemm_r(F, XBB + (size_t)MP * D, WSP(bf16, WS_WIN), MS, DINP, D, E, 0, U_IN_S, G, bid); }
        if (BOTH(3)) GRID_BAR(); }
    if (IN(4)) {
        { pg8::EpiProj E{WSP(float, WS_PROJ), DINP, SSQ1, 0}; run_gemm_r(F, XBB, WSP(bf16, WS_WIN), MP, DINP, D, E, 0, U_IN_P, G, bid); }
        p4_mixer_sample(F, A, 0);
        if (BOTH(4)) GRID_BAR(); }
    if (IN(5)) {
        p4_mixer_prompt(F, A);
        if (F.G > 192) { if (bid >= 192) p5_normalize(F, A, MP, M, NBP, NBP + NBS, (bid - 192) * NWAVES + F.wave, (F.G - 192) * NWAVES); }
        else p5_normalize(F, A, MP, M, NBP, NBP + NBS, F.vcu * NWAVES + F.wave, F.G * NWAVES);
        if (BOTH(5)) GRID_BAR(); }
    if (IN(6)) {
        { pg8::EpiRes<false, true> E{nullptr, nullptr, XR, XBA, SSQ2, 1.0f, MP}; run_gemm_r(F, VV + (size_t)MP * DMIX, WSP(bf16, WS_WOUT), MS, D, DMIX, E, 0, U_D_S, 32, bid < 32 ? bid : -1); }
        if (G > 32) { if (bid >= 32) p5_normalize(F, A, 0, MP, 0, NBP, c32 * NWAVES + F.wave, (G - 32) * NWAVES); } else p5_normalize(F, A, 0, MP, 0, NBP, F.vcu * NWAVES + F.wave, G * NWAVES);
        if (BOTH(6)) GRID_BAR(); }
    if (IN(7)) {
        { pg8::EpiRes<false, true> E{nullptr, nullptr, XR, XBA, SSQ2, 1.0f, 0}; run_gemm_r(F, VV, WSP(bf16, WS_WOUT), MP, D, DMIX, E, 0, U_D_P, G, bid); }
        { pg8::EpiQ E{QQ, SSQ2, QSCALE, MP}; run_gemm_r(F, XBA + (size_t)MP * D, WSP(bf16, WS_WQ), MS, D, D, E, 0, U_D_S, 32, bid < 32 ? bid : -1); }
        if (BOTH(7)) GRID_BAR(); }
    if (IN(8)) {
        { pg8::EpiQ E{QQ, SSQ2, QSCALE, 0}; run_gemm_r(F, XBA, WSP(bf16, WS_WQ), MP, D, D, E, 0, U_D_P, G, bid); }
        p8_attn_sample(F, A);
        if (BOTH(8)) GRID_BAR(); }
    if (IN(9)) {
        { pg8::EpiRes<false, true> E{nullptr, nullptr, XR, XBB, SSQ3, 1.0f, MP}; run_gemm_r(F, OO + (size_t)MP * D, WSP(bf16, WS_WO), MS, D, D, E, 0, U_D_S, 32, bid < 32 ? bid : -1); }
        p8_attn_prompt(F, A);
        if (BOTH(9)) GRID_BAR(); }
    if (IN(10)) {
        { pg8::EpiRes<false, true> E{nullptr, nullptr, XR, XBB, SSQ3, 1.0f, 0}; run_gemm_r(F, OO, WSP(bf16, WS_WO), MP, D, D, E, 0, U_D_P, G, bid); }
        { pg8::EpiSwiglu E{ACT, FF, SSQ3, MP}; run_gemm_r(F, XBB + (size_t)MP * D, WSP(bf16, WS_W2GU), MS, NGU, D, E, 0, U_GU_S, G, bid); }
        if (BOTH(10)) GRID_BAR(); }
    if (IN(11)) {
        { pg8::EpiRes<false, false> E{nullptr, nullptr, XR, nullptr, SSQ4, 0.5f, MP}; run_gemm_r(F, ACT + (size_t)MP * FF, WSP(bf16, WS_W2D), MS, D, FF, E, 0, U_D_S, 32, bid < 32 ? bid : -1); }
        { pg8::EpiSwiglu E{ACT, FF, SSQ3, 0}; if (bid < 32) run_gemm_r(F, XBB, WSP(bf16, WS_W2GU), MP, NGU, D, E, U_GU_P - 96, 96, 32, bid); else run_gemm_r(F, XBB, WSP(bf16, WS_W2GU), MP, NGU, D, E, 0, U_GU_P - 96, G - 32, c32); }
        if (BOTH(11)) GRID_BAR(); }
    if (IN(12)) {
        { pg8::EpiRes<false, false> E{nullptr, nullptr, XR, nullptr, SSQ4, 0.5f, 0}; run_gemm_r(F, ACT, WSP(bf16, WS_W2D), MP, D, FF, E, 0, U_D_P, G, bid); }
        p12_final(F, A, MP, M);
        if (BOTH(12)) GRID_BAR(); }
    if (IN(13)) { p12_final(F, A, 0, MP); }
#undef IN
#undef BOTH
}

extern "C" void kernel_launch(void* const* d_in, const int* in_sizes, int n_in, void* d_out, int out_size, void* d_ws, size_t ws_size, hipStream_t stream) {
    static int grid = 0;
    if (grid == 0) {
        if (n_in != N_IN || (size_t)out_size != O_END || ws_size < WS_END) { fprintf(stderr, "kernel_launch: shape mismatch: n_in %d out %d ws %zu (need %zu)\n", n_in, out_size, ws_size, (size_t)WS_END); grid = -1; return; }
        int dev = 0, cus = 0, per_cu = 0;
        if (hipGetDevice(&dev) != hipSuccess || hipDeviceGetAttribute(&cus, hipDeviceAttributeMultiprocessorCount, dev) != hipSuccess) { grid = -1; return; }
        if (hipFuncSetAttribute((const void*)hymba_fwd, hipFuncAttributeMaxDynamicSharedMemorySize, LDS_BYTES) != hipSuccess) { fprintf(stderr, "kernel_launch: hipFuncSetAttribute failed\n"); grid = -1; return; }
        if (hipOccupancyMaxActiveBlocksPerMultiprocessor(&per_cu, (const void*)hymba_fwd, NWAVES * 64, LDS_BYTES) != hipSuccess || per_cu < 1) { fprintf(stderr, "kernel_launch: occupancy query says %d blocks per CU\n", per_cu); (void)hipGetLastError(); grid = -1; return; }
        grid = cus;
    }
    if (grid < 0) return;
    if (hipMemsetAsync((char*)d_ws + WS_CTL, 0, CTL_ZERO_BYTES, stream) != hipSuccess) return;
    Args a{};
    for (int i = 0; i < N_IN; ++i) a.in[i] = (const float*)d_in[i];
    a.out = (float*)d_out; a.ws = (unsigned char*)d_ws;
    a.ph_lo = 0; a.ph_hi = N_PHASES; hipLaunchKernelGGL(hymba_fwd, dim3(grid), dim3(NWAVES * 64), LDS_BYTES, stream, a);
}
```

```cpp
#include <hip/hip_runtime.h>
#include <cstdio>
#include <cstdint>

constexpr int NWAVES = 8;
constexpr int D = 2048, MP = 8192, MS = 1024, M = MP + MS, TP = 2048, TS = 8, NBP = 4, NBS = 128;
constexpr int FF = 5632, NGU = 2 * FF, DIN = 8736, DINP = 8960, DMIX = 4096, NMEM = 256, MMEM = NBP * NMEM;
constexpr int LRU_H = 16, LRU_B = 128, SSD_H = 32, SSD_P = 64, SSD_N = 128, XBC = 2560;
constexpr int C_XL = 0, C_GL = 2048, C_Z = 4096, C_XBC = 6144, C_DT = 8704;
constexpr float EPS = 1e-6f;
constexpr int NSSQ = 32;
constexpr int NSQV = 160;
constexpr size_t O_Y = 0, O_PLC = (size_t)M * D, O_PLH = O_PLC + (size_t)NBP * 3 * D, O_PSC = O_PLH + (size_t)NBP * D, O_PSH = O_PSC + (size_t)NBP * 3 * XBC,
                 O_PMK = O_PSH + (size_t)NBP * SSD_H * SSD_P * SSD_N, O_PMV = O_PMK + (size_t)MMEM * D, O_SLC = O_PMV + (size_t)MMEM * D, O_SLH = O_SLC + (size_t)NBS * 3 * D,
                 O_SSC = O_SLH + (size_t)NBS * D, O_SSH = O_SSC + (size_t)NBS * 3 * XBC, O_END = O_SSH + (size_t)NBS * SSD_H * SSD_P * SSD_N;
static_assert(O_END == 59766784, "d_out size");
enum { I_XP = 0, I_MEMP, I_XS, I_CK, I_CV, I_SLC, I_SLH, I_SSC, I_SSH, I_F1G, I_F1WG, I_F1WU, I_F1WD, I_MIXG, I_WIN, I_LCW, I_LCB, I_LWA, I_LBA, I_LWX, I_LBX, I_LLAM, I_LOG,
       I_SCW, I_SCB, I_SDTB, I_SALOG, I_SD, I_SOG, I_WOUT, I_XAG, I_MEMG, I_WQ, I_WK, I_WV, I_WO, I_F2G, I_F2WG, I_F2WU, I_F2WD, I_FING, N_IN };
static_assert(N_IN == 41, "inputs");

constexpr size_t MiB = 1u << 20;
constexpr size_t al(size_t x) { return (x + 4095) & ~(size_t)4095; }
constexpr size_t WS_CTL = 0, CTL_ZERO_BYTES = 1 * MiB;
constexpr size_t WS_W1GU = 2 * MiB;
constexpr size_t WS_W1D  = WS_W1GU + al((size_t)NGU * D * 2);
constexpr size_t WS_WIN  = WS_W1D + al((size_t)D * FF * 2);
constexpr size_t WS_WOUT = WS_WIN + al((size_t)DINP * D * 2);
constexpr size_t WS_WQ   = WS_WOUT + al((size_t)D * DMIX * 2);
constexpr size_t WS_WKV  = WS_WQ + al((size_t)D * D * 2);
constexpr size_t WS_WO   = WS_WKV + al((size_t)2 * D * D * 2);
constexpr size_t WS_W2GU = WS_WO + al((size_t)D * D * 2);
constexpr size_t WS_W2D  = WS_W2GU + al((size_t)NGU * D * 2);
constexpr size_t WS_WL   = WS_W2D + al((size_t)D * FF * 2);
constexpr size_t WS_XBA  = WS_WL + al((size_t)LRU_H * 256 * 128 * 2);
constexpr size_t WS_XBB  = WS_XBA + al((size_t)M * D * 2);
constexpr size_t WS_MEMB = WS_XBB + al((size_t)M * D * 2);
constexpr size_t WS_ACT  = WS_MEMB + al((size_t)MMEM * D * 2);
constexpr size_t WS_XR   = WS_ACT + al((size_t)M * FF * 2);
constexpr size_t WS_PROJ = WS_XR + al((size_t)M * D * 4);
constexpr size_t WS_V    = WS_PROJ + al((size_t)M * DINP * 4);
constexpr size_t WS_Q    = WS_V + al((size_t)M * DMIX * 2);
constexpr size_t WS_O    = WS_Q + al((size_t)M * D * 2);
constexpr size_t WS_KM   = WS_O + al((size_t)M * D * 2);
constexpr size_t WS_VT   = WS_KM + al((size_t)MMEM * D * 2);
constexpr size_t WS_SSQ  = WS_VT + al((size_t)MMEM * D * 2);
constexpr size_t WS_SSQM = WS_SSQ + al((size_t)4 * M * NSSQ * 4);
constexpr size_t WS_SQV  = WS_SSQM + al((size_t)MMEM * NSSQ * 4);
constexpr size_t WS_BCC  = WS_SQV + al((size_t)M * NSQV * 4);
constexpr size_t WS_END  = WS_BCC + al((size_t)MP * 512 * 2);
constexpr int CW_TMO = 0, CW_CODE = 1, CW_QUEUE = 64, CW_BAR = 4096;

namespace pg8 {
#define PG8_LAS __attribute__((address_space(3)))
typedef unsigned short bf16_t;
typedef short bf16x8 __attribute__((ext_vector_type(8)));
typedef float f32x4 __attribute__((ext_vector_type(4)));
typedef unsigned u32x4 __attribute__((ext_vector_type(4)));
constexpr int BM = 256, BK = 64, HALF = 128, HTB = HALF * BK * 2  , STAGE_BYTES = 8 * HTB, NXCD = 8, WGM = 8;

__host__ __device__ __forceinline__ int lds_byte(int r, int c) { const int st = (r >> 4) * 2 + (c >> 5), rr = r & 15, cc = c & 31, ob = rr * 64 + cc * 2; return st * 1024 + (ob ^ (((ob >> 9) & 1) << 5)); }
__host__ __device__ __forceinline__ void stage_rc(int b, int& R, int& C) { const int st = b / 1024, sb = b % 1024, swz = sb ^ (((sb >> 9) & 1) << 5); R = (st >> 1) * 16 + swz / 64; C = (st & 1) * 32 + (swz % 64) / 2; }
__host__ __device__ __forceinline__ int perm32(int rho) { const int n = rho >> 4, i = rho & 15; return 8 * (i >> 2) + 4 * n + (i & 3); }

struct Unit { int pm, pn; };
struct Gemm { const bf16_t* A; const bf16_t* Bt; int M, N, K; };

struct StaticOrder {
    int nM, nN, nwg, G, c;
    __host__ __device__ void init(int M, int N, int G_, int c_) { nM = M / BM; nN = N / BM; nwg = nM * nN; G = G_; c = c_; }
    __host__ __device__ bool next(int i, Unit& u) const {
        const long L = (long)i * G + c; if (L >= nwg) return false;
        int wgid = (int)L; { const int q = nwg / NXCD, r = nwg % NXCD, xcd = wgid % NXCD, off = wgid / NXCD; wgid = (xcd < r ? xcd * (q + 1) : r * (q + 1) + (xcd - r) * q) + off; }
        const int nig = WGM * nN, gid = wgid / nig, fm = gid * WGM, gsz = (nM - fm) < WGM ? (nM - fm) : WGM;
        u.pm = fm + ((wgid % nig) % gsz); u.pn = (wgid % nig) / gsz; return true;
    }
    __device__ __forceinline__ void a_ready(const Unit&) const {}
    __device__ __forceinline__ void done(const Unit&) const {}
};

#define PG8_RLX __ATOMIC_RELAXED, __HIP_MEMORY_SCOPE_AGENT
struct QueueOrder {
    int nM, nN, cnt, base, S; unsigned cu;
    unsigned* qhead; volatile PG8_LAS unsigned* slots;
    mutable unsigned pend, taken;
    __device__ __forceinline__ void init(int M, int N, int xq, int& Sx, unsigned cu_, unsigned* qhead_, volatile PG8_LAS unsigned* slots_) {
        nM = M / BM; nN = N / BM; const int nwg = nM * nN;
        if (xq < 0) { base = 0; cnt = nwg; } else { const int q = nwg / NXCD, r = nwg % NXCD; cnt = q + (xq < r ? 1 : 0); base = xq < r ? xq * (q + 1) : r * (q + 1) + (xq - r) * q; }
        S = Sx; Sx += cnt; cu = cu_; qhead = qhead_; slots = slots_; pend = 0u; taken = 0u; }
    __device__ __forceinline__ bool next(int i, Unit& u) const {
        const int L = (int)__builtin_amdgcn_readfirstlane(slots[(cu + (unsigned)i) & 3u]) - S;
        if (L >= cnt) return false;
        const int wgid = base + L, nig = WGM * nN, gid = wgid / nig, fm = gid * WGM, gsz = (nM - fm) < WGM ? (nM - fm) : WGM, rem = wgid - gid * nig;
        u.pm = fm + rem % gsz; u.pn = rem / gsz;
        if (threadIdx.x == 0) pend = __hip_atomic_fetch_add(qhead, 1u, PG8_RLX);
        taken = (unsigned)i + 1u;
        return true;
    }
    __device__ __forceinline__ void a_ready(const Unit&) const {
        if (threadIdx.x == 0) slots[(cu + taken) & 3u] = pend;
        asm volatile("s_waitcnt lgkmcnt(0)" ::: "memory"); __builtin_amdgcn_s_barrier(); asm volatile("" ::: "memory");
    }
    __device__ __forceinline__ void done(const Unit&) const {}
};

struct RangeOrder {
    int nM, nN, lo, n, G, c;
    __device__ __forceinline__ void init(int M, int N, int lo_, int n_, int G_, int c_) { nM = M / BM; nN = N / BM; lo = lo_; n = n_; G = G_; c = c_; }
    __device__ __forceinline__ bool next(int i, Unit& u) const {
        const int Lr = i * G + c; if (c < 0 || c >= G || Lr >= n) return false;
        int w = Lr; { const int q = n / NXCD, r = n % NXCD, xcd = w % NXCD, off = w / NXCD; w = (xcd < r ? xcd * (q + 1) : r * (q + 1) + (xcd - r) * q) + off; }
        const int wgid = lo + w, nig = WGM * nN, gid = wgid / nig, fm = gid * WGM, gsz = (nM - fm) < WGM ? (nM - fm) : WGM, rem = wgid - gid * nig;
        u.pm = fm + rem % gsz; u.pn = rem / gsz; return true;
    }
    __device__ __forceinline__ void a_ready(const Unit&) const {}
    __device__ __forceinline__ void done(const Unit&) const {}
};

__device__ __forceinline__ unsigned cvt_pk_bf16(float lo, float hi) { unsigned r; asm volatile("v_cvt_pk_bf16_f32 %0, %1, %2" : "=v"(r) : "v"(lo), "v"(hi)); return r; }
typedef unsigned u32x2 __attribute__((ext_vector_type(2)));
constexpr float EPS_ = 1e-6f;
__device__ __forceinline__ float row_rstd(const float* ssq, int row, int fq) {
    const f32x4* p = (const f32x4*)(ssq + (size_t)row * 32 + fq * 8);
    const f32x4 a = p[0], b = p[1];
    float s = ((a[0] + a[1]) + (a[2] + a[3])) + ((b[0] + b[1]) + (b[2] + b[3]));
    s += __shfl_xor(s, 16); s += __shfl_xor(s, 32);
    return __builtin_amdgcn_rsqf(s * (1.0f / 2048.0f) + EPS_);
}
__device__ __forceinline__ float silu_f(float x) { return x * __builtin_amdgcn_rcpf(1.0f + __expf(-x)); }

struct EpiSwiglu {
    static constexpr bool PERM = true, AFTER_DRAIN = false;
    bf16_t* O; int ldc; const float* ssq; int rbase;
    __device__ __forceinline__ void operator()(const f32x4 (&acc)[2][2][4][2], const Unit& u, int wr, int wc, int fr, int fq) const {
        const int row0 = rbase + u.pm * BM + wr * 64 + fr, col0 = u.pn * HALF + wc * 32 + 8 * fq;
#pragma unroll
        for (int ai = 0; ai < 2; ++ai)
#pragma unroll
            for (int m = 0; m < 4; ++m) { const int row = row0 + ai * HALF + m * 16; const float rs = row_rstd(ssq, row, fq);
                u32x4 w; float o[8];
#pragma unroll
                for (int n = 0; n < 2; ++n)
#pragma unroll
                    for (int i = 0; i < 4; ++i) { const float g = acc[ai][0][m][n][i] * rs, up = acc[ai][1][m][n][i] * rs; o[4 * n + i] = silu_f(g) * up; }
                w.x = cvt_pk_bf16(o[0], o[1]); w.y = cvt_pk_bf16(o[2], o[3]); w.z = cvt_pk_bf16(o[4], o[5]); w.w = cvt_pk_bf16(o[6], o[7]);
                *(u32x4*)(O + (size_t)row * ldc + col0) = w; }
    }
};
struct EpiKV {
    static constexpr bool PERM = false, AFTER_DRAIN = false;
    float* ko; float* vo; bf16_t* km; bf16_t* vt; const float* ssq; int rbase;
    __device__ __forceinline__ void operator()(const f32x4 (&acc)[2][2][4][2], const Unit& u, int wr, int wc, int fr, int fq) const {
        const int row0 = rbase + u.pm * BM + wr * 64 + fr;
#pragma unroll
        for (int ai = 0; ai < 2; ++ai)
#pragma unroll
            for (int m = 0; m < 4; ++m) { const int row = row0 + ai * HALF + m * 16; const float rs = row_rstd(ssq, row, fq);
#pragma unroll
                for (int bj = 0; bj < 2; ++bj)
#pragma unroll
                    for (int n = 0; n < 2; ++n) { const int col = u.pn * BM + bj * HALF + wc * 32 + n * 16 + 4 * fq; const f32x4 v = acc[ai][bj][m][n] * rs;
                        if (u.pn < 8) { *(f32x4*)(ko + (size_t)row * 2048 + col) = v; u32x2 w; w.x = cvt_pk_bf16(v[0], v[1]); w.y = cvt_pk_bf16(v[2], v[3]); *(u32x2*)(km + (size_t)row * 2048 + col) = w; }
                        else { const int c2 = col - 2048; *(f32x4*)(vo + (size_t)row * 2048 + c2) = v; const int b = row >> 8, key = row & 255;
                            const unsigned w0 = cvt_pk_bf16(v[0], v[1]), w1 = cvt_pk_bf16(v[2], v[3]); bf16_t* t = vt + ((size_t)(b * 2048 + c2)) * 256 + key;
                            t[0] = (bf16_t)(w0 & 0xffffu); t[256] = (bf16_t)(w0 >> 16); t[512] = (bf16_t)(w1 & 0xffffu); t[768] = (bf16_t)(w1 >> 16); } } }
    }
};
template <bool FIRST, bool WRITE_XB> struct EpiRes {
    static constexpr bool PERM = false, AFTER_DRAIN = false;
    const float* xp; const float* xs; float* xr; bf16_t* xb; float* ssq_out; float alpha; int rbase;
    __device__ __forceinline__ void operator()(const f32x4 (&acc)[2][2][4][2], const Unit& u, int wr, int wc, int fr, int fq) const {
        const int row0 = rbase + u.pm * BM + wr * 64 + fr;
#pragma unroll
        for (int ai = 0; ai < 2; ++ai)
#pragma unroll
            for (int m = 0; m < 4; ++m) { const int row = row0 + ai * HALF + m * 16; float q = 0.f;
                const float* base = FIRST ? (row < 8192 ? xp + (size_t)row * 2048 : xs + (size_t)(row - 8192) * 2048) : xr + (size_t)row * 2048;
#pragma unroll
                for (int bj = 0; bj < 2; ++bj)
#pragma unroll
                    for (int n = 0; n < 2; ++n) { const int col = u.pn * BM + bj * HALF + wc * 32 + n * 16 + 4 * fq; const f32x4 b = *(const f32x4*)(base + col); const f32x4 o = b + acc[ai][bj][m][n] * alpha;
                        *(f32x4*)(xr + (size_t)row * 2048 + col) = o; q += (o[0] * o[0] + o[1] * o[1]) + (o[2] * o[2] + o[3] * o[3]);
                        if (WRITE_XB) { u32x2 w; w.x = cvt_pk_bf16(o[0], o[1]); w.y = cvt_pk_bf16(o[2], o[3]); *(u32x2*)(xb + (size_t)row * 2048 + col) = w; } }
                q += __shfl_xor(q, 16); q += __shfl_xor(q, 32);
                if (fq == 0) ssq_out[(size_t)row * 32 + u.pn * 4 + wc] = q; }
    }
};
struct EpiProj {
    static constexpr bool PERM = false, AFTER_DRAIN = false;
    float* C; int ldc; const float* ssq; int rbase;
    __device__ __forceinline__ void operator()(const f32x4 (&acc)[2][2][4][2], const Unit& u, int wr, int wc, int fr, int fq) const {
        const int row0 = rbase + u.pm * BM + wr * 64 + fr;
#pragma unroll
        for (int ai = 0; ai < 2; ++ai)
#pragma unroll
            for (int m = 0; m < 4; ++m) { const int row = row0 + ai * HALF + m * 16; const float rs = row_rstd(ssq, row, fq);
#pragma unroll
                for (int bj = 0; bj < 2; ++bj)
#pragma unroll
                    for (int n = 0; n < 2; ++n) { const int col = u.pn * BM + bj * HALF + wc * 32 + n * 16 + 4 * fq; *(f32x4*)(C + (size_t)row * ldc + col) = acc[ai][bj][m][n] * rs; } }
    }
};
struct EpiQ {
    static constexpr bool PERM = true, AFTER_DRAIN = false;
    bf16_t* O; const float* ssq; float scale; int rbase;
    __device__ __forceinline__ void operator()(const f32x4 (&acc)[2][2][4][2], const Unit& u, int wr, int wc, int fr, int fq) const {
        const int row0 = rbase + u.pm * BM + wr * 64 + fr, col0 = u.pn * BM + wc * 32 + 8 * fq;
#pragma unroll
        for (int ai = 0; ai < 2; ++ai)
#pragma unroll
            for (int m = 0; m < 4; ++m) { const int row = row0 + ai * HALF + m * 16; const float rs = row_rstd(ssq, row, fq) * scale;
#pragma unroll
                for (int bj = 0; bj < 2; ++bj) { const f32x4 v0 = acc[ai][bj][m][0] * rs, v1 = acc[ai][bj][m][1] * rs;
                    u32x4 w; w.x = cvt_pk_bf16(v0[0], v0[1]); w.y = cvt_pk_bf16(v0[2], v0[3]); w.z = cvt_pk_bf16(v1[0], v1[1]); w.w = cvt_pk_bf16(v1[2], v1[3]);
                    *(u32x4*)(O + (size_t)row * 2048 + col0 + bj * HALF) = w; } }
    }
};

template <class Epi, class Sched, bool ALIGN_EPI = false, bool SP2 = false>
__device__ __forceinline__ void gemm_phase(PG8_LAS unsigned char* lds, const Gemm g, const Sched& S, const Epi& E) {
    const int tid = threadIdx.x, wid = __builtin_amdgcn_readfirstlane(tid >> 6), lane = tid & 63, wr = wid >> 2, wc = wid & 3, fr = lane & 15, fq = lane >> 4;
    const int K = g.K, nt = K / BK;
    unsigned voffA[2], voffB[2];
#pragma unroll
    for (int i = 0; i < 2; ++i) { int R, C; stage_rc(tid * 16 + i * 8192, R, C); const int Rb = Epi::PERM ? ((R & ~31) + perm32(R & 31)) : R;
        voffA[i] = (unsigned)(R * K + C) * 2u; voffB[i] = (unsigned)(Rb * K + C) * 2u; }
    const size_t kstep = (size_t)(BK * 2);
    const size_t hstep = (size_t)HALF * K * 2;
    const size_t tstep = 2 * hstep;
    const unsigned ldsw = (unsigned)wid * 1024u;
    const int aoff = lds_byte(wr * 64 + fr, fq * 8), boff = lds_byte(wc * 32 + fr, fq * 8);
#define PG8_SA(b, h) (((b) * 2 + (h)) * HTB)
#define PG8_SB(b, h) ((4 + (b) * 2 + (h)) * HTB)
#define PG8_STAGE(bufoff, gbase, voff) do { _Pragma("unroll") for (int _i = 0; _i < 2; ++_i) \
        __builtin_amdgcn_global_load_lds((const unsigned*)((const char*)(gbase) + (voff)[_i]), (PG8_LAS unsigned*)(lds + (bufoff) + ldsw + _i * 8192), 16, 0, 0); } while (0)
#define PG8_LDA(dst, b, h) do { _Pragma("unroll") for (int m = 0; m < 4; ++m) _Pragma("unroll") for (int k = 0; k < 2; ++k) dst[m][k] = *(const PG8_LAS bf16x8*)(lds + PG8_SA(b, h) + aoff + m * 2048 + k * 1024); } while (0)
#define PG8_LDB(dst, b, h) do { _Pragma("unroll") for (int n = 0; n < 2; ++n) _Pragma("unroll") for (int k = 0; k < 2; ++k) dst[n][k] = *(const PG8_LAS bf16x8*)(lds + PG8_SB(b, h) + boff + n * 2048 + k * 1024); } while (0)
#define PG8_MMA(ai, bj, At, Bt) do { __builtin_amdgcn_s_setprio(1); _Pragma("unroll") for (int m = 0; m < 4; ++m) _Pragma("unroll") for (int n = 0; n < 2; ++n) _Pragma("unroll") for (int k = 0; k < 2; ++k) \
        acc[ai][bj][m][n] = __builtin_amdgcn_mfma_f32_16x16x32_bf16(Bt[n][k], At[m][k], acc[ai][bj][m][n], 0, 0, 0); __builtin_amdgcn_s_setprio(0); } while (0)
#define PG8_WAIT_V(n) asm volatile("s_waitcnt vmcnt(" #n ")" ::: "memory")
#define PG8_WAIT_L(n) asm volatile("s_waitcnt lgkmcnt(" #n ")" ::: "memory")
#define PG8_BAR __builtin_amdgcn_s_barrier()
#define PG8_SCHED __builtin_amdgcn_sched_barrier(0)
    Unit cur, nxt; int ui = 0;
    if (!S.next(0, cur)) return;
    f32x4 acc[2][2][4][2];
#pragma unroll
    for (int a = 0; a < 2; ++a)
#pragma unroll
        for (int b = 0; b < 2; ++b)
#pragma unroll
            for (int m = 0; m < 4; ++m)
#pragma unroll
                for (int n = 0; n < 2; ++n) acc[a][b][m][n] = (f32x4){0.f, 0.f, 0.f, 0.f};
    bf16x8 At[4][2], B0[2][2], B1[2][2];
    const char* cA = (const char*)g.A + (size_t)cur.pm * tstep; const char* cB = (const char*)g.Bt + (size_t)cur.pn * tstep;
    S.a_ready(cur);
    if constexpr (SP2) {
        PG8_STAGE(PG8_SB(0, 0), cB, voffB); PG8_STAGE(PG8_SB(0, 1), cB + hstep, voffB); PG8_STAGE(PG8_SA(0, 0), cA, voffA); PG8_STAGE(PG8_SA(0, 1), cA + hstep, voffA);
        if (wr == 1) PG8_BAR;
        PG8_WAIT_V(2); PG8_BAR;
        PG8_STAGE(PG8_SB(1, 0), cB + kstep, voffB); PG8_STAGE(PG8_SA(1, 0), cA + kstep, voffA); PG8_STAGE(PG8_SB(1, 1), cB + hstep + kstep, voffB);
        PG8_WAIT_V(6); PG8_BAR;
    } else {
        PG8_STAGE(PG8_SB(0, 0), cB, voffB); PG8_STAGE(PG8_SA(0, 0), cA, voffA); PG8_STAGE(PG8_SB(0, 1), cB + hstep, voffB); PG8_STAGE(PG8_SA(0, 1), cA + hstep, voffA);
        if (wr == 1) PG8_BAR;
        PG8_WAIT_V(4); PG8_BAR;
        PG8_STAGE(PG8_SB(1, 0), cB + kstep, voffB); PG8_STAGE(PG8_SA(1, 0), cA + kstep, voffA); PG8_STAGE(PG8_SB(1, 1), cB + hstep + kstep, voffB);
        PG8_WAIT_V(6); PG8_BAR;
    }
    for (;;) {
        const bool has_next = S.next(ui + 1, nxt);
        const char* nA = has_next ? (const char*)g.A + (size_t)nxt.pm * tstep : cA; const char* nB = has_next ? (const char*)g.Bt + (size_t)nxt.pn * tstep : cB;
        for (int t = 0; t < nt; t += 2) {
            const bool last = (t == nt - 2);
            const char* a1 = cA + (size_t)(t + 1) * kstep;
            const char* a2 = last ? nA : cA + (size_t)(t + 2) * kstep; const char* b2 = last ? nB : cB + (size_t)(t + 2) * kstep;
            const char* a3 = a2 + kstep; const char* b3 = b2 + kstep;
            if (last && has_next) S.a_ready(nxt);
            if constexpr (SP2) {
            PG8_LDB(B0, 0, 0); PG8_LDB(B1, 0, 1); PG8_SCHED; PG8_LDA(At, 0, 0); PG8_STAGE(PG8_SA(1, 1), a1 + hstep, voffA);
            PG8_WAIT_V(8); PG8_WAIT_L(0); PG8_BAR; PG8_MMA(0, 0, At, B0); PG8_MMA(0, 1, At, B1); PG8_BAR; PG8_SCHED;
            PG8_LDA(At, 0, 1); PG8_STAGE(PG8_SB(0, 0), b2, voffB); PG8_STAGE(PG8_SB(0, 1), b2 + hstep, voffB); PG8_STAGE(PG8_SA(0, 0), a2, voffA);
            PG8_WAIT_V(8); PG8_WAIT_L(0); PG8_BAR; PG8_MMA(1, 0, At, B0); PG8_MMA(1, 1, At, B1); PG8_BAR; PG8_SCHED;
            PG8_LDB(B0, 1, 0); PG8_LDB(B1, 1, 1); PG8_SCHED; PG8_LDA(At, 1, 0); PG8_STAGE(PG8_SA(0, 1), a2 + hstep, voffA);
            PG8_WAIT_V(8); PG8_WAIT_L(0); PG8_BAR; PG8_MMA(0, 0, At, B0); PG8_MMA(0, 1, At, B1); PG8_BAR; PG8_SCHED;
            PG8_LDA(At, 1, 1); PG8_STAGE(PG8_SB(1, 0), b3, voffB); PG8_STAGE(PG8_SB(1, 1), b3 + hstep, voffB); PG8_STAGE(PG8_SA(1, 0), a3, voffA);
            PG8_WAIT_V(8); PG8_WAIT_L(0); PG8_BAR; PG8_MMA(1, 0, At, B0); PG8_MMA(1, 1, At, B1); PG8_BAR; PG8_SCHED;
            } else {
            PG8_LDB(B0, 0, 0); PG8_SCHED; PG8_LDA(At, 0, 0); PG8_STAGE(PG8_SA(1, 1), a1 + hstep, voffA);
            PG8_WAIT_L(8); PG8_BAR; PG8_WAIT_L(0); PG8_MMA(0, 0, At, B0); PG8_BAR; PG8_SCHED;
            PG8_LDB(B1, 0, 1); PG8_STAGE(PG8_SB(0, 0), b2, voffB);
            PG8_BAR; PG8_WAIT_L(0); PG8_MMA(0, 1, At, B1); PG8_BAR;
            PG8_LDA(At, 0, 1); PG8_STAGE(PG8_SA(0, 0), a2, voffA);
            PG8_BAR; PG8_WAIT_L(0); PG8_MMA(1, 0, At, B0); PG8_BAR; PG8_SCHED;
            PG8_STAGE(PG8_SB(0, 1), b2 + hstep, voffB);
            PG8_WAIT_V(6); PG8_BAR; PG8_MMA(1, 1, At, B1); PG8_BAR;
            PG8_LDB(B0, 1, 0); PG8_SCHED; PG8_LDA(At, 1, 0); PG8_STAGE(PG8_SA(0, 1), a2 + hstep, voffA);
            PG8_WAIT_L(8); PG8_BAR; PG8_WAIT_L(0); PG8_MMA(0, 0, At, B0); PG8_BAR; PG8_SCHED;
            PG8_LDB(B1, 1, 1); PG8_STAGE(PG8_SB(1, 0), b3, voffB);
            PG8_BAR; PG8_WAIT_L(0); PG8_MMA(0, 1, At, B1); PG8_BAR;
            PG8_LDA(At, 1, 1); PG8_STAGE(PG8_SA(1, 0), a3, voffA);
            PG8_BAR; PG8_WAIT_L(0); PG8_MMA(1, 0, At, B0); PG8_BAR; PG8_SCHED;
            PG8_STAGE(PG8_SB(1, 1), b3 + hstep, voffB);
            PG8_WAIT_V(6); PG8_BAR; PG8_MMA(1, 1, At, B1); PG8_BAR;
            }
        }
        if constexpr (ALIGN_EPI) { if (wr == 0) PG8_BAR; }
        if constexpr (!Epi::AFTER_DRAIN) { E(acc, cur, wr, wc, fr, fq); S.done(cur); }
        if (!has_next) break;
#pragma unroll
        for (int a = 0; a < 2; ++a)
#pragma unroll
            for (int b = 0; b < 2; ++b)
#pragma unroll
                for (int m = 0; m < 4; ++m)
#pragma unroll
                    for (int n = 0; n < 2; ++n) acc[a][b][m][n] = (f32x4){0.f, 0.f, 0.f, 0.f};
        cur = nxt; cA = nA; cB = nB; ++ui;
        if constexpr (ALIGN_EPI) { if (wr == 1) PG8_BAR; }
    }
    PG8_WAIT_V(0);
    if constexpr (!ALIGN_EPI) { if (wr == 0) PG8_BAR; }
    PG8_BAR;
    if constexpr (Epi::AFTER_DRAIN) { E.fused(acc, cur, wr, wc, fr, fq, lds, wid, lane); S.done(cur); }
#undef PG8_SA
#undef PG8_SB
#undef PG8_STAGE
#undef PG8_LDA
#undef PG8_LDB
#undef PG8_MMA
#undef PG8_WAIT_V
#undef PG8_WAIT_L
#undef PG8_BAR
#undef PG8_SCHED
}
}
#ifndef PG8_SP2
#define PG8_SP2 true
#endif
#ifndef PG8_ALIGN
#define PG8_ALIGN true
#endif
constexpr int RING_OFF = 0, RING_BYTES = 131072;
constexpr int LDSCTL_OFF = RING_BYTES, MISC_OFF = LDSCTL_OFF + 320;
constexpr int LDS_BYTES = 147456;
static_assert(MISC_OFF + 128 <= LDS_BYTES, "LDS map");

#define GAS __attribute__((address_space(1)))
#define LAS __attribute__((address_space(3)))
typedef unsigned short bf16;
typedef unsigned v4u __attribute__((ext_vector_type(4)));
typedef unsigned v2u __attribute__((ext_vector_type(2)));
typedef float f32x4 __attribute__((ext_vector_type(4)));
typedef float f32x2 __attribute__((ext_vector_type(2)));
typedef short bf16x8 __attribute__((ext_vector_type(8)));
typedef short bf16x4 __attribute__((ext_vector_type(4)));
typedef GAS unsigned gu32;
#define RLX_AGENT __ATOMIC_RELAXED, __HIP_MEMORY_SCOPE_AGENT
#define LDS_WAIT() asm volatile("s_waitcnt lgkmcnt(0)" ::: "memory")
#define VM_WAIT() asm volatile("s_waitcnt vmcnt(0)" ::: "memory")
__device__ __forceinline__ unsigned f2bf(float f) { unsigned u = __builtin_bit_cast(unsigned, f); return (u + 0x7fffu + ((u >> 16) & 1u)) >> 16; }
__device__ __forceinline__ unsigned pk2(float lo, float hi) { return f2bf(lo) | (f2bf(hi) << 16); }
__device__ __forceinline__ float bf2f(unsigned b) { return __builtin_bit_cast(float, b << 16); }
__device__ __forceinline__ float wave_sum(float v) {
#pragma unroll
    for (int o = 1; o < 64; o <<= 1) v += __shfl_xor(v, o);
    return v;
}
__device__ __forceinline__ float sigmoid_f(float x) { return __builtin_amdgcn_rcpf(1.0f + __expf(-x)); }
__device__ __forceinline__ float siluf_(float x) { return x * sigmoid_f(x); }
__device__ __forceinline__ float softplus_f(float x) { return x > 20.f ? x : log1pf(__expf(x)); }
__device__ __forceinline__ float gelu_tanh_f(float x) { const float t = 0.7978845608028654f * (x + 0.044715f * x * x * x); return x * sigmoid_f(2.0f * t); }
#define MFMA16(a, b, c) __builtin_amdgcn_mfma_f32_16x16x32_bf16((a), (b), (c), 0, 0, 0)

#define XB_TMO      128
#define XB_XCNT(j)  (256  + 64 * (j))
#define XB_XSUB(j)  (1280 + 64 * (j))
#define XB_XGEN(j)  (2304 + 64 * (j))
#define XB_TOP      3328
#define XB_TOPGEN   3392
#define XCD_BAR_WORDS 3456
#define XB_SPIN_CAP (1u << 18)

__device__ __forceinline__ unsigned xb_ld(unsigned* p)              { return __hip_atomic_load(p, __ATOMIC_RELAXED, __HIP_MEMORY_SCOPE_AGENT); }
__device__ __forceinline__ unsigned xb_add(unsigned* p, unsigned v) { return __hip_atomic_fetch_add(p, v, __ATOMIC_RELAXED, __HIP_MEMORY_SCOPE_AGENT); }
__device__ __forceinline__ unsigned xb_xcc_id() { return (unsigned)__builtin_amdgcn_s_getreg((3 << 11) | 20) & 0xFu; }
#define XB_SPIN(cond, bar) do { unsigned _sp = 0; while (cond) { __builtin_amdgcn_s_sleep(1); \
    if ((++_sp & 255u) == 0u) { if (xb_ld(&(bar)[XB_TMO])) break; if (_sp > XB_SPIN_CAP) { atomicAdd(&(bar)[XB_TMO], 1u); break; } } } } while (0)

struct XcdBarrier {
    unsigned* bar; unsigned x;
    volatile LAS unsigned* st;
};

__device__ __forceinline__ XcdBarrier xcd_barrier_post(unsigned* bar, volatile LAS unsigned* st) {
    XcdBarrier b; b.bar = bar; b.x = xb_xcc_id(); b.st = st;
    if (threadIdx.x == 0) (void)xb_add(&bar[XB_XCNT(b.x)], 1u);
    return b;
}
__device__ __forceinline__ void xcd_barrier_complete(unsigned* bar, unsigned x, unsigned& nloc, unsigned& nx) {
    const unsigned G = gridDim.x * gridDim.y * gridDim.z;
    unsigned sum, cnt, mine, sp = 0u;
    for (;;) {
        sum = 0u; cnt = 0u; mine = 0u;
#pragma unroll
        for (unsigned j = 0; j < 16; ++j) { const unsigned c = xb_ld(&bar[XB_XCNT(j)]); sum += c; cnt += (c > 0u) ? 1u : 0u; mine = (j == x) ? c : mine; }
        if (sum == G) break;
        __builtin_amdgcn_s_sleep(1);
        if ((++sp & 255u) == 0u) { if (xb_ld(&bar[XB_TMO])) break; if (sp > XB_SPIN_CAP) { atomicAdd(&bar[XB_TMO], 1u); break; } }
    }
    nloc = mine > 0u ? mine : 1u; nx = cnt > 0u ? cnt : 1u;
}

__device__ __forceinline__ void xcd_barrier(const XcdBarrier& b) {
    asm volatile("s_waitcnt vmcnt(0)" ::: "memory");
    __syncthreads();
    if (threadIdx.x == 0) {
        unsigned* bar = b.bar;
        __builtin_amdgcn_s_waitcnt(0);
        unsigned nloc = b.st[0], nx = b.st[1];
        if (nloc == 0u) { xcd_barrier_complete(bar, b.x, nloc, nx); b.st[0] = nloc; b.st[1] = nx; }
        const unsigned old = xb_add(&bar[XB_XSUB(b.x)], 1u);
        const unsigned gen = old / nloc;
        if (old + 1u == (gen + 1u) * nloc) {
            __builtin_amdgcn_fence(__ATOMIC_RELEASE, "agent");
            asm volatile("s_waitcnt vmcnt(0)" ::: "memory");
            const unsigned og = xb_add(&bar[XB_TOP], 1u);
            const unsigned tg = og / nx;
            if (og + 1u == (tg + 1u) * nx) xb_add(&bar[XB_TOPGEN], 1u);
            else XB_SPIN(xb_ld(&bar[XB_TOPGEN]) == tg, bar);
            __builtin_amdgcn_fence(__ATOMIC_ACQUIRE, "agent");
            xb_add(&bar[XB_XGEN(b.x)], 1u);
            asm volatile("s_waitcnt vmcnt(0)" ::: "memory");
        } else {
            XB_SPIN(xb_ld(&bar[XB_XGEN(b.x)]) == gen, bar);
            __builtin_amdgcn_fence(__ATOMIC_ACQUIRE, "agent");
            asm volatile("s_waitcnt vmcnt(0)" ::: "memory");
        }
    }
    __syncthreads();
}
struct Args { const float* in[41]; float* out; unsigned char* ws; int ph_lo, ph_hi; };
struct Frame {
    LAS unsigned char* lds;
    volatile LAS unsigned* MISC;
    gu32* ctl;
    int tid, lane, wave;
    int vcu, G;
    float* out;
    unsigned char* ws;
};
#define WSP(T, off) ((T*)(F.ws + (off)))
#define INP(i) (A.in[(i)])

__device__ __forceinline__ void p0_transpose_item(const float* W, int N, bf16* WT, int ldt, int kdst, int dst_row0, const float* gain, LAS float* scr, int k0, int n0, int lane) {
    const int rs = lane >> 3, c4 = (lane & 7) * 4; f32x4 v[8]; float gn[8];
    const GAS float* src = (const GAS float*)W + (size_t)(k0 + rs) * N + n0 + c4;
#pragma unroll
    for (int i = 0; i < 8; ++i) { v[i] = *(const GAS f32x4*)(src + (size_t)(8 * i) * N); gn[i] = gain ? gain[k0 + 8 * i + rs] : 1.0f; }
#pragma unroll
    for (int i = 0; i < 8; ++i) { LAS float* d = scr + (8 * i + rs) * 33 + c4; d[0] = v[i].x * gn[i]; d[1] = v[i].y * gn[i]; d[2] = v[i].z * gn[i]; d[3] = v[i].w * gn[i]; }
    LDS_WAIT(); asm volatile("" ::: "memory");
    const int c = lane & 7;
#pragma unroll
    for (int j = 0; j < 4; ++j) { const int n = (lane >> 3) + 8 * j; const LAS float* s = scr + (8 * c) * 33 + n;
        v4u o; o.x = pk2(s[0 * 33], s[1 * 33]); o.y = pk2(s[2 * 33], s[3 * 33]); o.z = pk2(s[4 * 33], s[5 * 33]); o.w = pk2(s[6 * 33], s[7 * 33]);
        *(GAS v4u*)(WT + (size_t)(dst_row0 + n) * ldt + kdst + k0 + 8 * c) = o; }
    LDS_WAIT(); asm volatile("" ::: "memory");
}
__device__ __forceinline__ void p0_tr(const float* W, int K, int N, bf16* WT, int ldt, int kdst, int row_base, int mode  , const float* gain, LAS float* scr, int item, int lane) {
    const int nblk = N / 32, kb = item / nblk, nb = item % nblk, k0 = 64 * kb, n0 = 32 * nb; (void)K;
    const int dr = mode == 0 ? row_base + n0 : (n0 / 128) * 256 + (n0 % 128) + (mode == 2 ? 128 : 0);
    p0_transpose_item(W, N, WT, ldt, kdst, dr, gain, scr, k0, n0, lane);
}
__device__ __forceinline__ void row_to_bf16_ssq(const float* xrow, bf16* orow, float* ssq32, int lane) {
    const GAS f32x4* xr = (const GAS f32x4*)xrow + lane; GAS v2u* o8 = (GAS v2u*)orow + lane; float s = 0.f;
#pragma unroll
    for (int j = 0; j < 8; ++j) { const f32x4 v = xr[64 * j]; s += (v.x * v.x + v.y * v.y) + (v.z * v.z + v.w * v.w); v2u w; w.x = pk2(v.x, v.y); w.y = pk2(v.z, v.w); o8[64 * j] = w; }
    s = wave_sum(s);
    if (lane < 32) ssq32[lane] = lane == 0 ? s : 0.f;
}
template <int SET> __device__ __forceinline__ void convert_weights(Frame& F, const Args& A, int gw, int NGW) {
    LAS float* scr = (LAS float*)(F.lds + RING_OFF + F.wave * 16384);
    constexpr int I_GU = (D / 64) * (FF / 32), I_DN = (FF / 64) * (D / 32), I_IN = (D / 64) * (DIN / 32), I_SQ = (D / 64) * (D / 32), I_L = 16 * 8;
    constexpr int NITEMS = SET == 0 ? 2 * I_GU + I_DN + I_IN + 2 * I_SQ + 2 * I_L : (SET == 1 ? 2 * I_SQ : (SET == 2 ? 2 * I_SQ + 2 * I_GU : I_DN));
    for (int it = gw; it < NITEMS; it += NGW) {
        int r = it;
        if (SET == 0) {
            if (r < I_GU) { p0_tr(INP(I_F1WG), D, FF, WSP(bf16, WS_W1GU), D, 0, 0, 1, INP(I_F1G), scr, r, F.lane); continue; } r -= I_GU;
            if (r < I_GU) { p0_tr(INP(I_F1WU), D, FF, WSP(bf16, WS_W1GU), D, 0, 0, 2, INP(I_F1G), scr, r, F.lane); continue; } r -= I_GU;
            if (r < I_DN) { p0_tr(INP(I_F1WD), FF, D, WSP(bf16, WS_W1D), FF, 0, 0, 0, nullptr, scr, r, F.lane); continue; } r -= I_DN;
            if (r < I_IN) { p0_tr(INP(I_WIN), D, DIN, WSP(bf16, WS_WIN), D, 0, 0, 0, INP(I_MIXG), scr, r, F.lane); continue; } r -= I_IN;
            if (r < I_SQ) { p0_tr(INP(I_WK), D, D, WSP(bf16, WS_WKV), D, 0, 0, 0, INP(I_MEMG), scr, r, F.lane); continue; } r -= I_SQ;
            if (r < I_SQ) { p0_tr(INP(I_WV), D, D, WSP(bf16, WS_WKV), D, 0, D, 0, INP(I_MEMG), scr, r, F.lane); continue; } r -= I_SQ;
            if (r < I_L) { const int h = r >> 3; p0_tr(INP(I_LWA) + (size_t)h * 16384, 128, 128, WSP(bf16, WS_WL), 128, 0, h * 256, 0, nullptr, scr, r & 7, F.lane); continue; } r -= I_L;
            { const int h = r >> 3; p0_tr(INP(I_LWX) + (size_t)h * 16384, 128, 128, WSP(bf16, WS_WL), 128, 0, h * 256 + 128, 0, nullptr, scr, r & 7, F.lane); }
        } else if (SET == 1) {
            if (r < I_SQ) { p0_tr(INP(I_WOUT), D, D, WSP(bf16, WS_WOUT), DMIX, 0, 0, 0, INP(I_LOG), scr, r, F.lane); continue; } r -= I_SQ;
            p0_tr(INP(I_WOUT) + (size_t)D * D, D, D, WSP(bf16, WS_WOUT), DMIX, D, 0, 0, INP(I_SOG), scr, r, F.lane);
        } else if (SET == 2) {
            if (r < I_SQ) { p0_tr(INP(I_WQ), D, D, WSP(bf16, WS_WQ), D, 0, 0, 0, INP(I_XAG), scr, r, F.lane); continue; } r -= I_SQ;
            if (r < I_SQ) { p0_tr(INP(I_WO), D, D, WSP(bf16, WS_WO), D, 0, 0, 0, nullptr, scr, r, F.lane); continue; } r -= I_SQ;
            if (r < I_GU) { p0_tr(INP(I_F2WG), D, FF, WSP(bf16, WS_W2GU), D, 0, 0, 1, INP(I_F2G), scr, r, F.lane); continue; } r -= I_GU;
            p0_tr(INP(I_F2WU), D, FF, WSP(bf16, WS_W2GU), D, 0, 0, 2, INP(I_F2G), scr, r, F.lane);
        } else {
            p0_tr(INP(I_F2WD), FF, D, WSP(bf16, WS_W2D), FF, 0, 0, 0, nullptr, scr, r, F.lane);
        }
    }
}
__device__ __forceinline__ void p0_prologue(Frame& F, const Args& A) {
    const int gw = F.vcu * NWAVES + F.wave, NGW = F.G * NWAVES;
    convert_weights<0>(F, A, gw, NGW);
    for (int m = gw; m < M; m += NGW) { const float* src = m < MP ? INP(I_XP) + (size_t)m * D : INP(I_XS) + (size_t)(m - MP) * D;
        row_to_bf16_ssq(src, WSP(bf16, WS_XBA) + (size_t)m * D, WSP(float, WS_SSQ) + (size_t)m * NSSQ, F.lane); }
    for (int m = gw; m < MMEM; m += NGW) row_to_bf16_ssq(INP(I_MEMP) + (size_t)m * D, WSP(bf16, WS_MEMB) + (size_t)m * D, WSP(float, WS_SSQM) + (size_t)m * NSSQ, F.lane);
    { GAS v4u* z = (GAS v4u*)(WSP(bf16, WS_WIN) + (size_t)DIN * D); const int nz = (DINP - DIN) * D * 2 / 16;
      for (int i = gw * 64 + F.lane; i < nz; i += NGW * 64) z[i] = (v4u){0u, 0u, 0u, 0u}; }
}

__device__ __forceinline__ void p5_normalize(Frame& F, const Args& A, int m0, int m1, int q0, int q1, int gw, int NGW) {
    const int lane = F.lane;
    bf16* V = WSP(bf16, WS_V); const float* SQ = WSP(float, WS_SQV);
    for (int m = m0 + gw; m < m1; m += NGW) {
        const float* sq = SQ + (size_t)m * NSQV;
        const float pl = lane < 32 ? sq[lane] : 0.f, p0 = sq[32 + lane], p1 = sq[96 + lane];
        const float rl = __builtin_amdgcn_rsqf(wave_sum(pl) * (1.0f / 2048.0f) + EPS), r0 = __builtin_amdgcn_rsqf(wave_sum(p0) * (1.0f / 1024.0f) + EPS), r1 = __builtin_amdgcn_rsqf(wave_sum(p1) * (1.0f / 1024.0f) + EPS);
        GAS v4u* row = (GAS v4u*)(V + (size_t)m * DMIX) + lane;
#pragma unroll
        for (int i = 0; i < 8; ++i) { const float rs = i < 4 ? rl : (i < 6 ? r0 : r1); v4u w = row[64 * i];
            w.x = pk2(bf2f(w.x & 0xffffu) * rs, bf2f(w.x >> 16) * rs); w.y = pk2(bf2f(w.y & 0xffffu) * rs, bf2f(w.y >> 16) * rs);
            w.z = pk2(bf2f(w.z & 0xffffu) * rs, bf2f(w.z >> 16) * rs); w.w = pk2(bf2f(w.w & 0xffffu) * rs, bf2f(w.w >> 16) * rs); row[64 * i] = w; }
    }
    const float* P = WSP(float, WS_PROJ);
    for (int it = q0 * 3 + gw; it < q1 * 3; it += NGW) { const int sq = it / 3, k = it % 3;
        const int row = sq < NBP ? sq * TP + TP - 3 + k : MP + (sq - NBP) * TS + TS - 3 + k;
        float* lc = sq < NBP ? F.out + O_PLC + (size_t)(sq * 3 + k) * D : F.out + O_SLC + (size_t)((sq - NBP) * 3 + k) * D;
        float* sc = sq < NBP ? F.out + O_PSC + (size_t)(sq * 3 + k) * XBC : F.out + O_SSC + (size_t)((sq - NBP) * 3 + k) * XBC;
        const float* src = P + (size_t)row * DINP;
        for (int c = lane * 4; c < D; c += 256) *(GAS f32x4*)(lc + c) = *(const GAS f32x4*)(src + C_XL + c);
        for (int c = lane * 4; c < XBC; c += 256) *(GAS f32x4*)(sc + c) = *(const GAS f32x4*)(src + C_XBC + c);
    }
}
__device__ __forceinline__ void p12_final(Frame& F, const Args& A, int m0, int m1) {
    const int gw = F.vcu * NWAVES + F.wave, NGW = F.G * NWAVES, lane = F.lane;
    const float* XR = WSP(float, WS_XR); const float* SSQ = WSP(float, WS_SSQ) + (size_t)4 * M * NSSQ; const float* g = INP(I_FING);
    for (int m = m0 + gw; m < m1; m += NGW) {
        const float p = lane < 32 ? SSQ[(size_t)m * NSSQ + lane] : 0.f; const float rs = __builtin_amdgcn_rsqf(wave_sum(p) * (1.0f / 2048.0f) + EPS);
        const GAS f32x4* xr = (const GAS f32x4*)(XR + (size_t)m * D) + lane; const GAS f32x4* gg = (const GAS f32x4*)g + lane; GAS f32x4* o = (GAS f32x4*)(F.out + O_Y + (size_t)m * D) + lane;
#pragma unroll
        for (int j = 0; j < 8; ++j) o[64 * j] = xr[64 * j] * rs * gg[64 * j];
    }
}

__device__ __forceinline__ void p3b_bcconv(Frame& F, const Args& A) {
    const float* P = WSP(float, WS_PROJ); bf16* BCC = WSP(bf16, WS_BCC);
    const int q = F.tid & 127, rsub = F.tid >> 7;
    const int xc = 2048 + 4 * q;
    f32x4 w[4];
#pragma unroll
    for (int k = 0; k < 4; ++k) w[k] = *(const GAS f32x4*)(INP(I_SCW) + (size_t)k * XBC + xc);
    const f32x4 bb = *(const GAS f32x4*)(INP(I_SCB) + xc);
    for (int r0 = blockIdx.x * 4; r0 < MP; r0 += F.G * 4) { const int R = r0 + rsub, t = R & (TP - 1);
        const GAS float* src = (const GAS float*)P + (size_t)R * DINP + C_XBC + xc; f32x4 v = bb;
#pragma unroll
        for (int k = 0; k < 4; ++k) { if (t - 3 + k >= 0) v = v + w[k] * *(const GAS f32x4*)(src - (ptrdiff_t)(3 - k) * DINP); }
        v2u o; o.x = pk2(siluf_(v[0]), siluf_(v[1])); o.y = pk2(siluf_(v[2]), siluf_(v[3]));
        *(GAS v2u*)(BCC + (size_t)R * 512 + 4 * q) = o; }
}

__device__ __forceinline__ bf16x8 pack8(const f32x4 a, const f32x4 b) { v4u w; w.x = pg8::cvt_pk_bf16(a[0], a[1]); w.y = pg8::cvt_pk_bf16(a[2], a[3]); w.z = pg8::cvt_pk_bf16(b[0], b[1]); w.w = pg8::cvt_pk_bf16(b[2], b[3]); return __builtin_bit_cast(bf16x8, w); }
#define SCHED_FENCE() __builtin_amdgcn_sched_barrier(0)
__device__ __forceinline__ void attn_prompt_item(Frame& F, const Args& A, int b, int h, int qt) {
    const int lane = F.lane, c16 = lane & 15, g = lane >> 4;
    const int R = b * TP + qt * 16 + c16;
    const bf16* Q = WSP(bf16, WS_Q) + (size_t)R * D + h * 512;
    bf16x8 qf[16];
#pragma unroll
    for (int ks = 0; ks < 16; ++ks) qf[ks] = *(const GAS bf16x8*)(Q + ks * 32 + 8 * g);
    const GAS char* kb = (const GAS char*)(WSP(bf16, WS_KM) + (size_t)(b * NMEM) * D + h * 512); const unsigned ko = (unsigned)(c16 * D + 8 * g) * 2u;
    f32x4 s[16]; bf16x8 kbuf[2][8];
#define KLOAD(step_) do { const int kt_ = (step_) >> 1, hf_ = (step_) & 1; _Pragma("unroll") for (int i = 0; i < 8; ++i) kbuf[(step_) & 1][i] = *(const GAS bf16x8*)(kb + (size_t)kt_ * 16 * D * 2 + ko + (hf_ * 8 + i) * 64); } while (0)
    KLOAD(0);
#pragma unroll
    for (int step = 0; step < 32; ++step) { const int kt = step >> 1, hf = step & 1;
        if (step + 1 < 32) KLOAD(step + 1);
        SCHED_FENCE();
        if (hf == 0) s[kt] = (f32x4){0.f, 0.f, 0.f, 0.f};
#pragma unroll
        for (int i = 0; i < 8; ++i) s[kt] = MFMA16(kbuf[step & 1][i], qf[hf * 8 + i], s[kt]);
        SCHED_FENCE(); }
#undef KLOAD
    const GAS char* vb = (const GAS char*)(WSP(bf16, WS_VT) + (size_t)(b * D + h * 512) * NMEM); const unsigned vo = (unsigned)(c16 * NMEM + 4 * g) * 2u;
    v2u vbuf[2][16];
#define VLOAD(dt_) do { _Pragma("unroll") for (int kk = 0; kk < 8; ++kk) { vbuf[(dt_) & 1][2 * kk] = *(const GAS v2u*)(vb + (size_t)(dt_) * 16 * NMEM * 2 + vo + kk * 64); vbuf[(dt_) & 1][2 * kk + 1] = *(const GAS v2u*)(vb + (size_t)(dt_) * 16 * NMEM * 2 + vo + kk * 64 + 32); } } while (0)
    VLOAD(0);
    float mx = -3.0e38f;
#pragma unroll
    for (int kt = 0; kt < 16; ++kt) mx = fmaxf(mx, fmaxf(fmaxf(s[kt][0], s[kt][1]), fmaxf(s[kt][2], s[kt][3])));
    mx = fmaxf(mx, __shfl_xor(mx, 16)); mx = fmaxf(mx, __shfl_xor(mx, 32));
    float sum = 0.f;
#pragma unroll
    for (int kt = 0; kt < 16; ++kt) {
#pragma unroll
        for (int j = 0; j < 4; ++j) { const float e = __expf(s[kt][j] - mx); s[kt][j] = e; sum += e; } }
    sum += __shfl_xor(sum, 16); sum += __shfl_xor(sum, 32);
    const float inv = 1.0f / sum;
    bf16x8 pf[8];
#pragma unroll
    for (int kk = 0; kk < 8; ++kk) pf[kk] = pack8(s[2 * kk], s[2 * kk + 1]);
    bf16* O = WSP(bf16, WS_O) + (size_t)R * D + h * 512 + 4 * g;
#pragma unroll
    for (int dt = 0; dt < 32; ++dt) { f32x4 o = (f32x4){0.f, 0.f, 0.f, 0.f};
        if (dt + 1 < 32) VLOAD(dt + 1);
        SCHED_FENCE();
#pragma unroll
        for (int kk = 0; kk < 8; ++kk) { v4u w; w.x = vbuf[dt & 1][2 * kk].x; w.y = vbuf[dt & 1][2 * kk].y; w.z = vbuf[dt & 1][2 * kk + 1].x; w.w = vbuf[dt & 1][2 * kk + 1].y; o = MFMA16(__builtin_bit_cast(bf16x8, w), pf[kk], o); }
        o = o * inv;
        { v2u w; w.x = pg8::cvt_pk_bf16(o[0], o[1]); w.y = pg8::cvt_pk_bf16(o[2], o[3]); *(GAS v2u*)(O + dt * 16) = w; }
        SCHED_FENCE(); }
#undef VLOAD
}
constexpr int AT_ML = 0, AT_PF = 1024;
__device__ __forceinline__ void attn_sample_wg(Frame& F, const Args& A, int b, int h) {
    const int lane = F.lane, w = F.wave, c16 = lane & 15, g = lane >> 4;
    LAS float* ML = (LAS float*)(F.lds + AT_ML); LAS v4u* PF = (LAS v4u*)(F.lds + AT_PF);
    const int R = MP + b * TS + (c16 & 7); const bool qvalid = c16 < 8;
    const bf16* Q = WSP(bf16, WS_Q) + (size_t)R * D + h * 512;
    bf16x8 qf[16];
#pragma unroll
    for (int ks = 0; ks < 16; ++ks) qf[ks] = *(const GAS bf16x8*)(Q + ks * 32 + 8 * g);
    const GAS char* kb = (const GAS char*)(INP(I_CK) + (size_t)(b * NMEM + 32 * w) * D + h * 512); const unsigned ko = (unsigned)(c16 * D + 8 * g) * 4u;
    f32x4 s[2]; f32x4 kbuf[2][16];
#define KLOAD(step_) do { const int t_ = (step_) >> 1, hf_ = (step_) & 1; _Pragma("unroll") for (int i = 0; i < 8; ++i) { \
        kbuf[(step_) & 1][2 * i] = *(const GAS f32x4*)(kb + (size_t)t_ * 16 * D * 4 + ko + (hf_ * 8 + i) * 128); kbuf[(step_) & 1][2 * i + 1] = *(const GAS f32x4*)(kb + (size_t)t_ * 16 * D * 4 + ko + (hf_ * 8 + i) * 128 + 16); } } while (0)
    KLOAD(0);
#pragma unroll
    for (int step = 0; step < 4; ++step) { const int t = step >> 1, hf = step & 1;
        if (step + 1 < 4) KLOAD(step + 1);
        SCHED_FENCE();
        if (hf == 0) s[t] = (f32x4){0.f, 0.f, 0.f, 0.f};
#pragma unroll
        for (int i = 0; i < 8; ++i) s[t] = MFMA16(pack8(kbuf[step & 1][2 * i], kbuf[step & 1][2 * i + 1]), qf[hf * 8 + i], s[t]);
        SCHED_FENCE(); }
#undef KLOAD
    const GAS char* vb = (const GAS char*)(INP(I_CV) + (size_t)(b * NMEM) * D + h * 512); const unsigned vo2 = (unsigned)(4 * g * D + c16) * 4u;
    float vbuf[2][64];
#define VLOAD(i_) do { const int dt_ = 4 * w + (i_); _Pragma("unroll") for (int kk = 0; kk < 8; ++kk) { const GAS char* v0 = vb + (size_t)(kk * 32) * D * 4 + dt_ * 64 + vo2; \
        _Pragma("unroll") for (int j = 0; j < 4; ++j) { vbuf[(i_) & 1][kk * 8 + j] = *(const GAS float*)(v0 + (size_t)j * D * 4); vbuf[(i_) & 1][kk * 8 + 4 + j] = *(const GAS float*)(v0 + (size_t)(16 + j) * D * 4); } } } while (0)
    VLOAD(0);
    float mx = fmaxf(fmaxf(fmaxf(s[0][0], s[0][1]), fmaxf(s[0][2], s[0][3])), fmaxf(fmaxf(s[1][0], s[1][1]), fmaxf(s[1][2], s[1][3])));
    mx = fmaxf(mx, __shfl_xor(mx, 16)); mx = fmaxf(mx, __shfl_xor(mx, 32));
    float sum = 0.f;
#pragma unroll
    for (int t = 0; t < 2; ++t)
#pragma unroll
        for (int j = 0; j < 4; ++j) { const float e = __expf(s[t][j] - mx); s[t][j] = e; sum += e; }
    sum += __shfl_xor(sum, 16); sum += __shfl_xor(sum, 32);
    if (g == 0) { ML[(w * 16 + c16) * 2] = mx; ML[(w * 16 + c16) * 2 + 1] = sum; }
    __syncthreads();
    float gm = -3.0e38f;
#pragma unroll
    for (int ww = 0; ww < 8; ++ww) gm = fmaxf(gm, ML[(ww * 16 + c16) * 2]);
    float tot = 0.f;
#pragma unroll
    for (int ww = 0; ww < 8; ++ww) tot += ML[(ww * 16 + c16) * 2 + 1] * __expf(ML[(ww * 16 + c16) * 2] - gm);
    const float f = __expf(mx - gm), inv = 1.0f / tot;
    { const bf16x8 pk = pack8(s[0] * f, s[1] * f); PF[w * 64 + lane] = __builtin_bit_cast(v4u, pk); }
    __syncthreads();
    bf16x8 pf[8];
#pragma unroll
    for (int kk = 0; kk < 8; ++kk) pf[kk] = __builtin_bit_cast(bf16x8, PF[kk * 64 + lane]);
    bf16* O = WSP(bf16, WS_O) + (size_t)R * D + h * 512 + 4 * g;
#pragma unroll
    for (int i = 0; i < 4; ++i) { const int dt = 4 * w + i; f32x4 o = (f32x4){0.f, 0.f, 0.f, 0.f};
        if (i + 1 < 4) VLOAD(i + 1);
        SCHED_FENCE();
#pragma unroll
        for (int kk = 0; kk < 8; ++kk) { const float* vv = &vbuf[i & 1][kk * 8]; o = MFMA16(pack8((f32x4){vv[0], vv[1], vv[2], vv[3]}, (f32x4){vv[4], vv[5], vv[6], vv[7]}), pf[kk], o); }
        o = o * inv;
        if (qvalid) { v2u wv; wv.x = pg8::cvt_pk_bf16(o[0], o[1]); wv.y = pg8::cvt_pk_bf16(o[2], o[3]); *(GAS v2u*)(O + dt * 16) = wv; }
        SCHED_FENCE(); }
#undef VLOAD
    __syncthreads();
}
__device__ __forceinline__ void p8_attn_sample(Frame& F, const Args& A) {
    for (int it = blockIdx.x; it < NBS * 4; it += F.G) attn_sample_wg(F, A, it >> 2, it & 3);
}
constexpr int AP_BUF = 33792, AP_KP = 1040, AP_VP = 528;
__device__ __forceinline__ void attn_prompt_wg(Frame& F, const Args& A, int b, int h, int qb) {
    const int tid = F.tid, lane = F.lane, w = F.wave, c16 = lane & 15, g = lane >> 4;
    LAS unsigned char* L0 = F.lds;
    const int R = b * TP + qb * 128 + w * 16 + c16;
    const bf16* Q = WSP(bf16, WS_Q) + (size_t)R * D + h * 512;
    bf16x8 qf[16];
#pragma unroll
    for (int ks = 0; ks < 16; ++ks) qf[ks] = *(const GAS bf16x8*)(Q + ks * 32 + 8 * g);
    const int kkey = tid >> 4, kseg = tid & 15;
    const GAS char* kg = (const GAS char*)(WSP(bf16, WS_KM) + (size_t)(b * NMEM) * D + h * 512) + (size_t)kkey * D * 2 + kseg * 64;
    const unsigned kl = (unsigned)(kkey * AP_KP + kseg * 64);
    v4u st[4];
#define AP_LOAD(src_) do { _Pragma("unroll") for (int j = 0; j < 4; ++j) st[j] = *(const GAS v4u*)((src_) + j * 16); } while (0)
#define AP_STORE(buf_, off_) do { _Pragma("unroll") for (int j = 0; j < 4; ++j) *(LAS v4u*)(L0 + (buf_) * AP_BUF + (off_) + j * 16) = st[j]; } while (0)
    AP_LOAD(kg); AP_STORE(0, kl); __syncthreads();
    f32x4 s[16];
#pragma unroll
    for (int t = 0; t < 8; ++t) {
        if (t + 1 < 8) AP_LOAD(kg + (size_t)(t + 1) * 32 * D * 2);
        SCHED_FENCE();
#pragma unroll
        for (int tt = 0; tt < 2; ++tt) { const int kt = 2 * t + tt; s[kt] = (f32x4){0.f, 0.f, 0.f, 0.f};
#pragma unroll
            for (int ks = 0; ks < 16; ++ks) { const bf16x8 kf = *(const LAS bf16x8*)(L0 + (t & 1) * AP_BUF + (16 * tt + c16) * AP_KP + ks * 64 + g * 16); s[kt] = MFMA16(kf, qf[ks], s[kt]); } }
        SCHED_FENCE();
        if (t + 1 < 8) AP_STORE((t + 1) & 1, kl);
        __syncthreads(); }
    const int vrow = tid >> 3, vseg = tid & 7;
    const GAS char* vg = (const GAS char*)(WSP(bf16, WS_VT) + (size_t)(b * D + h * 512) * NMEM) + (size_t)vrow * NMEM * 2 + vseg * 64;
    const unsigned vl = (unsigned)(vrow * AP_VP + vseg * 64);
    AP_LOAD(vg);
    float mx = -3.0e38f;
#pragma unroll
    for (int kt = 0; kt < 16; ++kt) mx = fmaxf(mx, fmaxf(fmaxf(s[kt][0], s[kt][1]), fmaxf(s[kt][2], s[kt][3])));
    mx = fmaxf(mx, __shfl_xor(mx, 16)); mx = fmaxf(mx, __shfl_xor(mx, 32));
    float sum = 0.f;
#pragma unroll
    for (int kt = 0; kt < 16; ++kt) {
#pragma unroll
        for (int j = 0; j < 4; ++j) { const float e = __expf(s[kt][j] - mx); s[kt][j] = e; sum += e; } }
    sum += __shfl_xor(sum, 16); sum += __shfl_xor(sum, 32);
    const float inv = 1.0f / sum;
    bf16x8 pf[8];
#pragma unroll
    for (int kk = 0; kk < 8; ++kk) pf[kk] = pack8(s[2 * kk], s[2 * kk + 1]);
    AP_STORE(0, vl); __syncthreads();
    bf16* O = WSP(bf16, WS_O) + (size_t)R * D + h * 512 + 4 * g;
#pragma unroll
    for (int u = 0; u < 8; ++u) {
        if (u + 1 < 8) AP_LOAD(vg + (size_t)(u + 1) * 64 * NMEM * 2);
        SCHED_FENCE();
#pragma unroll
        for (int i = 0; i < 4; ++i) { f32x4 o = (f32x4){0.f, 0.f, 0.f, 0.f};
#pragma unroll
            for (int kk = 0; kk < 8; ++kk) { const LAS unsigned char* vp = L0 + (u & 1) * AP_BUF + (16 * i + c16) * AP_VP + kk * 64 + g * 8; const v2u lo = *(const LAS v2u*)vp, hi = *(const LAS v2u*)(vp + 32);
                v4u wv; wv.x = lo.x; wv.y = lo.y; wv.z = hi.x; wv.w = hi.y; o = MFMA16(__builtin_bit_cast(bf16x8, wv), pf[kk], o); }
            o = o * inv;
            { v2u wv; wv.x = pg8::cvt_pk_bf16(o[0], o[1]); wv.y = pg8::cvt_pk_bf16(o[2], o[3]); *(GAS v2u*)(O + (4 * u + i) * 16) = wv; } }
        SCHED_FENCE();
        if (u + 1 < 8) AP_STORE((u + 1) & 1, vl);
        __syncthreads(); }
#undef AP_LOAD
#undef AP_STORE
}
__device__ __forceinline__ void p8_attn_prompt(Frame& F, const Args& A, int rank, int ngrp) {
    if (rank < 0) return;
    for (int it = rank; it < NBP * 4 * (TP / 128); it += ngrp) attn_prompt_wg(F, A, it >> 6, (it >> 4) & 3, it & 15);
}

__device__ __forceinline__ float conv4(const float* cur, int t, const float* st, int sp, float w0, float w1, float w2, float w3, float bias) {
    const float x3 = cur[0];
    const float x2 = t >= 1 ? cur[-(ptrdiff_t)DINP] : (st ? st[2 * sp] : 0.f);
    const float x1 = t >= 2 ? cur[-(ptrdiff_t)2 * DINP] : (st ? st[(t + 1) * sp] : 0.f);
    const float x0 = t >= 3 ? cur[-(ptrdiff_t)3 * DINP] : (st ? st[t * sp] : 0.f);
    return bias + w0 * x0 + w1 * x1 + w2 * x2 + w3 * x3;
}
constexpr int LR_U32 = 0, LR_UB = 32768, LR_UBP = 136, LR_A32 = 50176, LR_B32 = 66560, LR_SEG = 82944, LR_CAR = 85504;
#define LDG_F32(base_, voff_) (*(const GAS float*)((const GAS char*)(base_) + (voff_)))
template <bool SAMPLE>
__device__ __forceinline__ void lru_item(Frame& F, const Args& A, int sidx, int h, int half) {
    LAS float* U32 = (LAS float*)(F.lds + LR_U32); LAS bf16* UB = (LAS bf16*)(F.lds + LR_UB); LAS float* A32 = (LAS float*)(F.lds + LR_A32); LAS float* B32 = (LAS float*)(F.lds + LR_B32);
    LAS float* SEG = (LAS float*)(F.lds + LR_SEG); LAS float* CAR = (LAS float*)(F.lds + LR_CAR);
    const int tid = F.tid, lane = F.lane, w = F.wave, c16 = lane & 15, g = lane >> 4;
    const float* P = WSP(float, WS_PROJ);
    const bf16* WL = WSP(bf16, WS_WL) + (size_t)h * 256 * 128;
    const int nt = w & 3, mt0 = 2 * (w >> 2), hcol0 = 64 * half + 16 * nt;
    bf16x8 ba[4], bx[4];
#pragma unroll
    for (int ks = 0; ks < 4; ++ks) { ba[ks] = *(const GAS bf16x8*)(WL + (size_t)(hcol0 + c16) * 128 + ks * 32 + 8 * g); bx[ks] = *(const GAS bf16x8*)(WL + (size_t)(128 + hcol0 + c16) * 128 + ks * 32 + 8 * g); }
    const int mch = h * 128 + hcol0 + c16;
    const float b_a = INP(I_LBA)[mch], b_x = INP(I_LBX)[mch], cl = -8.0f * softplus_f(-INP(I_LLAM)[mch]);
    const int tq = w >> 1, cc = (w & 1) * 64 + lane, ch = h * 128 + cc;
    const unsigned voffx = (unsigned)(C_XL + ch) * 4u, voffg = (unsigned)(C_GL + h * 128 + 64 * half + lane) * 4u;
    const float cw0 = INP(I_LCW)[ch], cw1 = INP(I_LCW)[D + ch], cw2 = INP(I_LCW)[2 * D + ch], cw3 = INP(I_LCW)[3 * D + ch], cb = INP(I_LCB)[ch];
    const int nchunk = SAMPLE ? 1 : TP / 64;
    if (tid < 64) CAR[tid] = 0.f;
    float raw[22];
#define LRU_ISSUE(chunk_) do { \
        if (SAMPLE) { \
            _Pragma("unroll") for (int q = 0; q < 2; ++q) { const int sq_ = sidx * 8 + tq * 2 + q; \
                _Pragma("unroll") for (int k = 0; k < 3; ++k) raw[q * 11 + k] = LDG_F32(INP(I_SLC) + (size_t)(sq_ * 3 + k) * D, (unsigned)ch * 4u); \
                _Pragma("unroll") for (int t = 0; t < 8; ++t) raw[q * 11 + 3 + t] = LDG_F32(P + (size_t)(MP + sq_ * 8 + t) * DINP, voffx); } \
        } else { \
            const int R0_ = sidx * TP + (chunk_) * 64 + tq * 16; \
            _Pragma("unroll") for (int i = 0; i < 19; ++i) { const bool ok = ((chunk_) > 0 || tq > 0 || i >= 3); raw[i] = ok ? LDG_F32(P + (size_t)(R0_ - 3 + i) * DINP, voffx) : 0.f; } \
        } } while (0)
    LRU_ISSUE(0);
    float ggn[8];
    { const int R0f = SAMPLE ? MP + sidx * 64 : sidx * TP;
#pragma unroll
      for (int i = 0; i < 8; ++i) ggn[i] = LDG_F32(P + (size_t)(R0f + 8 * w + i) * DINP, voffg); }
    for (int chunk = 0; chunk < nchunk; ++chunk) {
        int ln_ = lane; asm volatile("" : "+v"(ln_));
        const int lane = ln_, c16 = lane & 15, g = lane >> 4, cc = (w & 1) * 64 + lane;
        const int R0 = SAMPLE ? MP + sidx * 64 : sidx * TP + chunk * 64;
        float gg[8];
#pragma unroll
        for (int i = 0; i < 8; ++i) gg[i] = ggn[i];
        if (chunk + 1 < nchunk) {
#pragma unroll
            for (int i = 0; i < 8; ++i) ggn[i] = LDG_F32(P + (size_t)(R0 + 64 + 8 * w + i) * DINP, voffg); }
#pragma unroll
        for (int i = 0; i < 16; ++i) { const int r = tq * 16 + i; const int o = SAMPLE ? (i >> 3) * 11 + (i & 7) : i;
            const float u = cb + cw0 * raw[o] + cw1 * raw[o + 1] + cw2 * raw[o + 2] + cw3 * raw[o + 3];
            U32[r * 128 + cc] = u; UB[r * LR_UBP + cc] = (bf16)f2bf(u); }
        if (chunk + 1 < nchunk) LRU_ISSUE(chunk + 1);
        __syncthreads();
        f32x4 ra[2], rx[2];
#pragma unroll
        for (int mi = 0; mi < 2; ++mi) { ra[mi] = (f32x4){0.f, 0.f, 0.f, 0.f}; rx[mi] = (f32x4){0.f, 0.f, 0.f, 0.f};
#pragma unroll
            for (int ks = 0; ks < 4; ++ks) { const bf16x8 af = *(const LAS bf16x8*)(UB + (16 * (mt0 + mi) + c16) * LR_UBP + ks * 32 + 8 * g); ra[mi] = MFMA16(af, ba[ks], ra[mi]); rx[mi] = MFMA16(af, bx[ks], rx[mi]); } }
#pragma unroll
        for (int mi = 0; mi < 2; ++mi)
#pragma unroll
            for (int j = 0; j < 4; ++j) { const int r = 16 * (mt0 + mi) + 4 * g + j; const float rr = sigmoid_f(ra[mi][j] + b_a), ii = sigmoid_f(rx[mi][j] + b_x), la = cl * rr;
                const float a = __expf(la), x2 = 2.0f * la;
                const float m2 = x2 > -0.25f ? -x2 * (1.0f + x2 * (0.5f + x2 * (0.16666667f + x2 * (0.041666668f + x2 * 0.0083333338f)))) : 1.0f - a * a;
                const float u = U32[r * 128 + hcol0 + c16]; A32[r * 64 + 16 * nt + c16] = a; B32[r * 64 + 16 * nt + c16] = __builtin_amdgcn_sqrtf(m2) * ii * u; }
        __syncthreads();
        if (tid < 256) { const int cch = tid & 63, seg = tid >> 6;
            if (SAMPLE) {
#pragma unroll
                for (int q = 0; q < 2; ++q) { const int sq = sidx * 8 + seg * 2 + q; float hh = INP(I_SLH)[(size_t)sq * D + h * 128 + 64 * half + cch];
#pragma unroll
                    for (int t = 0; t < 8; ++t) { const int r = 16 * seg + 8 * q + t; hh = A32[r * 64 + cch] * hh + B32[r * 64 + cch]; B32[r * 64 + cch] = hh; }
                    F.out[O_SLH + (size_t)sq * D + h * 128 + 64 * half + cch] = hh; }
            } else {
                float ap = 1.f, hp = 0.f;
#pragma unroll
                for (int i = 0; i < 16; ++i) { const int r = 16 * seg + i; const float a = A32[r * 64 + cch]; hp = a * hp + B32[r * 64 + cch]; ap *= a; }
                SEG[seg * 64 + cch] = ap; SEG[256 + seg * 64 + cch] = hp;
            } }
        if (!SAMPLE) {
            __syncthreads();
            if (tid < 256) { const int cch = tid & 63, seg = tid >> 6; float hh = CAR[cch];
#pragma unroll
                for (int s2 = 0; s2 < 3; ++s2) if (s2 < seg) hh = SEG[s2 * 64 + cch] * hh + SEG[256 + s2 * 64 + cch];
#pragma unroll
                for (int i = 0; i < 16; ++i) { const int r = 16 * seg + i; hh = A32[r * 64 + cch] * hh + B32[r * 64 + cch]; B32[r * 64 + cch] = hh; }
                if (seg == 3) { SEG[512 + cch] = hh; if (chunk == nchunk - 1) F.out[O_PLH + (size_t)sidx * D + h * 128 + 64 * half + cch] = hh; } }
        }
        __syncthreads();
        if (!SAMPLE && tid < 64) CAR[tid] = SEG[512 + tid];
#pragma unroll
        for (int i = 0; i < 8; ++i) { const int r = 8 * w + i, R = R0 + r;
            const float v0 = B32[r * 64 + lane] * gelu_tanh_f(gg[i]);
            WSP(bf16, WS_V)[(size_t)R * DMIX + h * 128 + 64 * half + lane] = (bf16)f2bf(v0);
            const float q = wave_sum(v0 * v0); if (lane == 0) WSP(float, WS_SQV)[(size_t)R * NSQV + 2 * h + half] = q; }
        __syncthreads();
    }
#undef LRU_ISSUE
}
constexpr int SD_CS = 0, SD_DT = 256, SD_WG = 512, SD_CM = 1024, SD_BM = 18432, SD_BT = 35840, SD_XT = 54272, SD_XS = 63488, SD_HB = 72704, SD_XF = 90112;
constexpr int SP136 = 136, SP72 = 72, SP68 = 68;
template <int L  >
__device__ __forceinline__ void ssd_item(Frame& F, const Args& A, int sq, int head) {
    constexpr bool SAMPLE = (L == 16); constexpr int LT = L / 16, KK = (L + 31) / 32, TV = SAMPLE ? TS : L;
    LAS float* CS = (LAS float*)(F.lds + SD_CS); LAS float* DT = (LAS float*)(F.lds + SD_DT); LAS float* WG = (LAS float*)(F.lds + SD_WG);
    LAS bf16* CM = (LAS bf16*)(F.lds + SD_CM); LAS bf16* BM = (LAS bf16*)(F.lds + SD_BM); LAS bf16* BT = (LAS bf16*)(F.lds + SD_BT);
    LAS bf16* XT = (LAS bf16*)(F.lds + SD_XT); LAS bf16* XS = (LAS bf16*)(F.lds + SD_XS); LAS bf16* HB = (LAS bf16*)(F.lds + SD_HB); LAS float* XF = (LAS float*)(F.lds + SD_XF);
    const int tid = F.tid, lane = F.lane, w = F.wave, c16 = lane & 15, g = lane >> 4, grp = head >> 4;
    const float* P = WSP(float, WS_PROJ);
    const float Aneg = -__expf(INP(I_SALOG)[head]), dtb = INP(I_SDTB)[head], Dh = INP(I_SD)[head];
    const int hpt = w & 3, hnt0 = 4 * (w >> 2);
    f32x4 Hacc[4];
    const size_t hbase = ((size_t)(sq * SSD_H + head) * SSD_P) * SSD_N;
#pragma unroll
    for (int i = 0; i < 4; ++i)
#pragma unroll
        for (int j = 0; j < 4; ++j) Hacc[i][j] = SAMPLE ? INP(I_SSH)[hbase + (size_t)(16 * hpt + 4 * g + j) * SSD_N + 16 * (hnt0 + i) + c16] : 0.f;
    const int cgb = lane, rbb = w, gx = lane & 15, rsub = lane >> 4, rp = 4 * w + rsub;
    const int xcb = 2048 + (cgb >> 5) * 256 + grp * 128 + 4 * (cgb & 31), xcx = head * 64 + 4 * gx;
    const bool actB = SAMPLE ? (w < 2) : true, actX = SAMPLE ? (w < 2) : true;
    const unsigned voffb = (unsigned)(C_XBC + xcb) * 4u, voffxx = (unsigned)(rsub * 2 * DINP + C_XBC + xcx) * 4u, voffxs = (unsigned)(rsub * 2 * XBC + xcx) * 4u;
    f32x4 wB[4], wX[4], bB, bX;
#pragma unroll
    for (int k = 0; k < 4; ++k) { wB[k] = *(const GAS f32x4*)(INP(I_SCW) + (size_t)k * XBC + xcb); wX[k] = *(const GAS f32x4*)(INP(I_SCW) + (size_t)k * XBC + xcx); }
    bB = *(const GAS f32x4*)(INP(I_SCB) + xcb); bX = *(const GAS f32x4*)(INP(I_SCB) + xcx);
    f32x4 rawB[11], rawX[5]; float rawdt = 0.f; v2u rawBC[8];
    const unsigned voffbc = (unsigned)((cgb < 32 ? grp * 128 + 4 * cgb : 256 + grp * 128 + 4 * (cgb - 32)) * 2);
#define SSD_LDROW(dst_, chunk_, rr_, rl_, vp_, vs_) do { const int rr__ = (rr_); const int tu__ = SAMPLE ? rr__ : (chunk_) * 64 + rr__; const int tl__ = SAMPLE ? (rl_) : (chunk_) * 64 + (rl_); \
        const GAS char* pb__ = (const GAS char*)(P + (size_t)((SAMPLE ? MP + sq * TS : sq * TP + (chunk_) * 64) + rr__) * DINP); \
        const GAS char* sb__ = (const GAS char*)(INP(I_SSC) + (size_t)(sq * 3 + 3 + tu__) * XBC); \
        if ((rl_) >= TV) dst_ = (f32x4){0.f, 0.f, 0.f, 0.f}; \
        else if (tl__ >= 0) dst_ = *(const GAS f32x4*)(pb__ + (vp_)); \
        else if (SAMPLE) dst_ = *(const GAS f32x4*)(sb__ + (vs_)); \
        else dst_ = (f32x4){0.f, 0.f, 0.f, 0.f}; } while (0)
#define SSD_ISSUE(chunk_) do { \
        if (SAMPLE) { if (actB) { _Pragma("unroll") for (int i = 0; i < 11; ++i) SSD_LDROW(rawB[i], chunk_, 8 * rbb - 3 + i, 8 * rbb - 3 + i, voffb, (unsigned)xcb * 4u); } } \
        else { _Pragma("unroll") for (int i = 0; i < 8; ++i) rawBC[i] = *(const GAS v2u*)((const GAS char*)(WSP(bf16, WS_BCC) + (size_t)(sq * TP + (chunk_) * 64 + 8 * w + i) * 512) + voffbc); } \
        if (actX) { _Pragma("unroll") for (int i = 0; i < 5; ++i) SSD_LDROW(rawX[i], chunk_, 8 * w - 3 + i, 2 * rp - 3 + i, voffxx, voffxs); } \
        if (w == 0) { const int r_ = lane; const int R_ = SAMPLE ? MP + sq * TS + r_ : sq * TP + (chunk_) * 64 + r_; rawdt = (r_ < TV) ? P[(size_t)R_ * DINP + C_DT + head] : 0.f; } } while (0)
    SSD_ISSUE(0);
#pragma unroll
    for (int i = 0; i < 4; ++i)
#pragma unroll
        for (int j = 0; j < 4; ++j) HB[(16 * hpt + 4 * g + j) * SP136 + 16 * (hnt0 + i) + c16] = (bf16)f2bf(Hacc[i][j]);
    if (SAMPLE) {
        for (int e = tid; e < 64 * 16; e += 512) { const int p = e >> 4, c = 16 + (e & 15); XT[p * SP72 + c] = 0; XS[p * SP72 + c] = 0; }
        for (int e = tid; e < 128 * 16; e += 512) { const int n = e >> 4, c = 16 + (e & 15); BT[n * SP72 + c] = 0; }
    }
    const int nchunk = SAMPLE ? 1 : TP / 64;
    constexpr int NPT0 = (L == 64) ? 2 : 1; f32x4 z4n[NPT0];
    const unsigned voffz = (unsigned)(c16 * DINP + C_Z + head * 64 + 16 * ((L == 64) ? 2 * (w >> 2) : (w & 3)) + 4 * g) * 4u;
    { const int lt0 = (L == 64) ? (w & 3) : 0; const int R0f = SAMPLE ? MP + sq * TS : sq * TP;
#pragma unroll
      for (int pi = 0; pi < NPT0; ++pi) { z4n[pi] = (f32x4){0.f, 0.f, 0.f, 0.f}; if (16 * lt0 + c16 < TV) z4n[pi] = *(const GAS f32x4*)((const GAS char*)(P + (size_t)(R0f + 16 * lt0) * DINP) + voffz + pi * 64); } }
    for (int chunk = 0; chunk < nchunk; ++chunk) {
        int ln_ = lane; asm volatile("" : "+v"(ln_));
        const int lane = ln_, c16 = lane & 15, g = lane >> 4, cgb = lane, gx = lane & 15, rsub = lane >> 4, rp = 4 * w + rsub;
        const int R0 = SAMPLE ? MP + sq * TS : sq * TP + chunk * 64;
        const int lt_ = (L == 64) ? (w & 3) : 0, l_ = 16 * lt_ + c16; constexpr int NPT = (L == 64) ? 2 : 1; const int pt0_ = (L == 64) ? 2 * (w >> 2) : (w & 3);
        f32x4 z4[NPT];
#pragma unroll
        for (int pi = 0; pi < NPT; ++pi) z4[pi] = z4n[pi];
        if (chunk + 1 < nchunk) {
#pragma unroll
            for (int pi = 0; pi < NPT; ++pi) z4n[pi] = *(const GAS f32x4*)((const GAS char*)(P + (size_t)(R0 + 64 + 16 * lt_) * DINP) + voffz + pi * 64); }
        if (actB) {
#pragma unroll
            for (int i = 0; i < 8; ++i) { const int r = 8 * rbb + i; v2u pk;
                if (SAMPLE) { f32x4 v = bB + wB[0] * rawB[i] + wB[1] * rawB[i + 1] + wB[2] * rawB[i + 2] + wB[3] * rawB[i + 3];
                    if (r >= TV) v = (f32x4){0.f, 0.f, 0.f, 0.f}; else { v[0] = siluf_(v[0]); v[1] = siluf_(v[1]); v[2] = siluf_(v[2]); v[3] = siluf_(v[3]); }
                    pk.x = pk2(v[0], v[1]); pk.y = pk2(v[2], v[3]); }
                else pk = rawBC[i];
                const int n = 4 * (cgb & 31);
                if (cgb < 32) { *(LAS v2u*)(BM + r * SP136 + n) = pk; BT[(n + 0) * SP72 + r] = (bf16)(pk.x & 0xffffu); BT[(n + 1) * SP72 + r] = (bf16)(pk.x >> 16); BT[(n + 2) * SP72 + r] = (bf16)(pk.y & 0xffffu); BT[(n + 3) * SP72 + r] = (bf16)(pk.y >> 16); }
                else *(LAS v2u*)(CM + r * SP136 + n) = pk; } }
        if (actX) {
#pragma unroll
            for (int i = 0; i < 2; ++i) { const int r = 2 * rp + i; f32x4 v = bX + wX[0] * rawX[i] + wX[1] * rawX[i + 1] + wX[2] * rawX[i + 2] + wX[3] * rawX[i + 3];
                if (r >= TV) v = (f32x4){0.f, 0.f, 0.f, 0.f}; else { v[0] = siluf_(v[0]); v[1] = siluf_(v[1]); v[2] = siluf_(v[2]); v[3] = siluf_(v[3]); }
                *(LAS f32x4*)(XF + r * SP68 + 4 * gx) = v; const unsigned p0 = pk2(v[0], v[1]), p1 = pk2(v[2], v[3]); const int p = 4 * gx;
                XT[(p + 0) * SP72 + r] = (bf16)(p0 & 0xffffu); XT[(p + 1) * SP72 + r] = (bf16)(p0 >> 16); XT[(p + 2) * SP72 + r] = (bf16)(p1 & 0xffffu); XT[(p + 3) * SP72 + r] = (bf16)(p1 >> 16); } }
        if (w == 0) { const int r = lane; float dt = 0.f;
            if (r < TV) dt = softplus_f(rawdt + dtb);
            float cs = dt * Aneg;
#pragma unroll
            for (int o = 1; o < 64; o <<= 1) { const float up = __shfl_up(cs, o); if (lane >= o) cs += up; }
            const float csl = __shfl(cs, L - 1);
            if (r < L) { CS[r] = cs; DT[r] = dt; WG[r] = __expf(csl - cs) * dt; } }
        if (chunk + 1 < nchunk) SSD_ISSUE(chunk + 1);
        __syncthreads();
        for (int e = tid; e < 64 * L; e += 512) { const int p = e & 63, l = e >> 6; XS[p * SP72 + l] = (bf16)f2bf(XF[l * SP68 + p] * WG[l]); }
        __syncthreads();
        if (L == 64 || w < 4) {
            const int l = l_, pt0 = pt0_;
            bf16x8 cf[4];
#pragma unroll
            for (int ks = 0; ks < 4; ++ks) cf[ks] = *(const LAS bf16x8*)(CM + l * SP136 + ks * 32 + 8 * g);
            const float cs_l = CS[l];
            f32x4 gt[2 * KK];
#pragma unroll
            for (int st = 0; st < 2 * KK; ++st) { gt[st] = (f32x4){0.f, 0.f, 0.f, 0.f};
                if (st < LT) {
#pragma unroll
                    for (int ks = 0; ks < 4; ++ks) { const bf16x8 af = *(const LAS bf16x8*)(BM + (16 * st + c16) * SP136 + ks * 32 + 8 * g); gt[st] = MFMA16(af, cf[ks], gt[st]); }
#pragma unroll
                    for (int j = 0; j < 4; ++j) { const int s = 16 * st + 4 * g + j; gt[st][j] = (s <= l) ? gt[st][j] * __expf(cs_l - CS[s]) * DT[s] : 0.f; } } }
            bf16x8 wf[KK];
#pragma unroll
            for (int kk = 0; kk < KK; ++kk) wf[kk] = pack8(gt[2 * kk], gt[2 * kk + 1]);
            const float ecl = __expf(cs_l); const bool valid = (l < TV); const int R = R0 + l;
#pragma unroll
            for (int pi = 0; pi < NPT; ++pi) { const int pt = pt0 + pi; f32x4 a1 = (f32x4){0.f, 0.f, 0.f, 0.f}, a2 = (f32x4){0.f, 0.f, 0.f, 0.f};
#pragma unroll
                for (int kk = 0; kk < KK; ++kk) { const v2u lo = *(const LAS v2u*)(XT + (16 * pt + c16) * SP72 + 32 * kk + 4 * g), hi = *(const LAS v2u*)(XT + (16 * pt + c16) * SP72 + 32 * kk + 16 + 4 * g);
                    v4u wv; wv.x = lo.x; wv.y = lo.y; wv.z = hi.x; wv.w = hi.y; a1 = MFMA16(__builtin_bit_cast(bf16x8, wv), wf[kk], a1); }
#pragma unroll
                for (int ks = 0; ks < 4; ++ks) { const bf16x8 af = *(const LAS bf16x8*)(HB + (16 * pt + c16) * SP136 + ks * 32 + 8 * g); a2 = MFMA16(af, cf[ks], a2); }
                const f32x4 x4 = *(const LAS f32x4*)(XF + l * SP68 + 16 * pt + 4 * g);
                float v[4], q = 0.f;
#pragma unroll
                for (int j = 0; j < 4; ++j) { const float y = a1[j] + ecl * a2[j] + Dh * x4[j]; v[j] = y * siluf_(z4[pi][j]); q += v[j] * v[j]; }
                q += __shfl_xor(q, 16); q += __shfl_xor(q, 32);
                if (valid) { v2u o; o.x = pk2(v[0], v[1]); o.y = pk2(v[2], v[3]); *(GAS v2u*)(WSP(bf16, WS_V) + (size_t)R * DMIX + 2048 + head * 64 + 16 * pt + 4 * g) = o;
                    if (g == 0) WSP(float, WS_SQV)[(size_t)R * NSQV + 32 + head * 4 + pt] = q; } }
        }
        __syncthreads();
        { const float dec = __expf(CS[L - 1]);
#pragma unroll
          for (int i = 0; i < 4; ++i) Hacc[i] = Hacc[i] * dec;
#pragma unroll
          for (int kk = 0; kk < KK; ++kk) { const bf16x8 af = *(const LAS bf16x8*)(XS + (16 * hpt + c16) * SP72 + 32 * kk + 8 * g);
#pragma unroll
              for (int i = 0; i < 4; ++i) { const bf16x8 bfr = *(const LAS bf16x8*)(BT + (16 * (hnt0 + i) + c16) * SP72 + 32 * kk + 8 * g); Hacc[i] = MFMA16(af, bfr, Hacc[i]); } }
          if (chunk + 1 < nchunk) {
#pragma unroll
              for (int i = 0; i < 4; ++i)
#pragma unroll
                  for (int j = 0; j < 4; ++j) HB[(16 * hpt + 4 * g + j) * SP136 + 16 * (hnt0 + i) + c16] = (bf16)f2bf(Hacc[i][j]); } }
        __syncthreads();
    }
    float* ho = F.out + (SAMPLE ? O_SSH : O_PSH) + hbase;
#pragma unroll
    for (int i = 0; i < 4; ++i)
#pragma unroll
        for (int j = 0; j < 4; ++j) ho[(size_t)(16 * hpt + 4 * g + j) * SSD_N + 16 * (hnt0 + i) + c16] = Hacc[i][j];
}
__device__ __forceinline__ void p4_mixer_prompt(Frame& F, const Args& A) {
    for (int it = blockIdx.x; it < 128 + 128; it += F.G) {
        if (it < 128) lru_item<false>(F, A, it >> 5, (it >> 1) & 15, it & 1); else ssd_item<64>(F, A, (it - 128) >> 5, (it - 128) & 31);
    }
}
__device__ __forceinline__ void p4_mixer_sample(Frame& F, const Args& A, int qoff) {
    for (;;) {
        __syncthreads();
        if (F.tid == 0) F.MISC[0] = __hip_atomic_fetch_add(F.ctl + CW_QUEUE + qoff, 1u, RLX_AGENT);
        __syncthreads();
        const int it = (int)F.MISC[0];
        if (it >= 512 + NBS * SSD_H) break;
        if (it < 512) lru_item<true>(F, A, it >> 5, (it >> 1) & 15, it & 1); else ssd_item<16>(F, A, (it - 512) >> 5, (it - 512) & 31);
    }
}

#ifndef DUP_PHASE
#define DUP_PHASE -1
#endif
#ifndef MK_PER_PHASE
#define MK_PER_PHASE 0
#endif
constexpr int N_PHASES = 14;
constexpr int CW_QH = 20480;
template <class Epi> __device__ __forceinline__ void run_gemm_r(Frame& F, const bf16* Aop, const bf16* Bt, int Mr, int N, int K, const Epi& E, int lo, int n, int G, int c) {
    pg8::Gemm g{Aop, Bt, Mr, N, K}; pg8::RangeOrder R; R.init(Mr, N, lo, n, G, c);
    pg8::gemm_phase<Epi, pg8::RangeOrder, PG8_ALIGN, PG8_SP2>(F.lds + RING_OFF, g, R, E);
}
__global__ void __launch_bounds__(NWAVES * 64, 2) hymba_fwd(Args args) {
    extern __shared__ __attribute__((aligned(16))) unsigned char lds[];
    const Args& A = args;
    Frame F;
    F.lds = (LAS unsigned char*)lds;
    F.MISC = (volatile LAS unsigned*)(F.lds + MISC_OFF);
    F.tid = threadIdx.x; F.lane = F.tid & 63; F.wave = __builtin_amdgcn_readfirstlane(F.tid >> 6);
    F.G = gridDim.x; { const int bx = blockIdx.x; F.vcu = (F.G % 8 == 0) ? (bx % 8) * (F.G / 8) + bx / 8 : bx; }
    F.ws = args.ws; F.out = args.out; F.ctl = (gu32*)(args.ws + WS_CTL);
    for (int u = F.tid; u < (LDS_BYTES - LDSCTL_OFF) / 4; u += NWAVES * 64) ((LAS unsigned*)(F.lds + LDSCTL_OFF))[u] = 0u;
    __syncthreads();
    XcdBarrier bar = xcd_barrier_post((unsigned*)(F.ctl + CW_BAR), F.MISC + 8);
#define GRID_BAR() xcd_barrier(bar)
#define SLOT_BEGIN(slot_) do { cu = 0u; Sx = 0; if (xq == -2) { unsigned ok = 1u; for (int j = 0; j < 16; ++j) { const unsigned c_ = xb_ld((unsigned*)(F.ctl + CW_BAR) + XB_XCNT(j)); ok &= (j < 8) ? (c_ > 0u) : (c_ == 0u); } \
            xq = ok ? (int)(bar.x & 7u) : -1; } \
        __syncthreads(); if (F.tid == 0) F.MISC[16] = __hip_atomic_fetch_add(F.ctl + CW_QH + 64 * ((slot_) * 8 + (xq < 0 ? 0 : xq)), 1u, RLX_AGENT); __syncthreads(); } while (0)
    const int lo = args.ph_lo, hi = args.ph_hi;
#define IN(k) (lo <= (k) && (k) < hi)
#define BOTH(k) (IN(k) && IN((k) + 1))
    const int bid = blockIdx.x;
    float* SSQ0 = WSP(float, WS_SSQ); float* SSQ1 = SSQ0 + (size_t)M * NSSQ; float* SSQ2 = SSQ1 + (size_t)M * NSSQ; float* SSQ3 = SSQ2 + (size_t)M * NSSQ; float* SSQ4 = SSQ3 + (size_t)M * NSSQ;
    unsigned cu = 0u; int Sx = 0, xq = -2;
    bf16* XBA = WSP(bf16, WS_XBA); bf16* XBB = WSP(bf16, WS_XBB); bf16* ACT = WSP(bf16, WS_ACT); float* XR = WSP(float, WS_XR); bf16* VV = WSP(bf16, WS_V); bf16* QQ = WSP(bf16, WS_Q); bf16* OO = WSP(bf16, WS_O);
    constexpr float QSCALE = 0.04419417382415922f;

    if (IN(0)) { p0_prologue(F, A); if (BOTH(0)) GRID_BAR(); }
    constexpr int U_GU_P = (MP / 256) * (NGU / 256), U_GU_S = (MS / 256) * (NGU / 256), U_D_P = (MP / 256) * (D / 256), U_D_S = (MS / 256) * (D / 256), U_IN_P = (MP / 256) * (DINP / 256), U_IN_S = (MS / 256) * (DINP / 256), U_KV = (MMEM / 256) * (2 * D / 256);
    const int G = F.G, c32 = bid - 32;
    if (IN(1)) {
        { pg8::EpiKV E{F.out + O_PMK, F.out + O_PMV, WSP(bf16, WS_KM), WSP(bf16, WS_VT), WSP(float, WS_SSQM), 0}; run_gemm_r(F, WSP(bf16, WS_MEMB), WSP(bf16, WS_WKV), MMEM, 2 * D, D, E, 0, U_KV, G, bid); }
        { pg8::EpiSwiglu E{ACT, FF, SSQ0, MP}; run_gemm_r(F, XBA + (size_t)MP * D, WSP(bf16, WS_W1GU), MS, NGU, D, E, 0, U_GU_S, G, bid - 64 >= 0 ? bid - 64 : bid + G - 64); }
        if (BOTH(1)) GRID_BAR(); }
    if (IN(2)) {
        { pg8::EpiRes<true, true> E{INP(I_XP), INP(I_XS), XR, XBB, SSQ1, 0.5f, MP}; run_gemm_r(F, ACT + (size_t)MP * FF, WSP(bf16, WS_W1D), MS, D, FF, E, 0, U_D_S, 32, bid < 32 ? bid : -1); }
        { pg8::EpiSwiglu E{ACT, FF, SSQ0, 0}; if (bid < 32) run_gemm_r(F, XBA, WSP(bf16, WS_W1GU), MP, NGU, D, E, U_GU_P - 96, 96, 32, bid); else run_gemm_r(F, XBA, WSP(bf16, WS_W1GU), MP, NGU, D, E, 0, U_GU_P - 96, G - 32, c32); }
        if (BOTH(2)) GRID_BAR(); }
    if (IN(3)) {
        { pg8::EpiRes<true, true> E{INP(I_XP), INP(I_XS), XR, XBB, SSQ1, 0.5f, 0}; run_gemm_r(F, ACT, WSP(bf16, WS_W1D), MP, D, FF, E, 0, U_D_P, G, bid); }
        { pg8::EpiProj E{WSP(float, WS_PROJ), DINP, SSQ1, MP}; run_gemm_r(F, XBB + (size_t)MP * D, WSP(bf16, WS_WIN), MS, DINP, D, E, 0, U_IN_S, G, bid); }
        if (G > U_IN_S) { if (bid >= U_IN_S) convert_weights<1>(F, A, (bid - U_IN_S) * NWAVES + F.wave, (G - U_IN_S) * NWAVES); } else convert_weights<1>(F, A, F.vcu * NWAVES + F.wave, G * NWAVES);
        if (BOTH(3)) GRID_BAR(); }
    if (IN(4)) {
        { pg8::EpiProj E{WSP(float, WS_PROJ), DINP, SSQ1, 0}; run_gemm_r(F, XBB, WSP(bf16, WS_WIN), MP, DINP, D, E, 0, U_IN_P, G, bid); }
        p4_mixer_sample(F, A, 0);
        if (BOTH(4)) GRID_BAR(); }
    if (IN(5)) { p3b_bcconv(F, A); GRID_BAR(); }
    if (IN(5)) {
        p4_mixer_prompt(F, A);
        p5_normalize(F, A, MP, M, NBP, NBP + NBS, F.vcu * NWAVES + F.wave, F.G * NWAVES);
        if (BOTH(5)) GRID_BAR(); }
    if (IN(6)) {
        { pg8::EpiRes<false, true> E{nullptr, nullptr, XR, XBA, SSQ2, 1.0f, MP}; run_gemm_r(F, VV + (size_t)MP * DMIX, WSP(bf16, WS_WOUT), MS, D, DMIX, E, 0, U_D_S, 32, bid < 32 ? bid : -1); }
        if (G > 32) { if (bid >= 32) { p5_normalize(F, A, 0, MP, 0, NBP, c32 * NWAVES + F.wave, (G - 32) * NWAVES); convert_weights<2>(F, A, c32 * NWAVES + F.wave, (G - 32) * NWAVES); } }
        else { p5_normalize(F, A, 0, MP, 0, NBP, F.vcu * NWAVES + F.wave, G * NWAVES); convert_weights<2>(F, A, F.vcu * NWAVES + F.wave, G * NWAVES); }
        if (BOTH(6)) GRID_BAR(); }
    if (IN(7)) {
        { pg8::EpiRes<false, true> E{nullptr, nullptr, XR, XBA, SSQ2, 1.0f, 0}; run_gemm_r(F, VV, WSP(bf16, WS_WOUT), MP, D, DMIX, E, 0, U_D_P, G, bid); }
        { pg8::EpiQ E{QQ, SSQ2, QSCALE, MP}; run_gemm_r(F, XBA + (size_t)MP * D, WSP(bf16, WS_WQ), MS, D, D, E, 0, U_D_S, 32, bid < 32 ? bid : -1); }
        if (G > 32) { if (bid >= 32) convert_weights<3>(F, A, c32 * NWAVES + F.wave, (G - 32) * NWAVES); } else convert_weights<3>(F, A, F.vcu * NWAVES + F.wave, G * NWAVES);
        if (BOTH(7)) GRID_BAR(); }
    if (IN(8)) {
        const bool attn_first = ((bid >> 3) & 1) != 0;
        if (attn_first) p8_attn_sample(F, A);
        { pg8::EpiQ E{QQ, SSQ2, QSCALE, 0}; run_gemm_r(F, XBA, WSP(bf16, WS_WQ), MP, D, D, E, 0, U_D_P, G, bid); }
        if (!attn_first) p8_attn_sample(F, A);
        if (BOTH(8)) GRID_BAR(); }
    if (IN(9)) {
        { pg8::EpiRes<false, true> E{nullptr, nullptr, XR, XBB, SSQ3, 1.0f, MP}; run_gemm_r(F, OO + (size_t)MP * D, WSP(bf16, WS_WO), MS, D, D, E, 0, U_D_S, 32, bid < 32 ? bid : -1); }
        if (G > 32) p8_attn_prompt(F, A, c32, G - 32); else p8_attn_prompt(F, A, bid, G);
        if (BOTH(9)) GRID_BAR(); }
    if (IN(10)) {
        { pg8::EpiRes<false, true> E{nullptr, nullptr, XR, XBB, SSQ3, 1.0f, 0}; run_gemm_r(F, OO, WSP(bf16, WS_WO), MP, D, D, E, 0, U_D_P, G, bid); }
        { pg8::EpiSwiglu E{ACT, FF, SSQ3, MP}; run_gemm_r(F, XBB + (size_t)MP * D, WSP(bf16, WS_W2GU), MS, NGU, D, E, 0, U_GU_S, G, bid); }
        if (BOTH(10)) GRID_BAR(); }
    if (IN(11)) {
        { pg8::EpiRes<false, false> E{nullptr, nullptr, XR, nullptr, SSQ4, 0.5f, MP}; run_gemm_r(F, ACT + (size_t)MP * FF, WSP(bf16, WS_W2D), MS, D, FF, E, 0, U_D_S, 32, bid < 32 ? bid : -1); }
        { pg8::EpiSwiglu E{ACT, FF, SSQ3, 0}; if (bid < 32) run_gemm_r(F, XBB, WSP(bf16, WS_W2GU), MP, NGU, D, E, U_GU_P - 96, 96, 32, bid); else run_gemm_r(F, XBB, WSP(bf16, WS_W2GU), MP, NGU, D, E, 0, U_GU_P - 96, G - 32, c32); }
        if (BOTH(11)) GRID_BAR(); }
    if (IN(12)) {
        { pg8::EpiRes<false, false> E{nullptr, nullptr, XR, nullptr, SSQ4, 0.5f, 0}; run_gemm_r(F, ACT, WSP(bf16, WS_W2D), MP, D, FF, E, 0, U_D_P, G, bid); }
        p12_final(F, A, MP, M);
        if (BOTH(12)) GRID_BAR(); }
    if (IN(13)) { p12_final(F, A, 0, MP); }
#undef IN
#undef BOTH
}

extern "C" void kernel_launch(void* const* d_in, const int* in_sizes, int n_in, void* d_out, int out_size, void* d_ws, size_t ws_size, hipStream_t stream) {
    static int grid = 0;
    if (grid == 0) {
        if (n_in != N_IN || (size_t)out_size != O_END || ws_size < WS_END) { fprintf(stderr, "kernel_launch: shape mismatch: n_in %d out %d ws %zu (need %zu)\n", n_in, out_size, ws_size, (size_t)WS_END); grid = -1; return; }
        int dev = 0, cus = 0, per_cu = 0;
        if (hipGetDevice(&dev) != hipSuccess || hipDeviceGetAttribute(&cus, hipDeviceAttributeMultiprocessorCount, dev) != hipSuccess) { grid = -1; return; }
        if (hipFuncSetAttribute((const void*)hymba_fwd, hipFuncAttributeMaxDynamicSharedMemorySize, LDS_BYTES) != hipSuccess) { fprintf(stderr, "kernel_launch: hipFuncSetAttribute failed\n"); grid = -1; return; }
        if (hipOccupancyMaxActiveBlocksPerMultiprocessor(&per_cu, (const void*)hymba_fwd, NWAVES * 64, LDS_BYTES) != hipSuccess || per_cu < 1) { fprintf(stderr, "kernel_launch: occupancy query says %d blocks per CU\n", per_cu); (void)hipGetLastError(); grid = -1; return; }
        grid = cus;
    }
    if (grid < 0) return;
    if (hipMemsetAsync((char*)d_ws + WS_CTL, 0, CTL_ZERO_BYTES, stream) != hipSuccess) return;
    Args a{};
    for (int i = 0; i < N_IN; ++i) a.in[i] = (const float*)d_in[i];
    a.out = (float*)d_out; a.ws = (unsigned char*)d_ws;
    a.ph_lo = 0; a.ph_hi = N_PHASES; hipLaunchKernelGGL(hymba_fwd, dim3(grid), dim3(NWAVES * 64), LDS_BYTES, stream, a);
}
```

```cpp
#include <hip/hip_runtime.h>
#include <cstdio>
#include <cstdint>

constexpr int NWAVES = 8;
constexpr int D = 2048, MP = 8192, MS = 1024, M = MP + MS, TP = 2048, TS = 8, NBP = 4, NBS = 128;
constexpr int FF = 5632, NGU = 2 * FF, DIN = 8736, DINP = 8960, DMIX = 4096, NMEM = 256, MMEM = NBP * NMEM;
constexpr int LRU_H = 16, LRU_B = 128, SSD_H = 32, SSD_P = 64, SSD_N = 128, XBC = 2560;
constexpr int C_XL = 0, C_GL = 2048, C_Z = 4096, C_XBC = 6144, C_DT = 8704;
constexpr float EPS = 1e-6f;
constexpr int NSSQ = 32;
constexpr int NSQV = 160;
constexpr size_t O_Y = 0, O_PLC = (size_t)M * D, O_PLH = O_PLC + (size_t)NBP * 3 * D, O_PSC = O_PLH + (size_t)NBP * D, O_PSH = O_PSC + (size_t)NBP * 3 * XBC,
                 O_PMK = O_PSH + (size_t)NBP * SSD_H * SSD_P * SSD_N, O_PMV = O_PMK + (size_t)MMEM * D, O_SLC = O_PMV + (size_t)MMEM * D, O_SLH = O_SLC + (size_t)NBS * 3 * D,
                 O_SSC = O_SLH + (size_t)NBS * D, O_SSH = O_SSC + (size_t)NBS * 3 * XBC, O_END = O_SSH + (size_t)NBS * SSD_H * SSD_P * SSD_N;
static_assert(O_END == 59766784, "d_out size");
enum { I_XP = 0, I_MEMP, I_XS, I_CK, I_CV, I_SLC, I_SLH, I_SSC, I_SSH, I_F1G, I_F1WG, I_F1WU, I_F1WD, I_MIXG, I_WIN, I_LCW, I_LCB, I_LWA, I_LBA, I_LWX, I_LBX, I_LLAM, I_LOG,
       I_SCW, I_SCB, I_SDTB, I_SALOG, I_SD, I_SOG, I_WOUT, I_XAG, I_MEMG, I_WQ, I_WK, I_WV, I_WO, I_F2G, I_F2WG, I_F2WU, I_F2WD, I_FING, N_IN };
static_assert(N_IN == 41, "inputs");

constexpr size_t MiB = 1u << 20;
constexpr size_t al(size_t x) { return (x + 4095) & ~(size_t)4095; }
constexpr size_t WS_CTL = 0, CTL_ZERO_BYTES = 1 * MiB;
constexpr size_t WS_W1GU = 2 * MiB;
constexpr size_t WS_W1D  = WS_W1GU + al((size_t)NGU * D * 2);
constexpr size_t WS_WIN  = WS_W1D + al((size_t)D * FF * 2);
constexpr size_t WS_WOUT = WS_WIN + al((size_t)DINP * D * 2);
constexpr size_t WS_WQ   = WS_WOUT + al((size_t)D * DMIX * 2);
constexpr size_t WS_WKV  = WS_WQ + al((size_t)D * D * 2);
constexpr size_t WS_WO   = WS_WKV + al((size_t)2 * D * D * 2);
constexpr size_t WS_W2GU = WS_WO + al((size_t)D * D * 2);
constexpr size_t WS_W2D  = WS_W2GU + al((size_t)NGU * D * 2);
constexpr size_t WS_WL   = WS_W2D + al((size_t)D * FF * 2);
constexpr size_t WS_XBA  = WS_WL + al((size_t)LRU_H * 256 * 128 * 2);
constexpr size_t WS_XBB  = WS_XBA + al((size_t)M * D * 2);
constexpr size_t WS_MEMB = WS_XBB + al((size_t)M * D * 2);
constexpr size_t WS_ACT  = WS_MEMB + al((size_t)MMEM * D * 2);
constexpr size_t WS_XR   = WS_ACT + al((size_t)M * FF * 2);
constexpr size_t WS_PROJ = WS_XR + al((size_t)M * D * 4);
constexpr size_t WS_V    = WS_PROJ + al((size_t)M * DINP * 4);
constexpr size_t WS_Q    = WS_V + al((size_t)M * DMIX * 2);
constexpr size_t WS_O    = WS_Q + al((size_t)M * D * 2);
constexpr size_t WS_KM   = WS_O + al((size_t)M * D * 2);
constexpr size_t WS_VT   = WS_KM + al((size_t)MMEM * D * 2);
constexpr size_t WS_SSQ  = WS_VT + al((size_t)MMEM * D * 2);
constexpr size_t WS_SSQM = WS_SSQ + al((size_t)4 * M * NSSQ * 4);
constexpr size_t WS_SQV  = WS_SSQM + al((size_t)MMEM * NSSQ * 4);
constexpr size_t WS_BCC  = WS_SQV + al((size_t)M * NSQV * 4);
constexpr size_t WS_END  = WS_BCC + al((size_t)MP * 512 * 2);
constexpr int CW_TMO = 0, CW_CODE = 1, CW_QUEUE = 64, CW_BAR = 4096;

namespace pg8 {
#define PG8_LAS __attribute__((address_space(3)))
typedef unsigned short bf16_t;
typedef short bf16x8 __attribute__((ext_vector_type(8)));
typedef float f32x4 __attribute__((ext_vector_type(4)));
typedef unsigned u32x4 __attribute__((ext_vector_type(4)));
constexpr int BM = 256, BK = 64, HALF = 128, HTB = HALF * BK * 2  , STAGE_BYTES = 8 * HTB, NXCD = 8, WGM = 8;

__host__ __device__ __forceinline__ int lds_byte(int r, int c) { const int st = (r >> 4) * 2 + (c >> 5), rr = r & 15, cc = c & 31, ob = rr * 64 + cc * 2; return st * 1024 + (ob ^ (((ob >> 9) & 1) << 5)); }
__host__ __device__ __forceinline__ void stage_rc(int b, int& R, int& C) { const int st = b / 1024, sb = b % 1024, swz = sb ^ (((sb >> 9) & 1) << 5); R = (st >> 1) * 16 + swz / 64; C = (st & 1) * 32 + (swz % 64) / 2; }
__host__ __device__ __forceinline__ int perm32(int rho) { const int n = rho >> 4, i = rho & 15; return 8 * (i >> 2) + 4 * n + (i & 3); }

struct Unit { int pm, pn; };
struct Gemm { const bf16_t* A; const bf16_t* Bt; int M, N, K; };

struct StaticOrder {
    int nM, nN, nwg, G, c;
    __host__ __device__ void init(int M, int N, int G_, int c_) { nM = M / BM; nN = N / BM; nwg = nM * nN; G = G_; c = c_; }
    __host__ __device__ bool next(int i, Unit& u) const {
        const long L = (long)i * G + c; if (L >= nwg) return false;
        int wgid = (int)L; { const int q = nwg / NXCD, r = nwg % NXCD, xcd = wgid % NXCD, off = wgid / NXCD; wgid = (xcd < r ? xcd * (q + 1) : r * (q + 1) + (xcd - r) * q) + off; }
        const int nig = WGM * nN, gid = wgid / nig, fm = gid * WGM, gsz = (nM - fm) < WGM ? (nM - fm) : WGM;
        u.pm = fm + ((wgid % nig) % gsz); u.pn = (wgid % nig) / gsz; return true;
    }
    __device__ __forceinline__ void a_ready(const Unit&) const {}
    __device__ __forceinline__ void done(const Unit&) const {}
};

#define PG8_RLX __ATOMIC_RELAXED, __HIP_MEMORY_SCOPE_AGENT
struct QueueOrder {
    int nM, nN, cnt, base, S; unsigned cu;
    unsigned* qhead; volatile PG8_LAS unsigned* slots;
    mutable unsigned pend, taken;
    __device__ __forceinline__ void init(int M, int N, int xq, int& Sx, unsigned cu_, unsigned* qhead_, volatile PG8_LAS unsigned* slots_) {
        nM = M / BM; nN = N / BM; const int nwg = nM * nN;
        if (xq < 0) { base = 0; cnt = nwg; } else { const int q = nwg / NXCD, r = nwg % NXCD; cnt = q + (xq < r ? 1 : 0); base = xq < r ? xq * (q + 1) : r * (q + 1) + (xq - r) * q; }
        S = Sx; Sx += cnt; cu = cu_; qhead = qhead_; slots = slots_; pend = 0u; taken = 0u; }
    __device__ __forceinline__ bool next(int i, Unit& u) const {
        const int L = (int)__builtin_amdgcn_readfirstlane(slots[(cu + (unsigned)i) & 3u]) - S;
        if (L >= cnt) return false;
        const int wgid = base + L, nig = WGM * nN, gid = wgid / nig, fm = gid * WGM, gsz = (nM - fm) < WGM ? (nM - fm) : WGM, rem = wgid - gid * nig;
        u.pm = fm + rem % gsz; u.pn = rem / gsz;
        if (threadIdx.x == 0) pend = __hip_atomic_fetch_add(qhead, 1u, PG8_RLX);
        taken = (unsigned)i + 1u;
        return true;
    }
    __device__ __forceinline__ void a_ready(const Unit&) const {
        if (threadIdx.x == 0) slots[(cu + taken) & 3u] = pend;
        asm volatile("s_waitcnt lgkmcnt(0)" ::: "memory"); __builtin_amdgcn_s_barrier(); asm volatile("" ::: "memory");
    }
    __device__ __forceinline__ void done(const Unit&) const {}
};

struct RangeOrder {
    int nM, nN, lo, n, G, c;
    __device__ __forceinline__ void init(int M, int N, int lo_, int n_, int G_, int c_) { nM = M / BM; nN = N / BM; lo = lo_; n = n_; G = G_; c = c_; }
    __device__ __forceinline__ bool next(int i, Unit& u) const {
        const int Lr = i * G + c; if (c < 0 || c >= G || Lr >= n) return false;
        int w = Lr; { const int q = n / NXCD, r = n % NXCD, xcd = w % NXCD, off = w / NXCD; w = (xcd < r ? xcd * (q + 1) : r * (q + 1) + (xcd - r) * q) + off; }
        const int wgid = lo + w, nig = WGM * nN, gid = wgid / nig, fm = gid * WGM, gsz = (nM - fm) < WGM ? (nM - fm) : WGM, rem = wgid - gid * nig;
        u.pm = fm + rem % gsz; u.pn = rem / gsz; return true;
    }
    __device__ __forceinline__ void a_ready(const Unit&) const {}
    __device__ __forceinline__ void done(const Unit&) const {}
};

__device__ __forceinline__ unsigned cvt_pk_bf16(float lo, float hi) { unsigned r; asm volatile("v_cvt_pk_bf16_f32 %0, %1, %2" : "=v"(r) : "v"(lo), "v"(hi)); return r; }
typedef unsigned u32x2 __attribute__((ext_vector_type(2)));
constexpr float EPS_ = 1e-6f;
__device__ __forceinline__ float row_rstd(const float* ssq, int row, int fq) {
    const f32x4* p = (const f32x4*)(ssq + (size_t)row * 32 + fq * 8);
    const f32x4 a = p[0], b = p[1];
    float s = ((a[0] + a[1]) + (a[2] + a[3])) + ((b[0] + b[1]) + (b[2] + b[3]));
    s += __shfl_xor(s, 16); s += __shfl_xor(s, 32);
    return __builtin_amdgcn_rsqf(s * (1.0f / 2048.0f) + EPS_);
}
__device__ __forceinline__ float silu_f(float x) { return x * __builtin_amdgcn_rcpf(1.0f + __expf(-x)); }

struct EpiSwiglu {
    static constexpr bool PERM = true, AFTER_DRAIN = false;
    bf16_t* O; int ldc; const float* ssq; int rbase;
    __device__ __forceinline__ void operator()(const f32x4 (&acc)[2][2][4][2], const Unit& u, int wr, int wc, int fr, int fq) const {
        const int row0 = rbase + u.pm * BM + wr * 64 + fr, col0 = u.pn * HALF + wc * 32 + 8 * fq;
#pragma unroll
        for (int ai = 0; ai < 2; ++ai)
#pragma unroll
            for (int m = 0; m < 4; ++m) { const int row = row0 + ai * HALF + m * 16; const float rs = row_rstd(ssq, row, fq);
                u32x4 w; float o[8];
#pragma unroll
                for (int n = 0; n < 2; ++n)
#pragma unroll
                    for (int i = 0; i < 4; ++i) { const float g = acc[ai][0][m][n][i] * rs, up = acc[ai][1][m][n][i] * rs; o[4 * n + i] = silu_f(g) * up; }
                w.x = cvt_pk_bf16(o[0], o[1]); w.y = cvt_pk_bf16(o[2], o[3]); w.z = cvt_pk_bf16(o[4], o[5]); w.w = cvt_pk_bf16(o[6], o[7]);
                *(u32x4*)(O + (size_t)row * ldc + col0) = w; }
    }
};
struct EpiKV {
    static constexpr bool PERM = false, AFTER_DRAIN = false;
    float* ko; float* vo; bf16_t* km; bf16_t* vt; const float* ssq; int rbase;
    __device__ __forceinline__ void operator()(const f32x4 (&acc)[2][2][4][2], const Unit& u, int wr, int wc, int fr, int fq) const {
        const int row0 = rbase + u.pm * BM + wr * 64 + fr;
#pragma unroll
        for (int ai = 0; ai < 2; ++ai)
#pragma unroll
            for (int m = 0; m < 4; ++m) { const int row = row0 + ai * HALF + m * 16; const float rs = row_rstd(ssq, row, fq);
#pragma unroll
                for (int bj = 0; bj < 2; ++bj)
#pragma unroll
                    for (int n = 0; n < 2; ++n) { const int col = u.pn * BM + bj * HALF + wc * 32 + n * 16 + 4 * fq; const f32x4 v = acc[ai][bj][m][n] * rs;
                        if (u.pn < 8) { *(f32x4*)(ko + (size_t)row * 2048 + col) = v; u32x2 w; w.x = cvt_pk_bf16(v[0], v[1]); w.y = cvt_pk_bf16(v[2], v[3]); *(u32x2*)(km + (size_t)row * 2048 + col) = w; }
                        else { const int c2 = col - 2048; *(f32x4*)(vo + (size_t)row * 2048 + c2) = v; const int b = row >> 8, key = row & 255;
                            const unsigned w0 = cvt_pk_bf16(v[0], v[1]), w1 = cvt_pk_bf16(v[2], v[3]); bf16_t* t = vt + ((size_t)(b * 2048 + c2)) * 256 + key;
                            t[0] = (bf16_t)(w0 & 0xffffu); t[256] = (bf16_t)(w0 >> 16); t[512] = (bf16_t)(w1 & 0xffffu); t[768] = (bf16_t)(w1 >> 16); } } }
    }
};
template <bool FIRST, bool WRITE_XB> struct EpiRes {
    static constexpr bool PERM = false, AFTER_DRAIN = false;
    const float* xp; const float* xs; float* xr; bf16_t* xb; float* ssq_out; float alpha; int rbase;
    __device__ __forceinline__ void operator()(const f32x4 (&acc)[2][2][4][2], const Unit& u, int wr, int wc, int fr, int fq) const {
        const int row0 = rbase + u.pm * BM + wr * 64 + fr;
#pragma unroll
        for (int ai = 0; ai < 2; ++ai)
#pragma unroll
            for (int m = 0; m < 4; ++m) { const int row = row0 + ai * HALF + m * 16; float q = 0.f;
                const float* base = FIRST ? (row < 8192 ? xp + (size_t)row * 2048 : xs + (size_t)(row - 8192) * 2048) : xr + (size_t)row * 2048;
#pragma unroll
                for (int bj = 0; bj < 2; ++bj)
#pragma unroll
                    for (int n = 0; n < 2; ++n) { const int col = u.pn * BM + bj * HALF + wc * 32 + n * 16 + 4 * fq; const f32x4 b = *(const f32x4*)(base + col); const f32x4 o = b + acc[ai][bj][m][n] * alpha;
                        *(f32x4*)(xr + (size_t)row * 2048 + col) = o; q += (o[0] * o[0] + o[1] * o[1]) + (o[2] * o[2] + o[3] * o[3]);
                        if (WRITE_XB) { u32x2 w; w.x = cvt_pk_bf16(o[0], o[1]); w.y = cvt_pk_bf16(o[2], o[3]); *(u32x2*)(xb + (size_t)row * 2048 + col) = w; } }
                q += __shfl_xor(q, 16); q += __shfl_xor(q, 32);
                if (fq == 0) ssq_out[(size_t)row * 32 + u.pn * 4 + wc] = q; }
    }
};
struct EpiProj {
    static constexpr bool PERM = false, AFTER_DRAIN = false;
    float* C; int ldc; const float* ssq; int rbase;
    __device__ __forceinline__ void operator()(const f32x4 (&acc)[2][2][4][2], const Unit& u, int wr, int wc, int fr, int fq) const {
        const int row0 = rbase + u.pm * BM + wr * 64 + fr;
#pragma unroll
        for (int ai = 0; ai < 2; ++ai)
#pragma unroll
            for (int m = 0; m < 4; ++m) { const int row = row0 + ai * HALF + m * 16; const float rs = row_rstd(ssq, row, fq);
#pragma unroll
                for (int bj = 0; bj < 2; ++bj)
#pragma unroll
                    for (int n = 0; n < 2; ++n) { const int col = u.pn * BM + bj * HALF + wc * 32 + n * 16 + 4 * fq; *(f32x4*)(C + (size_t)row * ldc + col) = acc[ai][bj][m][n] * rs; } }
    }
};
struct EpiQ {
    static constexpr bool PERM = true, AFTER_DRAIN = false;
    bf16_t* O; const float* ssq; float scale; int rbase;
    __device__ __forceinline__ void operator()(const f32x4 (&acc)[2][2][4][2], const Unit& u, int wr, int wc, int fr, int fq) const {
        const int row0 = rbase + u.pm * BM + wr * 64 + fr, col0 = u.pn * BM + wc * 32 + 8 * fq;
#pragma unroll
        for (int ai = 0; ai < 2; ++ai)
#pragma unroll
            for (int m = 0; m < 4; ++m) { const int row = row0 + ai * HALF + m * 16; const float rs = row_rstd(ssq, row, fq) * scale;
#pragma unroll
                for (int bj = 0; bj < 2; ++bj) { const f32x4 v0 = acc[ai][bj][m][0] * rs, v1 = acc[ai][bj][m][1] * rs;
                    u32x4 w; w.x = cvt_pk_bf16(v0[0], v0[1]); w.y = cvt_pk_bf16(v0[2], v0[3]); w.z = cvt_pk_bf16(v1[0], v1[1]); w.w = cvt_pk_bf16(v1[2], v1[3]);
                    *(u32x4*)(O + (size_t)row * 2048 + col0 + bj * HALF) = w; } }
    }
};

template <class Epi, class Sched, bool ALIGN_EPI = false, bool SP2 = false>
__device__ __forceinline__ void gemm_phase(PG8_LAS unsigned char* lds, const Gemm g, const Sched& S, const Epi& E) {
    const int tid = threadIdx.x, wid = __builtin_amdgcn_readfirstlane(tid >> 6), lane = tid & 63, wr = wid >> 2, wc = wid & 3, fr = lane & 15, fq = lane >> 4;
    const int K = g.K, nt = K / BK;
    unsigned voffA[2], voffB[2];
#pragma unroll
    for (int i = 0; i < 2; ++i) { int R, C; stage_rc(tid * 16 + i * 8192, R, C); const int Rb = Epi::PERM ? ((R & ~31) + perm32(R & 31)) : R;
        voffA[i] = (unsigned)(R * K + C) * 2u; voffB[i] = (unsigned)(Rb * K + C) * 2u; }
    const size_t kstep = (size_t)(BK * 2);
    const size_t hstep = (size_t)HALF * K * 2;
    const size_t tstep = 2 * hstep;
    const unsigned ldsw = (unsigned)wid * 1024u;
    const int aoff = lds_byte(wr * 64 + fr, fq * 8), boff = lds_byte(wc * 32 + fr, fq * 8);
#define PG8_SA(b, h) (((b) * 2 + (h)) * HTB)
#define PG8_SB(b, h) ((4 + (b) * 2 + (h)) * HTB)
#define PG8_STAGE(bufoff, gbase, voff) do { _Pragma("unroll") for (int _i = 0; _i < 2; ++_i) \
        __builtin_amdgcn_global_load_lds((const unsigned*)((const char*)(gbase) + (voff)[_i]), (PG8_LAS unsigned*)(lds + (bufoff) + ldsw + _i * 8192), 16, 0, 0); } while (0)
#define PG8_LDA(dst, b, h) do { _Pragma("unroll") for (int m = 0; m < 4; ++m) _Pragma("unroll") for (int k = 0; k < 2; ++k) dst[m][k] = *(const PG8_LAS bf16x8*)(lds + PG8_SA(b, h) + aoff + m * 2048 + k * 1024); } while (0)
#define PG8_LDB(dst, b, h) do { _Pragma("unroll") for (int n = 0; n < 2; ++n) _Pragma("unroll") for (int k = 0; k < 2; ++k) dst[n][k] = *(const PG8_LAS bf16x8*)(lds + PG8_SB(b, h) + boff + n * 2048 + k * 1024); } while (0)
#define PG8_MMA(ai, bj, At, Bt) do { __builtin_amdgcn_s_setprio(1); _Pragma("unroll") for (int m = 0; m < 4; ++m) _Pragma("unroll") for (int n = 0; n < 2; ++n) _Pragma("unroll") for (int k = 0; k < 2; ++k) \
        acc[ai][bj][m][n] = __builtin_amdgcn_mfma_f32_16x16x32_bf16(Bt[n][k], At[m][k], acc[ai][bj][m][n], 0, 0, 0); __builtin_amdgcn_s_setprio(0); } while (0)
#define PG8_WAIT_V(n) asm volatile("s_waitcnt vmcnt(" #n ")" ::: "memory")
#define PG8_WAIT_L(n) asm volatile("s_waitcnt lgkmcnt(" #n ")" ::: "memory")
#define PG8_BAR __builtin_amdgcn_s_barrier()
#define PG8_SCHED __builtin_amdgcn_sched_barrier(0)
    Unit cur, nxt; int ui = 0;
    if (!S.next(0, cur)) return;
    f32x4 acc[2][2][4][2];
#pragma unroll
    for (int a = 0; a < 2; ++a)
#pragma unroll
        for (int b = 0; b < 2; ++b)
#pragma unroll
            for (int m = 0; m < 4; ++m)
#pragma unroll
                for (int n = 0; n < 2; ++n) acc[a][b][m][n] = (f32x4){0.f, 0.f, 0.f, 0.f};
    bf16x8 At[4][2], B0[2][2], B1[2][2];
    const char* cA = (const char*)g.A + (size_t)cur.pm * tstep; const char* cB = (const char*)g.Bt + (size_t)cur.pn * tstep;
    S.a_ready(cur);
    if constexpr (SP2) {
        PG8_STAGE(PG8_SB(0, 0), cB, voffB); PG8_STAGE(PG8_SB(0, 1), cB + hstep, voffB); PG8_STAGE(PG8_SA(0, 0), cA, voffA); PG8_STAGE(PG8_SA(0, 1), cA + hstep, voffA);
        if (wr == 1) PG8_BAR;
        PG8_WAIT_V(2); PG8_BAR;
        PG8_STAGE(PG8_SB(1, 0), cB + kstep, voffB); PG8_STAGE(PG8_SA(1, 0), cA + kstep, voffA); PG8_STAGE(PG8_SB(1, 1), cB + hstep + kstep, voffB);
        PG8_WAIT_V(6); PG8_BAR;
    } else {
        PG8_STAGE(PG8_SB(0, 0), cB, voffB); PG8_STAGE(PG8_SA(0, 0), cA, voffA); PG8_STAGE(PG8_SB(0, 1), cB + hstep, voffB); PG8_STAGE(PG8_SA(0, 1), cA + hstep, voffA);
        if (wr == 1) PG8_BAR;
        PG8_WAIT_V(4); PG8_BAR;
        PG8_STAGE(PG8_SB(1, 0), cB + kstep, voffB); PG8_STAGE(PG8_SA(1, 0), cA + kstep, voffA); PG8_STAGE(PG8_SB(1, 1), cB + hstep + kstep, voffB);
        PG8_WAIT_V(6); PG8_BAR;
    }
    for (;;) {
        const bool has_next = S.next(ui + 1, nxt);
        const char* nA = has_next ? (const char*)g.A + (size_t)nxt.pm * tstep : cA; const char* nB = has_next ? (const char*)g.Bt + (size_t)nxt.pn * tstep : cB;
        for (int t = 0; t < nt; t += 2) {
            const bool last = (t == nt - 2);
            const char* a1 = cA + (size_t)(t + 1) * kstep;
            const char* a2 = last ? nA : cA + (size_t)(t + 2) * kstep; const char* b2 = last ? nB : cB + (size_t)(t + 2) * kstep;
            const char* a3 = a2 + kstep; const char* b3 = b2 + kstep;
            if (last && has_next) S.a_ready(nxt);
            if constexpr (SP2) {
            PG8_LDB(B0, 0, 0); PG8_LDB(B1, 0, 1); PG8_SCHED; PG8_LDA(At, 0, 0); PG8_STAGE(PG8_SA(1, 1), a1 + hstep, voffA);
            PG8_WAIT_V(8); PG8_WAIT_L(0); PG8_BAR; PG8_MMA(0, 0, At, B0); PG8_MMA(0, 1, At, B1); PG8_BAR; PG8_SCHED;
            PG8_LDA(At, 0, 1); PG8_STAGE(PG8_SB(0, 0), b2, voffB); PG8_STAGE(PG8_SB(0, 1), b2 + hstep, voffB); PG8_STAGE(PG8_SA(0, 0), a2, voffA);
            PG8_WAIT_V(8); PG8_WAIT_L(0); PG8_BAR; PG8_MMA(1, 0, At, B0); PG8_MMA(1, 1, At, B1); PG8_BAR; PG8_SCHED;
            PG8_LDB(B0, 1, 0); PG8_LDB(B1, 1, 1); PG8_SCHED; PG8_LDA(At, 1, 0); PG8_STAGE(PG8_SA(0, 1), a2 + hstep, voffA);
            PG8_WAIT_V(8); PG8_WAIT_L(0); PG8_BAR; PG8_MMA(0, 0, At, B0); PG8_MMA(0, 1, At, B1); PG8_BAR; PG8_SCHED;
            PG8_LDA(At, 1, 1); PG8_STAGE(PG8_SB(1, 0), b3, voffB); PG8_STAGE(PG8_SB(1, 1), b3 + hstep, voffB); PG8_STAGE(PG8_SA(1, 0), a3, voffA);
            PG8_WAIT_V(8); PG8_WAIT_L(0); PG8_BAR; PG8_MMA(1, 0, At, B0); PG8_MMA(1, 1, At, B1); PG8_BAR; PG8_SCHED;
            } else {
            PG8_LDB(B0, 0, 0); PG8_SCHED; PG8_LDA(At, 0, 0); PG8_STAGE(PG8_SA(1, 1), a1 + hstep, voffA);
            PG8_WAIT_L(8); PG8_BAR; PG8_WAIT_L(0); PG8_MMA(0, 0, At, B0); PG8_BAR; PG8_SCHED;
            PG8_LDB(B1, 0, 1); PG8_STAGE(PG8_SB(0, 0), b2, voffB);
            PG8_BAR; PG8_WAIT_L(0); PG8_MMA(0, 1, At, B1); PG8_BAR;
            PG8_LDA(At, 0, 1); PG8_STAGE(PG8_SA(0, 0), a2, voffA);
            PG8_BAR; PG8_WAIT_L(0); PG8_MMA(1, 0, At, B0); PG8_BAR; PG8_SCHED;
            PG8_STAGE(PG8_SB(0, 1), b2 + hstep, voffB);
            PG8_WAIT_V(6); PG8_BAR; PG8_MMA(1, 1, At, B1); PG8_BAR;
            PG8_LDB(B0, 1, 0); PG8_SCHED; PG8_LDA(At, 1, 0); PG8_STAGE(PG8_SA(0, 1), a2 + hstep, voffA);
            PG8_WAIT_L(8); PG8_BAR; PG8_WAIT_L(0); PG8_MMA(0, 0, At, B0); PG8_BAR; PG8_SCHED;
            PG8_LDB(B1, 1, 1); PG8_STAGE(PG8_SB(1, 0), b3, voffB);
            PG8_BAR; PG8_WAIT_L(0); PG8_MMA(0, 1, At, B1); PG8_BAR;
            PG8_LDA(At, 1, 1); PG8_STAGE(PG8_SA(1, 0), a3, voffA);
            PG8_BAR; PG8_WAIT_L(0); PG8_MMA(1, 0, At, B0); PG8_BAR; PG8_SCHED;
            PG8_STAGE(PG8_SB(1, 1), b3 + hstep, voffB);
            PG8_WAIT_V(6); PG8_BAR; PG8_MMA(1, 1, At, B1); PG8_BAR;
            }
        }
        if constexpr (ALIGN_EPI) { if (wr == 0) PG8_BAR; }
        if constexpr (!Epi::AFTER_DRAIN) { E(acc, cur, wr, wc, fr, fq); S.done(cur); }
        if (!has_next) break;
#pragma unroll
        for (int a = 0; a < 2; ++a)
#pragma unroll
            for (int b = 0; b < 2; ++b)
#pragma unroll
                for (int m = 0; m < 4; ++m)
#pragma unroll
                    for (int n = 0; n < 2; ++n) acc[a][b][m][n] = (f32x4){0.f, 0.f, 0.f, 0.f};
        cur = nxt; cA = nA; cB = nB; ++ui;
        if constexpr (ALIGN_EPI) { if (wr == 1) PG8_BAR; }
    }
    PG8_WAIT_V(0);
    if constexpr (!ALIGN_EPI) { if (wr == 0) PG8_BAR; }
    PG8_BAR;
    if constexpr (Epi::AFTER_DRAIN) { E.fused(acc, cur, wr, wc, fr, fq, lds, wid, lane); S.done(cur); }
#undef PG8_SA
#undef PG8_SB
#undef PG8_STAGE
#undef PG8_LDA
#undef PG8_LDB
#undef PG8_MMA
#undef PG8_WAIT_V
#undef PG8_WAIT_L
#undef PG8_BAR
#undef PG8_SCHED
}
}
#ifndef PG8_SP2
#define PG8_SP2 true
#endif
#ifndef PG8_ALIGN
#define PG8_ALIGN true
#endif
constexpr int RING_OFF = 0, RING_BYTES = 131072;
constexpr int LDSCTL_OFF = RING_BYTES, MISC_OFF = LDSCTL_OFF + 320;
constexpr int LDS_BYTES = 147456;
static_assert(MISC_OFF + 128 <= LDS_BYTES, "LDS map");

#define GAS __attribute__((address_space(1)))
#define LAS __attribute__((address_space(3)))
typedef unsigned short bf16;
typedef unsigned v4u __attribute__((ext_vector_type(4)));
typedef unsigned v2u __attribute__((ext_vector_type(2)));
typedef float f32x4 __attribute__((ext_vector_type(4)));
typedef float f32x2 __attribute__((ext_vector_type(2)));
typedef short bf16x8 __attribute__((ext_vector_type(8)));
typedef short bf16x4 __attribute__((ext_vector_type(4)));
typedef GAS unsigned gu32;
#define RLX_AGENT __ATOMIC_RELAXED, __HIP_MEMORY_SCOPE_AGENT
#define LDS_WAIT() asm volatile("s_waitcnt lgkmcnt(0)" ::: "memory")
#define VM_WAIT() asm volatile("s_waitcnt vmcnt(0)" ::: "memory")
__device__ __forceinline__ unsigned f2bf(float f) { unsigned u = __builtin_bit_cast(unsigned, f); return (u + 0x7fffu + ((u >> 16) & 1u)) >> 16; }
__device__ __forceinline__ unsigned pk2(float lo, float hi) { return f2bf(lo) | (f2bf(hi) << 16); }
__device__ __forceinline__ float bf2f(unsigned b) { return __builtin_bit_cast(float, b << 16); }
__device__ __forceinline__ float wave_sum(float v) {
#pragma unroll
    for (int o = 1; o < 64; o <<= 1) v += __shfl_xor(v, o);
    return v;
}
__device__ __forceinline__ float sigmoid_f(float x) { return __builtin_amdgcn_rcpf(1.0f + __expf(-x)); }
__device__ __forceinline__ float siluf_(float x) { return x * sigmoid_f(x); }
__device__ __forceinline__ float softplus_f(float x) { return x > 20.f ? x : log1pf(__expf(x)); }
__device__ __forceinline__ float gelu_tanh_f(float x) { const float t = 0.7978845608028654f * (x + 0.044715f * x * x * x); return x * sigmoid_f(2.0f * t); }
#define MFMA16(a, b, c) __builtin_amdgcn_mfma_f32_16x16x32_bf16((a), (b), (c), 0, 0, 0)

#define LDS_BAR() do { asm volatile("s_waitcnt lgkmcnt(0)" ::: "memory"); __builtin_amdgcn_s_barrier(); asm volatile("" ::: "memory"); } while (0)

#define XB_TMO      128
#define XB_XCNT(j)  (256  + 64 * (j))
#define XB_XSUB(j)  (1280 + 64 * (j))
#define XB_XGEN(j)  (2304 + 64 * (j))
#define XB_TOP      3328
#define XB_TOPGEN   3392
#define XCD_BAR_WORDS 3456
#define XB_SPIN_CAP (1u << 18)

__device__ __forceinline__ unsigned xb_ld(unsigned* p)              { return __hip_atomic_load(p, __ATOMIC_RELAXED, __HIP_MEMORY_SCOPE_AGENT); }
__device__ __forceinline__ unsigned xb_add(unsigned* p, unsigned v) { return __hip_atomic_fetch_add(p, v, __ATOMIC_RELAXED, __HIP_MEMORY_SCOPE_AGENT); }
__device__ __forceinline__ unsigned xb_xcc_id() { return (unsigned)__builtin_amdgcn_s_getreg((3 << 11) | 20) & 0xFu; }
#define XB_SPIN(cond, bar) do { unsigned _sp = 0; while (cond) { __builtin_amdgcn_s_sleep(1); \
    if ((++_sp & 255u) == 0u) { if (xb_ld(&(bar)[XB_TMO])) break; if (_sp > XB_SPIN_CAP) { atomicAdd(&(bar)[XB_TMO], 1u); break; } } } } while (0)

struct XcdBarrier {
    unsigned* bar; unsigned x;
    volatile LAS unsigned* st;
};

__device__ __forceinline__ XcdBarrier xcd_barrier_post(unsigned* bar, volatile LAS unsigned* st) {
    XcdBarrier b; b.bar = bar; b.x = xb_xcc_id(); b.st = st;
    if (threadIdx.x == 0) (void)xb_add(&bar[XB_XCNT(b.x)], 1u);
    return b;
}
__device__ __forceinline__ void xcd_barrier_complete(unsigned* bar, unsigned x, unsigned& nloc, unsigned& nx) {
    const unsigned G = gridDim.x * gridDim.y * gridDim.z;
    unsigned sum, cnt, mine, sp = 0u;
    for (;;) {
        sum = 0u; cnt = 0u; mine = 0u;
#pragma unroll
        for (unsigned j = 0; j < 16; ++j) { const unsigned c = xb_ld(&bar[XB_XCNT(j)]); sum += c; cnt += (c > 0u) ? 1u : 0u; mine = (j == x) ? c : mine; }
        if (sum == G) break;
        __builtin_amdgcn_s_sleep(1);
        if ((++sp & 255u) == 0u) { if (xb_ld(&bar[XB_TMO])) break; if (sp > XB_SPIN_CAP) { atomicAdd(&bar[XB_TMO], 1u); break; } }
    }
    nloc = mine > 0u ? mine : 1u; nx = cnt > 0u ? cnt : 1u;
}

__device__ __forceinline__ void xcd_barrier(const XcdBarrier& b) {
    asm volatile("s_waitcnt vmcnt(0)" ::: "memory");
    __syncthreads();
    if (threadIdx.x == 0) {
        unsigned* bar = b.bar;
        __builtin_amdgcn_s_waitcnt(0);
        unsigned nloc = b.st[0], nx = b.st[1];
        if (nloc == 0u) { xcd_barrier_complete(bar, b.x, nloc, nx); b.st[0] = nloc; b.st[1] = nx; }
        const unsigned old = xb_add(&bar[XB_XSUB(b.x)], 1u);
        const unsigned gen = old / nloc;
        if (old + 1u == (gen + 1u) * nloc) {
            __builtin_amdgcn_fence(__ATOMIC_RELEASE, "agent");
            asm volatile("s_waitcnt vmcnt(0)" ::: "memory");
            const unsigned og = xb_add(&bar[XB_TOP], 1u);
            const unsigned tg = og / nx;
            if (og + 1u == (tg + 1u) * nx) xb_add(&bar[XB_TOPGEN], 1u);
            else XB_SPIN(xb_ld(&bar[XB_TOPGEN]) == tg, bar);
            __builtin_amdgcn_fence(__ATOMIC_ACQUIRE, "agent");
            xb_add(&bar[XB_XGEN(b.x)], 1u);
            asm volatile("s_waitcnt vmcnt(0)" ::: "memory");
        } else {
            XB_SPIN(xb_ld(&bar[XB_XGEN(b.x)]) == gen, bar);
            __builtin_amdgcn_fence(__ATOMIC_ACQUIRE, "agent");
            asm volatile("s_waitcnt vmcnt(0)" ::: "memory");
        }
    }
    __syncthreads();
}
struct Args { const float* in[41]; float* out; unsigned char* ws; int ph_lo, ph_hi; };
struct Frame {
    LAS unsigned char* lds;
    volatile LAS unsigned* MISC;
    gu32* ctl;
    int tid, lane, wave;
    int vcu, G;
    float* out;
    unsigned char* ws;
};
#define WSP(T, off) ((T*)(F.ws + (off)))
#define INP(i) (A.in[(i)])

__device__ __forceinline__ void p0_transpose_item(const float* W, int N, bf16* WT, int ldt, int kdst, int dst_row0, const float* gain, LAS float* scr, int k0, int n0, int lane) {
    const int rs = lane >> 3, c4 = (lane & 7) * 4; f32x4 v[8]; float gn[8];
    const GAS float* src = (const GAS float*)W + (size_t)(k0 + rs) * N + n0 + c4;
#pragma unroll
    for (int i = 0; i < 8; ++i) { v[i] = *(const GAS f32x4*)(src + (size_t)(8 * i) * N); gn[i] = gain ? gain[k0 + 8 * i + rs] : 1.0f; }
#pragma unroll
    for (int i = 0; i < 8; ++i) { LAS float* d = scr + (8 * i + rs) * 33 + c4; d[0] = v[i].x * gn[i]; d[1] = v[i].y * gn[i]; d[2] = v[i].z * gn[i]; d[3] = v[i].w * gn[i]; }
    LDS_WAIT(); asm volatile("" ::: "memory");
    const int c = lane & 7;
#pragma unroll
    for (int j = 0; j < 4; ++j) { const int n = (lane >> 3) + 8 * j; const LAS float* s = scr + (8 * c) * 33 + n;
        v4u o; o.x = pk2(s[0 * 33], s[1 * 33]); o.y = pk2(s[2 * 33], s[3 * 33]); o.z = pk2(s[4 * 33], s[5 * 33]); o.w = pk2(s[6 * 33], s[7 * 33]);
        *(GAS v4u*)(WT + (size_t)(dst_row0 + n) * ldt + kdst + k0 + 8 * c) = o; }
    LDS_WAIT(); asm volatile("" ::: "memory");
}
__device__ __forceinline__ void p0_tr(const float* W, int K, int N, bf16* WT, int ldt, int kdst, int row_base, int mode  , const float* gain, LAS float* scr, int item, int lane) {
    const int nblk = N / 32, kb = item / nblk, nb = item % nblk, k0 = 64 * kb, n0 = 32 * nb; (void)K;
    const int dr = mode == 0 ? row_base + n0 : (n0 / 128) * 256 + (n0 % 128) + (mode == 2 ? 128 : 0);
    p0_transpose_item(W, N, WT, ldt, kdst, dr, gain, scr, k0, n0, lane);
}
__device__ __forceinline__ void row_to_bf16_ssq(const float* xrow, bf16* orow, float* ssq32, int lane) {
    const GAS f32x4* xr = (const GAS f32x4*)xrow + lane; GAS v2u* o8 = (GAS v2u*)orow + lane; float s = 0.f;
#pragma unroll
    for (int j = 0; j < 8; ++j) { const f32x4 v = xr[64 * j]; s += (v.x * v.x + v.y * v.y) + (v.z * v.z + v.w * v.w); v2u w; w.x = pk2(v.x, v.y); w.y = pk2(v.z, v.w); o8[64 * j] = w; }
    s = wave_sum(s);
    if (lane < 32) ssq32[lane] = lane == 0 ? s : 0.f;
}
template <int SET> __device__ __forceinline__ void convert_weights(Frame& F, const Args& A, int gw, int NGW) {
    LAS float* scr = (LAS float*)(F.lds + RING_OFF + F.wave * 16384);
    constexpr int I_GU = (D / 64) * (FF / 32), I_DN = (FF / 64) * (D / 32), I_IN = (D / 64) * (DIN / 32), I_SQ = (D / 64) * (D / 32), I_L = 16 * 8;
    constexpr int NITEMS = SET == 0 ? 2 * I_GU + I_DN + I_IN + 2 * I_SQ + 2 * I_L : (SET == 1 ? 2 * I_SQ : (SET == 2 ? 2 * I_SQ + 2 * I_GU : I_DN));
    for (int it = gw; it < NITEMS; it += NGW) {
        int r = it;
        if (SET == 0) {
            if (r < I_GU) { p0_tr(INP(I_F1WG), D, FF, WSP(bf16, WS_W1GU), D, 0, 0, 1, INP(I_F1G), scr, r, F.lane); continue; } r -= I_GU;
            if (r < I_GU) { p0_tr(INP(I_F1WU), D, FF, WSP(bf16, WS_W1GU), D, 0, 0, 2, INP(I_F1G), scr, r, F.lane); continue; } r -= I_GU;
            if (r < I_DN) { p0_tr(INP(I_F1WD), FF, D, WSP(bf16, WS_W1D), FF, 0, 0, 0, nullptr, scr, r, F.lane); continue; } r -= I_DN;
            if (r < I_IN) { p0_tr(INP(I_WIN), D, DIN, WSP(bf16, WS_WIN), D, 0, 0, 0, INP(I_MIXG), scr, r, F.lane); continue; } r -= I_IN;
            if (r < I_SQ) { p0_tr(INP(I_WK), D, D, WSP(bf16, WS_WKV), D, 0, 0, 0, INP(I_MEMG), scr, r, F.lane); continue; } r -= I_SQ;
            if (r < I_SQ) { p0_tr(INP(I_WV), D, D, WSP(bf16, WS_WKV), D, 0, D, 0, INP(I_MEMG), scr, r, F.lane); continue; } r -= I_SQ;
            if (r < I_L) { const int h = r >> 3; p0_tr(INP(I_LWA) + (size_t)h * 16384, 128, 128, WSP(bf16, WS_WL), 128, 0, h * 256, 0, nullptr, scr, r & 7, F.lane); continue; } r -= I_L;
            { const int h = r >> 3; p0_tr(INP(I_LWX) + (size_t)h * 16384, 128, 128, WSP(bf16, WS_WL), 128, 0, h * 256 + 128, 0, nullptr, scr, r & 7, F.lane); }
        } else if (SET == 1) {
            if (r < I_SQ) { p0_tr(INP(I_WOUT), D, D, WSP(bf16, WS_WOUT), DMIX, 0, 0, 0, INP(I_LOG), scr, r, F.lane); continue; } r -= I_SQ;
            p0_tr(INP(I_WOUT) + (size_t)D * D, D, D, WSP(bf16, WS_WOUT), DMIX, D, 0, 0, INP(I_SOG), scr, r, F.lane);
        } else if (SET == 2) {
            if (r < I_SQ) { p0_tr(INP(I_WQ), D, D, WSP(bf16, WS_WQ), D, 0, 0, 0, INP(I_XAG), scr, r, F.lane); continue; } r -= I_SQ;
            if (r < I_SQ) { p0_tr(INP(I_WO), D, D, WSP(bf16, WS_WO), D, 0, 0, 0, nullptr, scr, r, F.lane); continue; } r -= I_SQ;
            if (r < I_GU) { p0_tr(INP(I_F2WG), D, FF, WSP(bf16, WS_W2GU), D, 0, 0, 1, INP(I_F2G), scr, r, F.lane); continue; } r -= I_GU;
            p0_tr(INP(I_F2WU), D, FF, WSP(bf16, WS_W2GU), D, 0, 0, 2, INP(I_F2G), scr, r, F.lane);
        } else {
            p0_tr(INP(I_F2WD), FF, D, WSP(bf16, WS_W2D), FF, 0, 0, 0, nullptr, scr, r, F.lane);
        }
    }
}
__device__ __forceinline__ void p0_prologue(Frame& F, const Args& A) {
    const int gw = F.vcu * NWAVES + F.wave, NGW = F.G * NWAVES;
    convert_weights<0>(F, A, gw, NGW);
    for (int m = gw; m < M; m += NGW) { const float* src = m < MP ? INP(I_XP) + (size_t)m * D : INP(I_XS) + (size_t)(m - MP) * D;
        row_to_bf16_ssq(src, WSP(bf16, WS_XBA) + (size_t)m * D, WSP(float, WS_SSQ) + (size_t)m * NSSQ, F.lane); }
    for (int m = gw; m < MMEM; m += NGW) row_to_bf16_ssq(INP(I_MEMP) + (size_t)m * D, WSP(bf16, WS_MEMB) + (size_t)m * D, WSP(float, WS_SSQM) + (size_t)m * NSSQ, F.lane);
    { GAS v4u* z = (GAS v4u*)(WSP(bf16, WS_WIN) + (size_t)DIN * D); const int nz = (DINP - DIN) * D * 2 / 16;
      for (int i = gw * 64 + F.lane; i < nz; i += NGW * 64) z[i] = (v4u){0u, 0u, 0u, 0u}; }
}

__device__ __forceinline__ void p5_normalize(Frame& F, const Args& A, int m0, int m1, int q0, int q1, int gw, int NGW) {
    const int lane = F.lane;
    bf16* V = WSP(bf16, WS_V); const float* SQ = WSP(float, WS_SQV);
    for (int m = m0 + gw; m < m1; m += NGW) {
        const float* sq = SQ + (size_t)m * NSQV;
        const float pl = lane < 32 ? sq[lane] : 0.f, p0 = sq[32 + lane], p1 = sq[96 + lane];
        const float rl = __builtin_amdgcn_rsqf(wave_sum(pl) * (1.0f / 2048.0f) + EPS), r0 = __builtin_amdgcn_rsqf(wave_sum(p0) * (1.0f / 1024.0f) + EPS), r1 = __builtin_amdgcn_rsqf(wave_sum(p1) * (1.0f / 1024.0f) + EPS);
        GAS v4u* row = (GAS v4u*)(V + (size_t)m * DMIX) + lane;
#pragma unroll
        for (int i = 0; i < 8; ++i) { const float rs = i < 4 ? rl : (i < 6 ? r0 : r1); v4u w = row[64 * i];
            w.x = pk2(bf2f(w.x & 0xffffu) * rs, bf2f(w.x >> 16) * rs); w.y = pk2(bf2f(w.y & 0xffffu) * rs, bf2f(w.y >> 16) * rs);
            w.z = pk2(bf2f(w.z & 0xffffu) * rs, bf2f(w.z >> 16) * rs); w.w = pk2(bf2f(w.w & 0xffffu) * rs, bf2f(w.w >> 16) * rs); row[64 * i] = w; }
    }
    const float* P = WSP(float, WS_PROJ);
    for (int it = q0 * 3 + gw; it < q1 * 3; it += NGW) { const int sq = it / 3, k = it % 3;
        const int row = sq < NBP ? sq * TP + TP - 3 + k : MP + (sq - NBP) * TS + TS - 3 + k;
        float* lc = sq < NBP ? F.out + O_PLC + (size_t)(sq * 3 + k) * D : F.out + O_SLC + (size_t)((sq - NBP) * 3 + k) * D;
        float* sc = sq < NBP ? F.out + O_PSC + (size_t)(sq * 3 + k) * XBC : F.out + O_SSC + (size_t)((sq - NBP) * 3 + k) * XBC;
        const float* src = P + (size_t)row * DINP;
        for (int c = lane * 4; c < D; c += 256) *(GAS f32x4*)(lc + c) = *(const GAS f32x4*)(src + C_XL + c);
        for (int c = lane * 4; c < XBC; c += 256) *(GAS f32x4*)(sc + c) = *(const GAS f32x4*)(src + C_XBC + c);
    }
}
__device__ __forceinline__ void p12_final(Frame& F, const Args& A, int m0, int m1) {
    const int gw = F.vcu * NWAVES + F.wave, NGW = F.G * NWAVES, lane = F.lane;
    const float* XR = WSP(float, WS_XR); const float* SSQ = WSP(float, WS_SSQ) + (size_t)4 * M * NSSQ; const float* g = INP(I_FING);
    for (int m = m0 + gw; m < m1; m += NGW) {
        const float p = lane < 32 ? SSQ[(size_t)m * NSSQ + lane] : 0.f; const float rs = __builtin_amdgcn_rsqf(wave_sum(p) * (1.0f / 2048.0f) + EPS);
        const GAS f32x4* xr = (const GAS f32x4*)(XR + (size_t)m * D) + lane; const GAS f32x4* gg = (const GAS f32x4*)g + lane; GAS f32x4* o = (GAS f32x4*)(F.out + O_Y + (size_t)m * D) + lane;
#pragma unroll
        for (int j = 0; j < 8; ++j) o[64 * j] = xr[64 * j] * rs * gg[64 * j];
    }
}

__device__ __forceinline__ void p3b_bcconv(Frame& F, const Args& A) {
    const float* P = WSP(float, WS_PROJ); bf16* BCC = WSP(bf16, WS_BCC);
    const int q = F.tid & 127, rsub = F.tid >> 7;
    const int xc = 2048 + 4 * q;
    f32x4 w[4];
#pragma unroll
    for (int k = 0; k < 4; ++k) w[k] = *(const GAS f32x4*)(INP(I_SCW) + (size_t)k * XBC + xc);
    const f32x4 bb = *(const GAS f32x4*)(INP(I_SCB) + xc);
    for (int r0 = blockIdx.x * 4; r0 < MP; r0 += F.G * 4) { const int R = r0 + rsub, t = R & (TP - 1);
        const GAS float* src = (const GAS float*)P + (size_t)R * DINP + C_XBC + xc; f32x4 v = bb;
#pragma unroll
        for (int k = 0; k < 4; ++k) { if (t - 3 + k >= 0) v = v + w[k] * *(const GAS f32x4*)(src - (ptrdiff_t)(3 - k) * DINP); }
        v2u o; o.x = pk2(siluf_(v[0]), siluf_(v[1])); o.y = pk2(siluf_(v[2]), siluf_(v[3]));
        *(GAS v2u*)(BCC + (size_t)R * 512 + 4 * q) = o; }
}

__device__ __forceinline__ bf16x8 pack8(const f32x4 a, const f32x4 b) { v4u w; w.x = pg8::cvt_pk_bf16(a[0], a[1]); w.y = pg8::cvt_pk_bf16(a[2], a[3]); w.z = pg8::cvt_pk_bf16(b[0], b[1]); w.w = pg8::cvt_pk_bf16(b[2], b[3]); return __builtin_bit_cast(bf16x8, w); }
#define SCHED_FENCE() __builtin_amdgcn_sched_barrier(0)
__device__ __forceinline__ void attn_prompt_item(Frame& F, const Args& A, int b, int h, int qt) {
    const int lane = F.lane, c16 = lane & 15, g = lane >> 4;
    const int R = b * TP + qt * 16 + c16;
    const bf16* Q = WSP(bf16, WS_Q) + (size_t)R * D + h * 512;
    bf16x8 qf[16];
#pragma unroll
    for (int ks = 0; ks < 16; ++ks) qf[ks] = *(const GAS bf16x8*)(Q + ks * 32 + 8 * g);
    const GAS char* kb = (const GAS char*)(WSP(bf16, WS_KM) + (size_t)(b * NMEM) * D + h * 512); const unsigned ko = (unsigned)(c16 * D + 8 * g) * 2u;
    f32x4 s[16]; bf16x8 kbuf[2][8];
#define KLOAD(step_) do { const int kt_ = (step_) >> 1, hf_ = (step_) & 1; _Pragma("unroll") for (int i = 0; i < 8; ++i) kbuf[(step_) & 1][i] = *(const GAS bf16x8*)(kb + (size_t)kt_ * 16 * D * 2 + ko + (hf_ * 8 + i) * 64); } while (0)
    KLOAD(0);
#pragma unroll
    for (int step = 0; step < 32; ++step) { const int kt = step >> 1, hf = step & 1;
        if (step + 1 < 32) KLOAD(step + 1);
        SCHED_FENCE();
        if (hf == 0) s[kt] = (f32x4){0.f, 0.f, 0.f, 0.f};
#pragma unroll
        for (int i = 0; i < 8; ++i) s[kt] = MFMA16(kbuf[step & 1][i], qf[hf * 8 + i], s[kt]);
        SCHED_FENCE(); }
#undef KLOAD
    const GAS char* vb = (const GAS char*)(WSP(bf16, WS_VT) + (size_t)(b * D + h * 512) * NMEM); const unsigned vo = (unsigned)(c16 * NMEM + 4 * g) * 2u;
    v2u vbuf[2][16];
#define VLOAD(dt_) do { _Pragma("unroll") for (int kk = 0; kk < 8; ++kk) { vbuf[(dt_) & 1][2 * kk] = *(const GAS v2u*)(vb + (size_t)(dt_) * 16 * NMEM * 2 + vo + kk * 64); vbuf[(dt_) & 1][2 * kk + 1] = *(const GAS v2u*)(vb + (size_t)(dt_) * 16 * NMEM * 2 + vo + kk * 64 + 32); } } while (0)
    VLOAD(0);
    float mx = -3.0e38f;
#pragma unroll
    for (int kt = 0; kt < 16; ++kt) mx = fmaxf(mx, fmaxf(fmaxf(s[kt][0], s[kt][1]), fmaxf(s[kt][2], s[kt][3])));
    mx = fmaxf(mx, __shfl_xor(mx, 16)); mx = fmaxf(mx, __shfl_xor(mx, 32));
    float sum = 0.f;
#pragma unroll
    for (int kt = 0; kt < 16; ++kt) {
#pragma unroll
        for (int j = 0; j < 4; ++j) { const float e = __expf(s[kt][j] - mx); s[kt][j] = e; sum += e; } }
    sum += __shfl_xor(sum, 16); sum += __shfl_xor(sum, 32);
    const float inv = 1.0f / sum;
    bf16x8 pf[8];
#pragma unroll
    for (int kk = 0; kk < 8; ++kk) pf[kk] = pack8(s[2 * kk], s[2 * kk + 1]);
    bf16* O = WSP(bf16, WS_O) + (size_t)R * D + h * 512 + 4 * g;
#pragma unroll
    for (int dt = 0; dt < 32; ++dt) { f32x4 o = (f32x4){0.f, 0.f, 0.f, 0.f};
        if (dt + 1 < 32) VLOAD(dt + 1);
        SCHED_FENCE();
#pragma unroll
        for (int kk = 0; kk < 8; ++kk) { v4u w; w.x = vbuf[dt & 1][2 * kk].x; w.y = vbuf[dt & 1][2 * kk].y; w.z = vbuf[dt & 1][2 * kk + 1].x; w.w = vbuf[dt & 1][2 * kk + 1].y; o = MFMA16(__builtin_bit_cast(bf16x8, w), pf[kk], o); }
        o = o * inv;
        { v2u w; w.x = pg8::cvt_pk_bf16(o[0], o[1]); w.y = pg8::cvt_pk_bf16(o[2], o[3]); *(GAS v2u*)(O + dt * 16) = w; }
        SCHED_FENCE(); }
#undef VLOAD
}
constexpr int AT_ML = 0, AT_PF = 1024;
__device__ __forceinline__ void attn_sample_wg(Frame& F, const Args& A, int b, int h) {
    const int lane = F.lane, w = F.wave, c16 = lane & 15, g = lane >> 4;
    LAS float* ML = (LAS float*)(F.lds + AT_ML); LAS v4u* PF = (LAS v4u*)(F.lds + AT_PF);
    const int R = MP + b * TS + (c16 & 7); const bool qvalid = c16 < 8;
    const bf16* Q = WSP(bf16, WS_Q) + (size_t)R * D + h * 512;
    bf16x8 qf[16];
#pragma unroll
    for (int ks = 0; ks < 16; ++ks) qf[ks] = *(const GAS bf16x8*)(Q + ks * 32 + 8 * g);
    const GAS char* kb = (const GAS char*)(INP(I_CK) + (size_t)(b * NMEM + 32 * w) * D + h * 512); const unsigned ko = (unsigned)(c16 * D + 8 * g) * 4u;
    f32x4 s[2]; f32x4 kbuf[2][16];
#define KLOAD(step_) do { const int t_ = (step_) >> 1, hf_ = (step_) & 1; _Pragma("unroll") for (int i = 0; i < 8; ++i) { \
        kbuf[(step_) & 1][2 * i] = *(const GAS f32x4*)(kb + (size_t)t_ * 16 * D * 4 + ko + (hf_ * 8 + i) * 128); kbuf[(step_) & 1][2 * i + 1] = *(const GAS f32x4*)(kb + (size_t)t_ * 16 * D * 4 + ko + (hf_ * 8 + i) * 128 + 16); } } while (0)
    KLOAD(0);
#pragma unroll
    for (int step = 0; step < 4; ++step) { const int t = step >> 1, hf = step & 1;
        if (step + 1 < 4) KLOAD(step + 1);
        SCHED_FENCE();
        if (hf == 0) s[t] = (f32x4){0.f, 0.f, 0.f, 0.f};
#pragma unroll
        for (int i = 0; i < 8; ++i) s[t] = MFMA16(pack8(kbuf[step & 1][2 * i], kbuf[step & 1][2 * i + 1]), qf[hf * 8 + i], s[t]);
        SCHED_FENCE(); }
#undef KLOAD
    const GAS char* vb = (const GAS char*)(INP(I_CV) + (size_t)(b * NMEM) * D + h * 512); const unsigned vo2 = (unsigned)(4 * g * D + c16) * 4u;
    float vbuf[2][64];
#define VLOAD(i_) do { const int dt_ = 4 * w + (i_); _Pragma("unroll") for (int kk = 0; kk < 8; ++kk) { const GAS char* v0 = vb + (size_t)(kk * 32) * D * 4 + dt_ * 64 + vo2; \
        _Pragma("unroll") for (int j = 0; j < 4; ++j) { vbuf[(i_) & 1][kk * 8 + j] = *(const GAS float*)(v0 + (size_t)j * D * 4); vbuf[(i_) & 1][kk * 8 + 4 + j] = *(const GAS float*)(v0 + (size_t)(16 + j) * D * 4); } } } while (0)
    VLOAD(0);
    float mx = fmaxf(fmaxf(fmaxf(s[0][0], s[0][1]), fmaxf(s[0][2], s[0][3])), fmaxf(fmaxf(s[1][0], s[1][1]), fmaxf(s[1][2], s[1][3])));
    mx = fmaxf(mx, __shfl_xor(mx, 16)); mx = fmaxf(mx, __shfl_xor(mx, 32));
    float sum = 0.f;
#pragma unroll
    for (int t = 0; t < 2; ++t)
#pragma unroll
        for (int j = 0; j < 4; ++j) { const float e = __expf(s[t][j] - mx); s[t][j] = e; sum += e; }
    sum += __shfl_xor(sum, 16); sum += __shfl_xor(sum, 32);
    if (g == 0) { ML[(w * 16 + c16) * 2] = mx; ML[(w * 16 + c16) * 2 + 1] = sum; }
    LDS_BAR();
    float gm = -3.0e38f;
#pragma unroll
    for (int ww = 0; ww < 8; ++ww) gm = fmaxf(gm, ML[(ww * 16 + c16) * 2]);
    float tot = 0.f;
#pragma unroll
    for (int ww = 0; ww < 8; ++ww) tot += ML[(ww * 16 + c16) * 2 + 1] * __expf(ML[(ww * 16 + c16) * 2] - gm);
    const float f = __expf(mx - gm), inv = 1.0f / tot;
    { const bf16x8 pk = pack8(s[0] * f, s[1] * f); PF[w * 64 + lane] = __builtin_bit_cast(v4u, pk); }
    LDS_BAR();
    bf16x8 pf[8];
#pragma unroll
    for (int kk = 0; kk < 8; ++kk) pf[kk] = __builtin_bit_cast(bf16x8, PF[kk * 64 + lane]);
    bf16* O = WSP(bf16, WS_O) + (size_t)R * D + h * 512 + 4 * g;
#pragma unroll
    for (int i = 0; i < 4; ++i) { const int dt = 4 * w + i; f32x4 o = (f32x4){0.f, 0.f, 0.f, 0.f};
        if (i + 1 < 4) VLOAD(i + 1);
        SCHED_FENCE();
#pragma unroll
        for (int kk = 0; kk < 8; ++kk) { const float* vv = &vbuf[i & 1][kk * 8]; o = MFMA16(pack8((f32x4){vv[0], vv[1], vv[2], vv[3]}, (f32x4){vv[4], vv[5], vv[6], vv[7]}), pf[kk], o); }
        o = o * inv;
        if (qvalid) { v2u wv; wv.x = pg8::cvt_pk_bf16(o[0], o[1]); wv.y = pg8::cvt_pk_bf16(o[2], o[3]); *(GAS v2u*)(O + dt * 16) = wv; }
        SCHED_FENCE(); }
#undef VLOAD
    LDS_BAR();
}
__device__ __forceinline__ void p8_attn_sample(Frame& F, const Args& A) {
    for (int it = blockIdx.x; it < NBS * 4; it += F.G) attn_sample_wg(F, A, it >> 2, it & 3);
}
constexpr int AP_BUF = 33792, AP_KP = 1040, AP_VP = 528;
__device__ __forceinline__ void attn_prompt_wg(Frame& F, const Args& A, int b, int h, int qb) {
    const int tid = F.tid, lane = F.lane, w = F.wave, c16 = lane & 15, g = lane >> 4;
    LAS unsigned char* L0 = F.lds;
    const int R = b * TP + qb * 128 + w * 16 + c16;
    const bf16* Q = WSP(bf16, WS_Q) + (size_t)R * D + h * 512;
    bf16x8 qf[16];
#pragma unroll
    for (int ks = 0; ks < 16; ++ks) qf[ks] = *(const GAS bf16x8*)(Q + ks * 32 + 8 * g);
    const int kkey = tid >> 4, kseg = tid & 15;
    const GAS char* kg = (const GAS char*)(WSP(bf16, WS_KM) + (size_t)(b * NMEM) * D + h * 512) + (size_t)kkey * D * 2 + kseg * 64;
    const unsigned kl = (unsigned)(kkey * AP_KP + kseg * 64);
    v4u st[4];
#define AP_LOAD(src_) do { _Pragma("unroll") for (int j = 0; j < 4; ++j) st[j] = *(const GAS v4u*)((src_) + j * 16); } while (0)
#define AP_STORE(buf_, off_) do { _Pragma("unroll") for (int j = 0; j < 4; ++j) *(LAS v4u*)(L0 + (buf_) * AP_BUF + (off_) + j * 16) = st[j]; } while (0)
    AP_LOAD(kg); AP_STORE(0, kl); LDS_BAR();
    f32x4 s[16];
#pragma unroll
    for (int t = 0; t < 8; ++t) {
        if (t + 1 < 8) AP_LOAD(kg + (size_t)(t + 1) * 32 * D * 2);
        SCHED_FENCE();
#pragma unroll
        for (int tt = 0; tt < 2; ++tt) { const int kt = 2 * t + tt; s[kt] = (f32x4){0.f, 0.f, 0.f, 0.f};
#pragma unroll
            for (int ks = 0; ks < 16; ++ks) { const bf16x8 kf = *(const LAS bf16x8*)(L0 + (t & 1) * AP_BUF + (16 * tt + c16) * AP_KP + ks * 64 + g * 16); s[kt] = MFMA16(kf, qf[ks], s[kt]); } }
        SCHED_FENCE();
        if (t + 1 < 8) AP_STORE((t + 1) & 1, kl);
        LDS_BAR(); }
    const int vrow = tid >> 3, vseg = tid & 7;
    const GAS char* vg = (const GAS char*)(WSP(bf16, WS_VT) + (size_t)(b * D + h * 512) * NMEM) + (size_t)vrow * NMEM * 2 + vseg * 64;
    const unsigned vl = (unsigned)(vrow * AP_VP + vseg * 64);
    AP_LOAD(vg);
    float mx = -3.0e38f;
#pragma unroll
    for (int kt = 0; kt < 16; ++kt) mx = fmaxf(mx, fmaxf(fmaxf(s[kt][0], s[kt][1]), fmaxf(s[kt][2], s[kt][3])));
    mx = fmaxf(mx, __shfl_xor(mx, 16)); mx = fmaxf(mx, __shfl_xor(mx, 32));
    float sum = 0.f;
#pragma unroll
    for (int kt = 0; kt < 16; ++kt) {
#pragma unroll
        for (int j = 0; j < 4; ++j) { const float e = __expf(s[kt][j] - mx); s[kt][j] = e; sum += e; } }
    sum += __shfl_xor(sum, 16); sum += __shfl_xor(sum, 32);
    const float inv = 1.0f / sum;
    bf16x8 pf[8];
#pragma unroll
    for (int kk = 0; kk < 8; ++kk) pf[kk] = pack8(s[2 * kk], s[2 * kk + 1]);
    AP_STORE(0, vl); LDS_BAR();
    bf16* O = WSP(bf16, WS_O) + (size_t)R * D + h * 512 + 4 * g;
#pragma unroll
    for (int u = 0; u < 8; ++u) {
        if (u + 1 < 8) AP_LOAD(vg + (size_t)(u + 1) * 64 * NMEM * 2);
        SCHED_FENCE();
#pragma unroll
        for (int i = 0; i < 4; ++i) { f32x4 o = (f32x4){0.f, 0.f, 0.f, 0.f};
#pragma unroll
            for (int kk = 0; kk < 8; ++kk) { const LAS unsigned char* vp = L0 + (u & 1) * AP_BUF + (16 * i + c16) * AP_VP + kk * 64 + g * 8; const v2u lo = *(const LAS v2u*)vp, hi = *(const LAS v2u*)(vp + 32);
                v4u wv; wv.x = lo.x; wv.y = lo.y; wv.z = hi.x; wv.w = hi.y; o = MFMA16(__builtin_bit_cast(bf16x8, wv), pf[kk], o); }
            o = o * inv;
            { v2u wv; wv.x = pg8::cvt_pk_bf16(o[0], o[1]); wv.y = pg8::cvt_pk_bf16(o[2], o[3]); *(GAS v2u*)(O + (4 * u + i) * 16) = wv; } }
        SCHED_FENCE();
        if (u + 1 < 8) AP_STORE((u + 1) & 1, vl);
        LDS_BAR(); }
#undef AP_LOAD
#undef AP_STORE
}
__device__ __forceinline__ void p8_attn_prompt(Frame& F, const Args& A, int rank, int ngrp) {
    if (rank < 0) return;
    for (int it = rank; it < NBP * 4 * (TP / 128); it += ngrp) attn_prompt_wg(F, A, it >> 6, (it >> 4) & 3, it & 15);
}

__device__ __forceinline__ float conv4(const float* cur, int t, const float* st, int sp, float w0, float w1, float w2, float w3, float bias) {
    const float x3 = cur[0];
    const float x2 = t >= 1 ? cur[-(ptrdiff_t)DINP] : (st ? st[2 * sp] : 0.f);
    const float x1 = t >= 2 ? cur[-(ptrdiff_t)2 * DINP] : (st ? st[(t + 1) * sp] : 0.f);
    const float x0 = t >= 3 ? cur[-(ptrdiff_t)3 * DINP] : (st ? st[t * sp] : 0.f);
    return bias + w0 * x0 + w1 * x1 + w2 * x2 + w3 * x3;
}
constexpr int LR_U32 = 0, LR_UB = 32768, LR_UBP = 136, LR_A32 = 50176, LR_B32 = 66560, LR_SEG = 82944, LR_CAR = 85504;
#define LDG_F32(base_, voff_) (*(const GAS float*)((const GAS char*)(base_) + (voff_)))
template <bool SAMPLE>
__device__ __forceinline__ void lru_item(Frame& F, const Args& A, int sidx, int h, int half) {
    LAS float* U32 = (LAS float*)(F.lds + LR_U32); LAS bf16* UB = (LAS bf16*)(F.lds + LR_UB); LAS float* A32 = (LAS float*)(F.lds + LR_A32); LAS float* B32 = (LAS float*)(F.lds + LR_B32);
    LAS float* SEG = (LAS float*)(F.lds + LR_SEG); LAS float* CAR = (LAS float*)(F.lds + LR_CAR);
    const int tid = F.tid, lane = F.lane, w = F.wave, c16 = lane & 15, g = lane >> 4;
    const float* P = WSP(float, WS_PROJ);
    const bf16* WL = WSP(bf16, WS_WL) + (size_t)h * 256 * 128;
    const int nt = w & 3, mt0 = 2 * (w >> 2), hcol0 = 64 * half + 16 * nt;
    bf16x8 ba[4], bx[4];
#pragma unroll
    for (int ks = 0; ks < 4; ++ks) { ba[ks] = *(const GAS bf16x8*)(WL + (size_t)(hcol0 + c16) * 128 + ks * 32 + 8 * g); bx[ks] = *(const GAS bf16x8*)(WL + (size_t)(128 + hcol0 + c16) * 128 + ks * 32 + 8 * g); }
    const int mch = h * 128 + hcol0 + c16;
    const float b_a = INP(I_LBA)[mch], b_x = INP(I_LBX)[mch], cl = -8.0f * softplus_f(-INP(I_LLAM)[mch]);
    const int tq = w >> 1, cc = (w & 1) * 64 + lane, ch = h * 128 + cc;
    const unsigned voffx = (unsigned)(C_XL + ch) * 4u, voffg = (unsigned)(C_GL + h * 128 + 64 * half + lane) * 4u;
    const float cw0 = INP(I_LCW)[ch], cw1 = INP(I_LCW)[D + ch], cw2 = INP(I_LCW)[2 * D + ch], cw3 = INP(I_LCW)[3 * D + ch], cb = INP(I_LCB)[ch];
    const int nchunk = SAMPLE ? 1 : TP / 64;
    if (tid < 64) CAR[tid] = 0.f;
    float raw[2][22];
#define LRU_ISSUE(chunk_, st_) do { \
        if (SAMPLE) { \
            _Pragma("unroll") for (int q = 0; q < 2; ++q) { const int sq_ = sidx * 8 + tq * 2 + q; \
                _Pragma("unroll") for (int k = 0; k < 3; ++k) raw[st_][q * 11 + k] = LDG_F32(INP(I_SLC) + (size_t)(sq_ * 3 + k) * D, (unsigned)ch * 4u); \
                _Pragma("unroll") for (int t = 0; t < 8; ++t) raw[st_][q * 11 + 3 + t] = LDG_F32(P + (size_t)(MP + sq_ * 8 + t) * DINP, voffx); } \
        } else { \
            const int R0_ = sidx * TP + (chunk_) * 64 + tq * 16; \
            _Pragma("unroll") for (int i = 0; i < 19; ++i) { const bool ok = ((chunk_) > 0 || tq > 0 || i >= 3); raw[st_][i] = ok ? LDG_F32(P + (size_t)(R0_ - 3 + i) * DINP, voffx) : 0.f; } \
        } } while (0)
    LRU_ISSUE(0, 0);
    float ggn[8];
    { const int R0f = SAMPLE ? MP + sidx * 64 : sidx * TP;
#pragma unroll
      for (int i = 0; i < 8; ++i) ggn[i] = LDG_F32(P + (size_t)(R0f + 8 * w + i) * DINP, voffg); }
#pragma unroll 2
    for (int chunk = 0; chunk < nchunk; ++chunk) {
        int ln_ = lane; asm volatile("" : "+v"(ln_));
        const int lane = ln_, c16 = lane & 15, g = lane >> 4, cc = (w & 1) * 64 + lane;
        const int R0 = SAMPLE ? MP + sidx * 64 : sidx * TP + chunk * 64;
        if (chunk + 1 < nchunk) { if (chunk & 1) LRU_ISSUE(chunk + 1, 0); else LRU_ISSUE(chunk + 1, 1); }
        float gg[8];
#pragma unroll
        for (int i = 0; i < 8; ++i) gg[i] = ggn[i];
        if (chunk + 1 < nchunk) {
#pragma unroll
            for (int i = 0; i < 8; ++i) ggn[i] = LDG_F32(P + (size_t)(R0 + 64 + 8 * w + i) * DINP, voffg); }
#pragma unroll
        for (int i = 0; i < 16; ++i) { const int r = tq * 16 + i; const int o = SAMPLE ? (i >> 3) * 11 + (i & 7) : i;
            const float u = (chunk & 1) ? cb + cw0 * raw[1][o] + cw1 * raw[1][o + 1] + cw2 * raw[1][o + 2] + cw3 * raw[1][o + 3] : cb + cw0 * raw[0][o] + cw1 * raw[0][o + 1] + cw2 * raw[0][o + 2] + cw3 * raw[0][o + 3];
            U32[r * 128 + cc] = u; UB[r * LR_UBP + cc] = (bf16)f2bf(u); }
        LDS_BAR();
        f32x4 ra[2], rx[2];
#pragma unroll
        for (int mi = 0; mi < 2; ++mi) { ra[mi] = (f32x4){0.f, 0.f, 0.f, 0.f}; rx[mi] = (f32x4){0.f, 0.f, 0.f, 0.f};
#pragma unroll
            for (int ks = 0; ks < 4; ++ks) { const bf16x8 af = *(const LAS bf16x8*)(UB + (16 * (mt0 + mi) + c16) * LR_UBP + ks * 32 + 8 * g); ra[mi] = MFMA16(af, ba[ks], ra[mi]); rx[mi] = MFMA16(af, bx[ks], rx[mi]); } }
#pragma unroll
        for (int mi = 0; mi < 2; ++mi)
#pragma unroll
            for (int j = 0; j < 4; ++j) { const int r = 16 * (mt0 + mi) + 4 * g + j; const float rr = sigmoid_f(ra[mi][j] + b_a), ii = sigmoid_f(rx[mi][j] + b_x), la = cl * rr;
                const float a = __expf(la), x2 = 2.0f * la;
                const float m2 = x2 > -0.25f ? -x2 * (1.0f + x2 * (0.5f + x2 * (0.16666667f + x2 * (0.041666668f + x2 * 0.0083333338f)))) : 1.0f - a * a;
                const float u = U32[r * 128 + hcol0 + c16]; A32[r * 64 + 16 * nt + c16] = a; B32[r * 64 + 16 * nt + c16] = __builtin_amdgcn_sqrtf(m2) * ii * u; }
        LDS_BAR();
        if (tid < 256) { const int cch = tid & 63, seg = tid >> 6;
            if (SAMPLE) {
#pragma unroll
                for (int q = 0; q < 2; ++q) { const int sq = sidx * 8 + seg * 2 + q; float hh = INP(I_SLH)[(size_t)sq * D + h * 128 + 64 * half + cch];
#pragma unroll
                    for (int t = 0; t < 8; ++t) { const int r = 16 * seg + 8 * q + t; hh = A32[r * 64 + cch] * hh + B32[r * 64 + cch]; B32[r * 64 + cch] = hh; }
                    F.out[O_SLH + (size_t)sq * D + h * 128 + 64 * half + cch] = hh; }
            } else {
                float ap = 1.f, hp = 0.f;
#pragma unroll
                for (int i = 0; i < 16; ++i) { const int r = 16 * seg + i; const float a = A32[r * 64 + cch]; hp = a * hp + B32[r * 64 + cch]; ap *= a; }
                SEG[seg * 64 + cch] = ap; SEG[256 + seg * 64 + cch] = hp;
            } }
        if (!SAMPLE) {
            LDS_BAR();
            if (tid < 256) { const int cch = tid & 63, seg = tid >> 6; float hh = CAR[cch];
#pragma unroll
                for (int s2 = 0; s2 < 3; ++s2) if (s2 < seg) hh = SEG[s2 * 64 + cch] * hh + SEG[256 + s2 * 64 + cch];
#pragma unroll
                for (int i = 0; i < 16; ++i) { const int r = 16 * seg + i; hh = A32[r * 64 + cch] * hh + B32[r * 64 + cch]; B32[r * 64 + cch] = hh; }
                if (seg == 3) { SEG[512 + cch] = hh; if (chunk == nchunk - 1) F.out[O_PLH + (size_t)sidx * D + h * 128 + 64 * half + cch] = hh; } }
        }
        LDS_BAR();
        if (!SAMPLE && tid < 64) CAR[tid] = SEG[512 + tid];
#pragma unroll
        for (int i = 0; i < 8; ++i) { const int r = 8 * w + i, R = R0 + r;
            const float v0 = B32[r * 64 + lane] * gelu_tanh_f(gg[i]);
            WSP(bf16, WS_V)[(size_t)R * DMIX + h * 128 + 64 * half + lane] = (bf16)f2bf(v0);
            const float q = wave_sum(v0 * v0); if (lane == 0) WSP(float, WS_SQV)[(size_t)R * NSQV + 2 * h + half] = q; }
        LDS_BAR();
    }
#undef LRU_ISSUE
}
constexpr int SD_WX = 107520, SD_RX = 108800, SD_CS = 0, SD_DT = 256, SD_WG = 512, SD_CM = 1024, SD_BM = 18432, SD_BT = 35840, SD_XT = 54272, SD_XS = 63488, SD_HB = 72704, SD_XF = 90112;
constexpr int SP136 = 136, SP72 = 72, SP68 = 68;
template <int L  , int PROBE = 0  >
__device__ __forceinline__ void ssd_item(Frame& F, const Args& A, int sq, int head) {
    constexpr bool SAMPLE = (L == 16); constexpr int LT = L / 16, KK = (L + 31) / 32, TV = SAMPLE ? TS : L;
    LAS float* CS = (LAS float*)(F.lds + SD_CS); LAS float* DT = (LAS float*)(F.lds + SD_DT); LAS float* WG = (LAS float*)(F.lds + SD_WG);
    LAS bf16* CM = (LAS bf16*)(F.lds + SD_CM); LAS bf16* BM = (LAS bf16*)(F.lds + SD_BM); LAS bf16* BT = (LAS bf16*)(F.lds + SD_BT);
    LAS bf16* XT = (LAS bf16*)(F.lds + SD_XT); LAS bf16* XS = (LAS bf16*)(F.lds + SD_XS); LAS bf16* HB = (LAS bf16*)(F.lds + SD_HB); LAS float* XF = (LAS float*)(F.lds + SD_XF);
    const int tid = F.tid, lane = F.lane, w = F.wave, c16 = lane & 15, g = lane >> 4, grp = head >> 4;
    const float* P = WSP(float, WS_PROJ);
    const float Aneg = -__expf(INP(I_SALOG)[head]), dtb = INP(I_SDTB)[head], Dh = INP(I_SD)[head];
    const int hpt = w & 3, hnt0 = 4 * (w >> 2);
    f32x4 Hacc[4];
    const size_t hbase = ((size_t)(sq * SSD_H + head) * SSD_P) * SSD_N;
#pragma unroll
    for (int i = 0; i < 4; ++i)
#pragma unroll
        for (int j = 0; j < 4; ++j) Hacc[i][j] = SAMPLE ? INP(I_SSH)[hbase + (size_t)(16 * hpt + 4 * g + j) * SSD_N + 16 * (hnt0 + i) + c16] : 0.f;
    const int cgb = lane, rbb = w, gx = lane & 15, rsub = lane >> 4, rp = 4 * w + rsub;
    const int xcb = 2048 + (cgb >> 5) * 256 + grp * 128 + 4 * (cgb & 31), xcx = head * 64 + 4 * gx;
    const bool actB = SAMPLE ? (w < 2) : true, actX = SAMPLE ? (w < 2) : true;
    const unsigned voffb = (unsigned)(C_XBC + xcb) * 4u, voffxx = (unsigned)(rsub * 2 * DINP + C_XBC + xcx) * 4u, voffxs = (unsigned)(rsub * 2 * XBC + xcx) * 4u;
    f32x4 wB[4], wX[4], bB, bX;
#pragma unroll
    for (int k = 0; k < 4; ++k) { wB[k] = *(const GAS f32x4*)(INP(I_SCW) + (size_t)k * XBC + xcb); wX[k] = *(const GAS f32x4*)(INP(I_SCW) + (size_t)k * XBC + xcx); }
    bB = *(const GAS f32x4*)(INP(I_SCB) + xcb); bX = *(const GAS f32x4*)(INP(I_SCB) + xcx);
    f32x4 rawB[11], rawX[5]; float rawdt = 0.f;
    v4u rawBC4[2][4]; f32x4 rawXr[2][2]; float rawdt2[2] = {0.f, 0.f};
    const unsigned voffbc2 = (unsigned)(lane * 1024 + (w < 4 ? grp * 128 + 32 * w : 256 + grp * 128 + 32 * (w - 4)) * 2);
    const unsigned voffx2 = (unsigned)(lane * DINP + C_XBC + head * 64 + 8 * w) * 4u;
    LAS float* RX = (LAS float*)(F.lds + SD_RX) + w * (67 * 8);
    if (!SAMPLE && lane < 6) *(LAS f32x4*)(RX + lane * 4) = (f32x4){0.f, 0.f, 0.f, 0.f};
    LAS f32x4* WX = (LAS f32x4*)(F.lds + SD_WX) + w * 10;
    if (!SAMPLE && lane < 10) { const int k = lane >> 1, q = lane & 1; WX[lane] = k < 4 ? *(const GAS f32x4*)(INP(I_SCW) + (size_t)k * XBC + head * 64 + 8 * w + 4 * q) : *(const GAS f32x4*)(INP(I_SCB) + head * 64 + 8 * w + 4 * q); }
#define SSD_LDROW(dst_, chunk_, rr_, rl_, vp_, vs_) do { const int rr__ = (rr_); const int tu__ = SAMPLE ? rr__ : (chunk_) * 64 + rr__; const int tl__ = SAMPLE ? (rl_) : (chunk_) * 64 + (rl_); \
        const GAS char* pb__ = (const GAS char*)(P + (size_t)((SAMPLE ? MP + sq * TS : sq * TP + (chunk_) * 64) + rr__) * DINP); \
        const GAS char* sb__ = (const GAS char*)(INP(I_SSC) + (size_t)(sq * 3 + 3 + tu__) * XBC); \
        if ((rl_) >= TV) dst_ = (f32x4){0.f, 0.f, 0.f, 0.f}; \
        else if (tl__ >= 0) dst_ = *(const GAS f32x4*)(pb__ + (vp_)); \
        else if (SAMPLE) dst_ = *(const GAS f32x4*)(sb__ + (vs_)); \
        else dst_ = (f32x4){0.f, 0.f, 0.f, 0.f}; } while (0)
#define SSD_ISSUE(chunk_, st_) do { \
        if (SAMPLE) { if (actB) { _Pragma("unroll") for (int i = 0; i < 11; ++i) SSD_LDROW(rawB[i], chunk_, 8 * rbb - 3 + i, 8 * rbb - 3 + i, voffb, (unsigned)xcb * 4u); } \
            if (actX) { _Pragma("unroll") for (int i = 0; i < 5; ++i) SSD_LDROW(rawX[i], chunk_, 8 * w - 3 + i, 2 * rp - 3 + i, voffxx, voffxs); } } \
        else { const GAS char* bc_ = (const GAS char*)(WSP(bf16, WS_BCC) + (size_t)(sq * TP + (chunk_) * 64) * 512) + voffbc2; \
            _Pragma("unroll") for (int i = 0; i < 4; ++i) rawBC4[st_][i] = *(const GAS v4u*)(bc_ + i * 16); \
            const GAS char* px_ = (const GAS char*)(P + (size_t)(sq * TP + (chunk_) * 64) * DINP) + voffx2; \
            _Pragma("unroll") for (int q = 0; q < 2; ++q) rawXr[st_][q] = *(const GAS f32x4*)(px_ + q * 16); \
            if (w == 0) rawdt2[st_] = P[(size_t)(sq * TP + (chunk_) * 64 + lane) * DINP + C_DT + head]; } \
        if (SAMPLE && w == 0) { const int r_ = lane; rawdt = (r_ < TV) ? P[(size_t)(MP + sq * TS + r_) * DINP + C_DT + head] : 0.f; } } while (0)
    SSD_ISSUE(0, 0);
#pragma unroll
    for (int i = 0; i < 4; ++i)
#pragma unroll
        for (int j = 0; j < 4; ++j) HB[(16 * hpt + 4 * g + j) * SP136 + 16 * (hnt0 + i) + c16] = (bf16)f2bf(Hacc[i][j]);
    if (SAMPLE) {
        for (int e = tid; e < 64 * 16; e += 512) { const int p = e >> 4, c = 16 + (e & 15); XT[p * SP72 + c] = 0; XS[p * SP72 + c] = 0; }
        for (int e = tid; e < 128 * 16; e += 512) { const int n = e >> 4, c = 16 + (e & 15); BT[n * SP72 + c] = 0; }
    }
    const int nchunk = SAMPLE ? 1 : TP / 64;
    constexpr int NPT0 = (L == 64) ? 2 : 1; f32x4 z4n[NPT0];
    const unsigned voffz = (unsigned)(c16 * DINP + C_Z + head * 64 + 16 * ((L == 64) ? 2 * (w >> 2) : (w & 3)) + 4 * g) * 4u;
    { const int lt0 = (L == 64) ? (w & 3) : 0; const int R0f = SAMPLE ? MP + sq * TS : sq * TP;
#pragma unroll
      for (int pi = 0; pi < NPT0; ++pi) { z4n[pi] = (f32x4){0.f, 0.f, 0.f, 0.f}; if (16 * lt0 + c16 < TV) z4n[pi] = *(const GAS f32x4*)((const GAS char*)(P + (size_t)(R0f + 16 * lt0) * DINP) + voffz + pi * 64); } }
#pragma unroll 2
    for (int chunk = 0; chunk < nchunk; ++chunk) {
        int ln_ = lane; asm volatile("" : "+v"(ln_));
        const int lane = ln_, c16 = lane & 15, g = lane >> 4, cgb = lane, gx = lane & 15, rsub = lane >> 4, rp = 4 * w + rsub;
        const int R0 = SAMPLE ? MP + sq * TS : sq * TP + chunk * 64;
        if (!SAMPLE && chunk + 1 < nchunk) { if (chunk & 1) SSD_ISSUE(chunk + 1, 0); else SSD_ISSUE(chunk + 1, 1); }
        const int lt_ = (L == 64) ? (w & 3) : 0, l_ = 16 * lt_ + c16; constexpr int NPT = (L == 64) ? 2 : 1; const int pt0_ = (L == 64) ? 2 * (w >> 2) : (w & 3);
        f32x4 z4[NPT];
#pragma unroll
        for (int pi = 0; pi < NPT; ++pi) z4[pi] = z4n[pi];
        if (chunk + 1 < nchunk) {
#pragma unroll
            for (int pi = 0; pi < NPT; ++pi) z4n[pi] = *(const GAS f32x4*)((const GAS char*)(P + (size_t)(R0 + 64 + 16 * lt_) * DINP) + voffz + pi * 64); }
        if (SAMPLE) {
        if (actB) {
#pragma unroll
            for (int i = 0; i < 8; ++i) { const int r = 8 * rbb + i; v2u pk;
                if (SAMPLE) { f32x4 v = bB + wB[0] * rawB[i] + wB[1] * rawB[i + 1] + wB[2] * rawB[i + 2] + wB[3] * rawB[i + 3];
                    if (r >= TV) v = (f32x4){0.f, 0.f, 0.f, 0.f}; else { v[0] = siluf_(v[0]); v[1] = siluf_(v[1]); v[2] = siluf_(v[2]); v[3] = siluf_(v[3]); }
                    pk.x = pk2(v[0], v[1]); pk.y = pk2(v[2], v[3]); }
                else { pk.x = 0u; pk.y = 0u; }
                const int n = 4 * (cgb & 31);
                if (cgb < 32) { *(LAS v2u*)(BM + r * SP136 + n) = pk; BT[(n + 0) * SP72 + r] = (bf16)(pk.x & 0xffffu); BT[(n + 1) * SP72 + r] = (bf16)(pk.x >> 16); BT[(n + 2) * SP72 + r] = (bf16)(pk.y & 0xffffu); BT[(n + 3) * SP72 + r] = (bf16)(pk.y >> 16); }
                else *(LAS v2u*)(CM + r * SP136 + n) = pk; } }
        if (actX) {
#pragma unroll
            for (int i = 0; i < 2; ++i) { const int r = 2 * rp + i; f32x4 v = bX + wX[0] * rawX[i] + wX[1] * rawX[i + 1] + wX[2] * rawX[i + 2] + wX[3] * rawX[i + 3];
                if (r >= TV) v = (f32x4){0.f, 0.f, 0.f, 0.f}; else { v[0] = siluf_(v[0]); v[1] = siluf_(v[1]); v[2] = siluf_(v[2]); v[3] = siluf_(v[3]); }
                *(LAS f32x4*)(XF + r * SP68 + 4 * gx) = v; const unsigned p0 = pk2(v[0], v[1]), p1 = pk2(v[2], v[3]); const int p = 4 * gx;
                XT[(p + 0) * SP72 + r] = (bf16)(p0 & 0xffffu); XT[(p + 1) * SP72 + r] = (bf16)(p0 >> 16); XT[(p + 2) * SP72 + r] = (bf16)(p1 & 0xffffu); XT[(p + 3) * SP72 + r] = (bf16)(p1 >> 16); } }
        } else {
#pragma unroll
            for (int i = 0; i < 4; ++i) { const v4u v = (chunk & 1) ? rawBC4[1][i] : rawBC4[0][i]; const int n0 = 32 * (w & 3) + 8 * i;
                if (w < 4) { *(LAS v4u*)(BM + lane * SP136 + n0) = v;
                    BT[(n0 + 0) * SP72 + lane] = (bf16)(v.x & 0xffffu); BT[(n0 + 1) * SP72 + lane] = (bf16)(v.x >> 16); BT[(n0 + 2) * SP72 + lane] = (bf16)(v.y & 0xffffu); BT[(n0 + 3) * SP72 + lane] = (bf16)(v.y >> 16);
                    BT[(n0 + 4) * SP72 + lane] = (bf16)(v.z & 0xffffu); BT[(n0 + 5) * SP72 + lane] = (bf16)(v.z >> 16); BT[(n0 + 6) * SP72 + lane] = (bf16)(v.w & 0xffffu); BT[(n0 + 7) * SP72 + lane] = (bf16)(v.w >> 16); }
                else *(LAS v4u*)(CM + lane * SP136 + n0) = v; }
            f32x4 xr[2]; xr[0] = (chunk & 1) ? rawXr[1][0] : rawXr[0][0]; xr[1] = (chunk & 1) ? rawXr[1][1] : rawXr[0][1];
            *(LAS f32x4*)(RX + (lane + 3) * 8) = xr[0]; *(LAS f32x4*)(RX + (lane + 3) * 8 + 4) = xr[1];
            f32x4 xm[3][2];
#pragma unroll
            for (int k = 0; k < 3; ++k) { xm[k][0] = *(const LAS f32x4*)(RX + (lane + k) * 8); xm[k][1] = *(const LAS f32x4*)(RX + (lane + k) * 8 + 4); }
            asm volatile("s_waitcnt lgkmcnt(0)" ::: "memory");
            if (lane >= 61) { *(LAS f32x4*)(RX + (lane - 61) * 8) = xr[0]; *(LAS f32x4*)(RX + (lane - 61) * 8 + 4) = xr[1]; }
#pragma unroll
            for (int q = 0; q < 2; ++q) { f32x4 v = WX[8 + q] + WX[q] * xm[0][q] + WX[2 + q] * xm[1][q] + WX[4 + q] * xm[2][q] + WX[6 + q] * xr[q];
                v[0] = siluf_(v[0]); v[1] = siluf_(v[1]); v[2] = siluf_(v[2]); v[3] = siluf_(v[3]);
                *(LAS f32x4*)(XF + lane * SP68 + 8 * w + 4 * q) = v; const unsigned p0 = pk2(v[0], v[1]), p1 = pk2(v[2], v[3]); const int p = 8 * w + 4 * q;
                XT[(p + 0) * SP72 + lane] = (bf16)(p0 & 0xffffu); XT[(p + 1) * SP72 + lane] = (bf16)(p0 >> 16); XT[(p + 2) * SP72 + lane] = (bf16)(p1 & 0xffffu); XT[(p + 3) * SP72 + lane] = (bf16)(p1 >> 16); }
        }
        if (w == 0) { const int r = lane; float dt = 0.f;
            if (r < TV) dt = softplus_f((SAMPLE ? rawdt : ((chunk & 1) ? rawdt2[1] : rawdt2[0])) + dtb);
            float cs = dt * Aneg;
#pragma unroll
            for (int o = 1; o < 64; o <<= 1) { const float up = __shfl_up(cs, o); if (lane >= o) cs += up; }
            const float csl = __shfl(cs, L - 1);
            if (r < L) { CS[r] = cs; DT[r] = dt; WG[r] = __expf(csl - cs) * dt; } }
        LDS_BAR();
        if (PROBE >= 4) {} else if (SAMPLE) { for (int e = tid; e < 64 * L; e += 512) { const int p = e & 63, l = e >> 6; XS[p * SP72 + l] = (bf16)f2bf(XF[l * SP68 + p] * WG[l]); } }
        else { const float wg = WG[lane]; const f32x4 x0 = *(const LAS f32x4*)(XF + lane * SP68 + 8 * w), x1 = *(const LAS f32x4*)(XF + lane * SP68 + 8 * w + 4);
#pragma unroll
            for (int j = 0; j < 4; ++j) { XS[(8 * w + j) * SP72 + lane] = (bf16)f2bf(x0[j] * wg); XS[(8 * w + 4 + j) * SP72 + lane] = (bf16)f2bf(x1[j] * wg); } }
        LDS_BAR();
        if ((L == 64 || w < 4) && PROBE < 2) {
            const int l = l_, pt0 = pt0_;
            bf16x8 cf[4];
#pragma unroll
            for (int ks = 0; ks < 4; ++ks) cf[ks] = *(const LAS bf16x8*)(CM + l * SP136 + ks * 32 + 8 * g);
            const float cs_l = CS[l];
            f32x4 gt[2 * KK];
#pragma unroll
            for (int st = 0; st < 2 * KK; ++st) { gt[st] = (f32x4){0.f, 0.f, 0.f, 0.f};
                if (st < LT) {
#pragma unroll
                    for (int ks = 0; ks < 4; ++ks) { const bf16x8 af = *(const LAS bf16x8*)(BM + (16 * st + c16) * SP136 + ks * 32 + 8 * g); gt[st] = MFMA16(af, cf[ks], gt[st]); }
#pragma unroll
                    for (int j = 0; j < 4; ++j) { const int s = 16 * st + 4 * g + j; gt[st][j] = (s <= l) ? gt[st][j] * __expf(cs_l - CS[s]) * DT[s] : 0.f; } } }
            bf16x8 wf[KK];
#pragma unroll
            for (int kk = 0; kk < KK; ++kk) wf[kk] = pack8(gt[2 * kk], gt[2 * kk + 1]);
            const float ecl = __expf(cs_l); const bool valid = (l < TV); const int R = R0 + l;
#pragma unroll
            for (int pi = 0; pi < NPT; ++pi) { const int pt = pt0 + pi; f32x4 a1 = (f32x4){0.f, 0.f, 0.f, 0.f}, a2 = (f32x4){0.f, 0.f, 0.f, 0.f};
#pragma unroll
                for (int kk = 0; kk < KK; ++kk) { const v2u lo = *(const LAS v2u*)(XT + (16 * pt + c16) * SP72 + 32 * kk + 4 * g), hi = *(const LAS v2u*)(XT + (16 * pt + c16) * SP72 + 32 * kk + 16 + 4 * g);
                    v4u wv; wv.x = lo.x; wv.y = lo.y; wv.z = hi.x; wv.w = hi.y; a1 = MFMA16(__builtin_bit_cast(bf16x8, wv), wf[kk], a1); }
#pragma unroll
                for (int ks = 0; ks < 4; ++ks) { const bf16x8 af = *(const LAS bf16x8*)(HB + (16 * pt + c16) * SP136 + ks * 32 + 8 * g); a2 = MFMA16(af, cf[ks], a2); }
                const f32x4 x4 = *(const LAS f32x4*)(XF + l * SP68 + 16 * pt + 4 * g);
                float v[4], q = 0.f;
#pragma unroll
                for (int j = 0; j < 4; ++j) { const float y = a1[j] + ecl * a2[j] + Dh * x4[j]; v[j] = y * siluf_(z4[pi][j]); q += v[j] * v[j]; }
                q += __shfl_xor(q, 16); q += __shfl_xor(q, 32);
                if (valid && (PROBE == 0 || q == 1.2345e38f)) { v2u o; o.x = pk2(v[0], v[1]); o.y = pk2(v[2], v[3]); *(GAS v2u*)(WSP(bf16, WS_V) + (size_t)R * DMIX + 2048 + head * 64 + 16 * pt + 4 * g) = o;
                    if (g == 0) WSP(float, WS_SQV)[(size_t)R * NSQV + 32 + head * 4 + pt] = q; } }
        }
        LDS_BAR();
        if (PROBE < 3) { const float dec = __expf(CS[L - 1]);
#pragma unroll
          for (int i = 0; i < 4; ++i) Hacc[i] = Hacc[i] * dec;
#pragma unroll
          for (int kk = 0; kk < KK; ++kk) { const bf16x8 af = *(const LAS bf16x8*)(XS + (16 * hpt + c16) * SP72 + 32 * kk + 8 * g);
#pragma unroll
              for (int i = 0; i < 4; ++i) { const bf16x8 bfr = *(const LAS bf16x8*)(BT + (16 * (hnt0 + i) + c16) * SP72 + 32 * kk + 8 * g); Hacc[i] = MFMA16(af, bfr, Hacc[i]); } }
          if (chunk + 1 < nchunk) {
#pragma unroll
              for (int i = 0; i < 4; ++i)
#pragma unroll
                  for (int j = 0; j < 4; ++j) HB[(16 * hpt + 4 * g + j) * SP136 + 16 * (hnt0 + i) + c16] = (bf16)f2bf(Hacc[i][j]); } }
        LDS_BAR();
    }
    float* ho = F.out + (SAMPLE ? O_SSH : O_PSH) + hbase;
#pragma unroll
    for (int i = 0; i < 4; ++i)
#pragma unroll
        for (int j = 0; j < 4; ++j) if (PROBE == 0 || Hacc[i][j] == 1.2345e38f) ho[(size_t)(16 * hpt + 4 * g + j) * SSD_N + 16 * (hnt0 + i) + c16] = Hacc[i][j];
}
__device__ __forceinline__ void ssd_sample4(Frame& F, const Args& A, int sq, int hq) {
    LAS float* CS = (LAS float*)(F.lds + SD_CS); LAS float* DT = (LAS float*)(F.lds + SD_DT); LAS float* WG = (LAS float*)(F.lds + SD_WG);
    LAS bf16* CM = (LAS bf16*)(F.lds + SD_CM); LAS bf16* BM = (LAS bf16*)(F.lds + SD_BM); LAS bf16* BT = (LAS bf16*)(F.lds + SD_BT);
    LAS bf16* XT = (LAS bf16*)(F.lds + SD_XT); LAS bf16* XS = (LAS bf16*)(F.lds + SD_XS); LAS bf16* HB = (LAS bf16*)(F.lds + SD_HB); LAS float* XF = (LAS float*)(F.lds + SD_XF);
    const int tid = F.tid, lane = F.lane, w = F.wave, c16 = lane & 15, g = lane >> 4, head0 = 4 * hq, grp = head0 >> 4;
    const float* P = WSP(float, WS_PROJ); const int R0 = MP + sq * TS;
    const int hpt = w & 3, hnt0 = 4 * (w >> 2);
    f32x4 Hacc[4][4];
#pragma unroll
    for (int hh = 0; hh < 4; ++hh)
#pragma unroll
        for (int i = 0; i < 4; ++i) Hacc[hh][i] = *(const GAS f32x4*)(INP(I_SSH) + ((size_t)(sq * SSD_H + head0 + hh) * SSD_P + 16 * hpt + c16) * SSD_N + 16 * (hnt0 + i) + 4 * g);
    const int r = w, xcb = 2048 + (lane >> 5) * 256 + grp * 128 + 4 * (lane & 31), xh = lane >> 4, xcx = (head0 + xh) * 64 + 4 * (lane & 15);
    f32x4 tb[4], tx[4];
#pragma unroll
    for (int k = 0; k < 4; ++k) { const int t = r - 3 + k;
        const float* src = t >= 0 ? P + (size_t)(R0 + t) * DINP + C_XBC : INP(I_SSC) + (size_t)(sq * 3 + 3 + t) * XBC;
        tb[k] = *(const GAS f32x4*)(src + xcb); tx[k] = *(const GAS f32x4*)(src + xcx); }
    f32x4 z4[4];
#pragma unroll
    for (int hh = 0; hh < 4; ++hh) { z4[hh] = (f32x4){0.f, 0.f, 0.f, 0.f}; if (w < 4 && c16 < TS) z4[hh] = *(const GAS f32x4*)(P + (size_t)(R0 + c16) * DINP + C_Z + (head0 + hh) * 64 + 16 * w + 4 * g); }
    float rawdt = 0.f; if (w < 4 && lane < TS) rawdt = P[(size_t)(R0 + lane) * DINP + C_DT + head0 + w];
    f32x4 wb[4], wx[4];
#pragma unroll
    for (int k = 0; k < 4; ++k) { wb[k] = *(const GAS f32x4*)(INP(I_SCW) + (size_t)k * XBC + xcb); wx[k] = *(const GAS f32x4*)(INP(I_SCW) + (size_t)k * XBC + xcx); }
    const f32x4 bb = *(const GAS f32x4*)(INP(I_SCB) + xcb), bx = *(const GAS f32x4*)(INP(I_SCB) + xcx);
    for (int e = tid; e < 128 * 8; e += 512) { const int n = e >> 3, c = 16 + 2 * (e & 7); *(LAS unsigned*)(BT + n * SP72 + c) = 0u; }
    for (int e = tid; e < 64 * 8; e += 512) { const int p = e >> 3, c = 16 + 2 * (e & 7); *(LAS unsigned*)(XT + p * SP72 + c) = 0u; *(LAS unsigned*)(XS + p * SP72 + c) = 0u; }
    { f32x4 v = bb + wb[0] * tb[0] + wb[1] * tb[1] + wb[2] * tb[2] + wb[3] * tb[3]; v[0] = siluf_(v[0]); v[1] = siluf_(v[1]); v[2] = siluf_(v[2]); v[3] = siluf_(v[3]);
      v2u pk; pk.x = pk2(v[0], v[1]); pk.y = pk2(v[2], v[3]); const v2u zz = {0u, 0u}; const int n = 4 * (lane & 31);
      if (lane < 32) { *(LAS v2u*)(BM + r * SP136 + n) = pk; *(LAS v2u*)(BM + (r + 8) * SP136 + n) = zz;
          BT[(n + 0) * SP72 + r] = (bf16)(pk.x & 0xffffu); BT[(n + 1) * SP72 + r] = (bf16)(pk.x >> 16); BT[(n + 2) * SP72 + r] = (bf16)(pk.y & 0xffffu); BT[(n + 3) * SP72 + r] = (bf16)(pk.y >> 16);
          BT[(n + 0) * SP72 + r + 8] = 0; BT[(n + 1) * SP72 + r + 8] = 0; BT[(n + 2) * SP72 + r + 8] = 0; BT[(n + 3) * SP72 + r + 8] = 0; }
      else { *(LAS v2u*)(CM + r * SP136 + n) = pk; *(LAS v2u*)(CM + (r + 8) * SP136 + n) = zz; } }
    f32x4 xv = bx + wx[0] * tx[0] + wx[1] * tx[1] + wx[2] * tx[2] + wx[3] * tx[3]; xv[0] = siluf_(xv[0]); xv[1] = siluf_(xv[1]); xv[2] = siluf_(xv[2]); xv[3] = siluf_(xv[3]);
    if (w < 4) { float dt = 0.f; if (lane < TS) dt = softplus_f(rawdt + INP(I_SDTB)[head0 + w]);
        float cs = dt * -__expf(INP(I_SALOG)[head0 + w]);
#pragma unroll
        for (int o = 1; o < 16; o <<= 1) { const float up = __shfl_up(cs, o); if (lane >= o) cs += up; }
        const float csl = __shfl(cs, 15);
        if (lane < 16) { CS[w * 16 + lane] = cs; DT[w * 16 + lane] = dt; WG[w * 16 + lane] = __expf(csl - cs) * dt; } }
    LDS_BAR();
    bf16x8 cf[4]; f32x4 gt0 = (f32x4){0.f, 0.f, 0.f, 0.f};
    if (w < 4) {
#pragma unroll
        for (int ks = 0; ks < 4; ++ks) cf[ks] = *(const LAS bf16x8*)(CM + c16 * SP136 + ks * 32 + 8 * g);
#pragma unroll
        for (int ks = 0; ks < 4; ++ks) { const bf16x8 af = *(const LAS bf16x8*)(BM + c16 * SP136 + ks * 32 + 8 * g); gt0 = MFMA16(af, cf[ks], gt0); } }
#pragma unroll
    for (int hh = 0; hh < 4; ++hh) { const int head = head0 + hh;
#pragma unroll
        for (int i = 0; i < 4; ++i) { v2u hb; hb.x = pk2(Hacc[hh][i][0], Hacc[hh][i][1]); hb.y = pk2(Hacc[hh][i][2], Hacc[hh][i][3]); *(LAS v2u*)(HB + (16 * hpt + c16) * SP136 + 16 * (hnt0 + i) + 4 * g) = hb; }
        if (xh == hh) { const int p = 4 * (lane & 15); *(LAS f32x4*)(XF + r * SP68 + p) = xv; *(LAS f32x4*)(XF + (r + 8) * SP68 + p) = (f32x4){0.f, 0.f, 0.f, 0.f};
            const unsigned p0 = pk2(xv[0], xv[1]), p1 = pk2(xv[2], xv[3]);
            XT[(p + 0) * SP72 + r] = (bf16)(p0 & 0xffffu); XT[(p + 1) * SP72 + r] = (bf16)(p0 >> 16); XT[(p + 2) * SP72 + r] = (bf16)(p1 & 0xffffu); XT[(p + 3) * SP72 + r] = (bf16)(p1 >> 16);
            XT[(p + 0) * SP72 + r + 8] = 0; XT[(p + 1) * SP72 + r + 8] = 0; XT[(p + 2) * SP72 + r + 8] = 0; XT[(p + 3) * SP72 + r + 8] = 0; }
        LDS_BAR();
        for (int e = tid; e < 64 * 16; e += 512) { const int p = e & 63, l = e >> 6; XS[p * SP72 + l] = (bf16)f2bf(XF[l * SP68 + p] * WG[hh * 16 + l]); }
        LDS_BAR();
        if (w < 4) { const int l = c16, pt = w; const float cs_l = CS[hh * 16 + l]; f32x4 gm;
#pragma unroll
            for (int j = 0; j < 4; ++j) { const int s2 = 4 * g + j; gm[j] = (s2 <= l) ? gt0[j] * __expf(cs_l - CS[hh * 16 + s2]) * DT[hh * 16 + s2] : 0.f; }
            const bf16x8 wf = pack8(gm, (f32x4){0.f, 0.f, 0.f, 0.f});
            f32x4 a1 = (f32x4){0.f, 0.f, 0.f, 0.f}, a2 = (f32x4){0.f, 0.f, 0.f, 0.f};
            { const v2u lo = *(const LAS v2u*)(XT + (16 * pt + c16) * SP72 + 4 * g), hi = *(const LAS v2u*)(XT + (16 * pt + c16) * SP72 + 16 + 4 * g); v4u wv; wv.x = lo.x; wv.y = lo.y; wv.z = hi.x; wv.w = hi.y; a1 = MFMA16(__builtin_bit_cast(bf16x8, wv), wf, a1); }
#pragma unroll
            for (int ks = 0; ks < 4; ++ks) { const bf16x8 af = *(const LAS bf16x8*)(HB + (16 * pt + c16) * SP136 + ks * 32 + 8 * g); a2 = MFMA16(af, cf[ks], a2); }
            const f32x4 x4 = *(const LAS f32x4*)(XF + l * SP68 + 16 * pt + 4 * g); const float ecl = __expf(cs_l), Dh = INP(I_SD)[head];
            float v[4], q = 0.f;
#pragma unroll
            for (int j = 0; j < 4; ++j) { const float y = a1[j] + ecl * a2[j] + Dh * x4[j]; v[j] = y * siluf_(z4[hh][j]); q += v[j] * v[j]; }
            q += __shfl_xor(q, 16); q += __shfl_xor(q, 32);
            if (l < TS) { const int R = R0 + l; v2u o; o.x = pk2(v[0], v[1]); o.y = pk2(v[2], v[3]); *(GAS v2u*)(WSP(bf16, WS_V) + (size_t)R * DMIX + 2048 + head * 64 + 16 * pt + 4 * g) = o;
                if (g == 0) WSP(float, WS_SQV)[(size_t)R * NSQV + 32 + head * 4 + pt] = q; } }
        LDS_BAR();
        { const float dec = __expf(CS[hh * 16 + 15]); const bf16x8 af = *(const LAS bf16x8*)(XS + (16 * hpt + c16) * SP72 + 8 * g);
#pragma unroll
          for (int i = 0; i < 4; ++i) { const bf16x8 bfr = *(const LAS bf16x8*)(BT + (16 * (hnt0 + i) + c16) * SP72 + 8 * g); Hacc[hh][i] = MFMA16(bfr, af, Hacc[hh][i] * dec); } }
        LDS_BAR();
    }
#pragma unroll
    for (int hh = 0; hh < 4; ++hh)
#pragma unroll
        for (int i = 0; i < 4; ++i) *(GAS f32x4*)(F.out + O_SSH + ((size_t)(sq * SSD_H + head0 + hh) * SSD_P + 16 * hpt + c16) * SSD_N + 16 * (hnt0 + i) + 4 * g) = Hacc[hh][i];
}
__device__ __forceinline__ void p4_mixer_prompt(Frame& F, const Args& A) {
    for (int it = blockIdx.x; it < 128 + 128; it += F.G) {
        if (it < 128) lru_item<false>(F, A, it >> 5, (it >> 1) & 15, it & 1); else ssd_item<64>(F, A, (it - 128) >> 5, (it - 128) & 31);
    }
}
__device__ __forceinline__ void p4_mixer_sample(Frame& F, const Args& A, int qoff) {
    for (;;) {
        LDS_BAR();
        if (F.tid == 0) F.MISC[0] = __hip_atomic_fetch_add(F.ctl + CW_QUEUE + qoff, 1u, RLX_AGENT);
        LDS_BAR();
        const int it = (int)F.MISC[0];
        if (it >= 512 + NBS * (SSD_H / 4)) break;
        if (it < 512) lru_item<true>(F, A, it >> 5, (it >> 1) & 15, it & 1); else ssd_sample4(F, A, (it - 512) >> 3, (it - 512) & 7);
    }
}

#ifndef SSD_PROBE
#define SSD_PROBE 0
#endif
#ifndef DUP_PHASE
#define DUP_PHASE -1
#endif
#ifndef MK_PER_PHASE
#define MK_PER_PHASE 0
#endif
constexpr int N_PHASES = 14;
constexpr int CW_QH = 20480;
template <class Epi> __device__ __forceinline__ void run_gemm_r(Frame& F, const bf16* Aop, const bf16* Bt, int Mr, int N, int K, const Epi& E, int lo, int n, int G, int c) {
    pg8::Gemm g{Aop, Bt, Mr, N, K}; pg8::RangeOrder R; R.init(Mr, N, lo, n, G, c);
    pg8::gemm_phase<Epi, pg8::RangeOrder, PG8_ALIGN, PG8_SP2>(F.lds + RING_OFF, g, R, E);
}
__global__ void __launch_bounds__(NWAVES * 64, 2) hymba_fwd(Args args) {
    extern __shared__ __attribute__((aligned(16))) unsigned char lds[];
    const Args& A = args;
    Frame F;
    F.lds = (LAS unsigned char*)lds;
    F.MISC = (volatile LAS unsigned*)(F.lds + MISC_OFF);
    F.tid = threadIdx.x; F.lane = F.tid & 63; F.wave = __builtin_amdgcn_readfirstlane(F.tid >> 6);
    F.G = gridDim.x; { const int bx = blockIdx.x; F.vcu = (F.G % 8 == 0) ? (bx % 8) * (F.G / 8) + bx / 8 : bx; }
    F.ws = args.ws; F.out = args.out; F.ctl = (gu32*)(args.ws + WS_CTL);
    for (int u = F.tid; u < (LDS_BYTES - LDSCTL_OFF) / 4; u += NWAVES * 64) ((LAS unsigned*)(F.lds + LDSCTL_OFF))[u] = 0u;
    __syncthreads();
    XcdBarrier bar = xcd_barrier_post((unsigned*)(F.ctl + CW_BAR), F.MISC + 8);
#define GRID_BAR() xcd_barrier(bar)
#define SLOT_BEGIN(slot_) do { cu = 0u; Sx = 0; if (xq == -2) { unsigned ok = 1u; for (int j = 0; j < 16; ++j) { const unsigned c_ = xb_ld((unsigned*)(F.ctl + CW_BAR) + XB_XCNT(j)); ok &= (j < 8) ? (c_ > 0u) : (c_ == 0u); } \
            xq = ok ? (int)(bar.x & 7u) : -1; } \
        __syncthreads(); if (F.tid == 0) F.MISC[16] = __hip_atomic_fetch_add(F.ctl + CW_QH + 64 * ((slot_) * 8 + (xq < 0 ? 0 : xq)), 1u, RLX_AGENT); __syncthreads(); } while (0)
    const int lo = args.ph_lo, hi = args.ph_hi;
#define IN(k) (lo <= (k) && (k) < hi)
#define BOTH(k) (IN(k) && IN((k) + 1))
    const int bid = blockIdx.x;
    float* SSQ0 = WSP(float, WS_SSQ); float* SSQ1 = SSQ0 + (size_t)M * NSSQ; float* SSQ2 = SSQ1 + (size_t)M * NSSQ; float* SSQ3 = SSQ2 + (size_t)M * NSSQ; float* SSQ4 = SSQ3 + (size_t)M * NSSQ;
    unsigned cu = 0u; int Sx = 0, xq = -2;
    bf16* XBA = WSP(bf16, WS_XBA); bf16* XBB = WSP(bf16, WS_XBB); bf16* ACT = WSP(bf16, WS_ACT); float* XR = WSP(float, WS_XR); bf16* VV = WSP(bf16, WS_V); bf16* QQ = WSP(bf16, WS_Q); bf16* OO = WSP(bf16, WS_O);
    constexpr float QSCALE = 0.04419417382415922f;

    if (IN(0)) { p0_prologue(F, A); if (BOTH(0)) GRID_BAR(); }
    constexpr int U_GU_P = (MP / 256) * (NGU / 256), U_GU_S = (MS / 256) * (NGU / 256), U_D_P = (MP / 256) * (D / 256), U_D_S = (MS / 256) * (D / 256), U_IN_P = (MP / 256) * (DINP / 256), U_IN_S = (MS / 256) * (DINP / 256), U_KV = (MMEM / 256) * (2 * D / 256);
    const int G = F.G, c32 = bid - 32;
    if (IN(1)) {
        { pg8::EpiKV E{F.out + O_PMK, F.out + O_PMV, WSP(bf16, WS_KM), WSP(bf16, WS_VT), WSP(float, WS_SSQM), 0}; run_gemm_r(F, WSP(bf16, WS_MEMB), WSP(bf16, WS_WKV), MMEM, 2 * D, D, E, 0, U_KV, G, bid); }
        { pg8::EpiSwiglu E{ACT, FF, SSQ0, MP}; run_gemm_r(F, XBA + (size_t)MP * D, WSP(bf16, WS_W1GU), MS, NGU, D, E, 0, U_GU_S, G, bid - 64 >= 0 ? bid - 64 : bid + G - 64); }
        if (BOTH(1)) GRID_BAR(); }
    if (IN(2)) {
        { pg8::EpiRes<true, true> E{INP(I_XP), INP(I_XS), XR, XBB, SSQ1, 0.5f, MP}; run_gemm_r(F, ACT + (size_t)MP * FF, WSP(bf16, WS_W1D), MS, D, FF, E, 0, U_D_S, 32, bid < 32 ? bid : -1); }
        { pg8::EpiSwiglu E{ACT, FF, SSQ0, 0}; if (bid < 32) run_gemm_r(F, XBA, WSP(bf16, WS_W1GU), MP, NGU, D, E, U_GU_P - 96, 96, 32, bid); else run_gemm_r(F, XBA, WSP(bf16, WS_W1GU), MP, NGU, D, E, 0, U_GU_P - 96, G - 32, c32); }
        if (BOTH(2)) GRID_BAR(); }
    if (IN(3)) {
        { pg8::EpiRes<true, true> E{INP(I_XP), INP(I_XS), XR, XBB, SSQ1, 0.5f, 0}; run_gemm_r(F, ACT, WSP(bf16, WS_W1D), MP, D, FF, E, 0, U_D_P, G, bid); }
        { pg8::EpiProj E{WSP(float, WS_PROJ), DINP, SSQ1, MP}; run_gemm_r(F, XBB + (size_t)MP * D, WSP(bf16, WS_WIN), MS, DINP, D, E, 0, U_IN_S, G, bid); }
        if (G > U_IN_S) { if (bid >= U_IN_S) convert_weights<1>(F, A, (bid - U_IN_S) * NWAVES + F.wave, (G - U_IN_S) * NWAVES); } else convert_weights<1>(F, A, F.vcu * NWAVES + F.wave, G * NWAVES);
        if (BOTH(3)) GRID_BAR(); }
    if (IN(4)) {
        { pg8::EpiProj E{WSP(float, WS_PROJ), DINP, SSQ1, 0}; run_gemm_r(F, XBB, WSP(bf16, WS_WIN), MP, DINP, D, E, 0, U_IN_P, G, bid); }
        p4_mixer_sample(F, A, 0);
        if (BOTH(4)) GRID_BAR(); }
    if (IN(5)) { p3b_bcconv(F, A); GRID_BAR(); }
    if (IN(5)) {
        p4_mixer_prompt(F, A);
#if SSD_PROBE
        GRID_BAR(); if (bid >= 128) ssd_item<64, SSD_PROBE>(F, A, (bid - 128) >> 5, (bid - 128) & 31);
#endif
        p5_normalize(F, A, MP, M, NBP, NBP + NBS, F.vcu * NWAVES + F.wave, F.G * NWAVES);
        if (BOTH(5)) GRID_BAR(); }
    if (IN(6)) {
        { pg8::EpiRes<false, true> E{nullptr, nullptr, XR, XBA, SSQ2, 1.0f, MP}; run_gemm_r(F, VV + (size_t)MP * DMIX, WSP(bf16, WS_WOUT), MS, D, DMIX, E, 0, U_D_S, 32, bid < 32 ? bid : -1); }
        if (G > 32) { if (bid >= 32) { p5_normalize(F, A, 0, MP, 0, NBP, c32 * NWAVES + F.wave, (G - 32) * NWAVES); convert_weights<2>(F, A, c32 * NWAVES + F.wave, (G - 32) * NWAVES); } }
        else { p5_normalize(F, A, 0, MP, 0, NBP, F.vcu * NWAVES + F.wave, G * NWAVES); convert_weights<2>(F, A, F.vcu * NWAVES + F.wave, G * NWAVES); }
        if (BOTH(6)) GRID_BAR(); }
    if (IN(7)) {
        { pg8::EpiRes<false, true> E{nullptr, nullptr, XR, XBA, SSQ2, 1.0f, 0}; run_gemm_r(F, VV, WSP(bf16, WS_WOUT), MP, D, DMIX, E, 0, U_D_P, G, bid); }
        { pg8::EpiQ E{QQ, SSQ2, QSCALE, MP}; run_gemm_r(F, XBA + (size_t)MP * D, WSP(bf16, WS_WQ), MS, D, D, E, 0, U_D_S, 32, bid < 32 ? bid : -1); }
        if (G > 32) { if (bid >= 32) convert_weights<3>(F, A, c32 * NWAVES + F.wave, (G - 32) * NWAVES); } else convert_weights<3>(F, A, F.vcu * NWAVES + F.wave, G * NWAVES);
        if (BOTH(7)) GRID_BAR(); }
    if (IN(8)) {
        const bool attn_first = ((bid >> 3) & 1) != 0;
        if (attn_first) p8_attn_sample(F, A);
        { pg8::EpiQ E{QQ, SSQ2, QSCALE, 0}; run_gemm_r(F, XBA, WSP(bf16, WS_WQ), MP, D, D, E, 0, U_D_P, G, bid); }
        if (!attn_first) p8_attn_sample(F, A);
        if (BOTH(8)) GRID_BAR(); }
    if (IN(9)) {
        { pg8::EpiRes<false, true> E{nullptr, nullptr, XR, XBB, SSQ3, 1.0f, MP}; run_gemm_r(F, OO + (size_t)MP * D, WSP(bf16, WS_WO), MS, D, D, E, 0, U_D_S, 32, bid < 32 ? bid : -1); }
        if (G > 32) p8_attn_prompt(F, A, c32, G - 32); else p8_attn_prompt(F, A, bid, G);
        if (BOTH(9)) GRID_BAR(); }
    if (IN(10)) {
        { pg8::EpiRes<false, true> E{nullptr, nullptr, XR, XBB, SSQ3, 1.0f, 0}; run_gemm_r(F, OO, WSP(bf16, WS_WO), MP, D, D, E, 0, U_D_P, G, bid); }
        { pg8::EpiSwiglu E{ACT, FF, SSQ3, MP}; run_gemm_r(F, XBB + (size_t)MP * D, WSP(bf16, WS_W2GU), MS, NGU, D, E, 0, U_GU_S, G, bid); }
        if (BOTH(10)) GRID_BAR(); }
    if (IN(11)) {
        { pg8::EpiRes<false, false> E{nullptr, nullptr, XR, nullptr, SSQ4, 0.5f, MP}; run_gemm_r(F, ACT + (size_t)MP * FF, WSP(bf16, WS_W2D), MS, D, FF, E, 0, U_D_S, 32, bid < 32 ? bid : -1); }
        { pg8::EpiSwiglu E{ACT, FF, SSQ3, 0}; if (bid < 32) run_gemm_r(F, XBB, WSP(bf16, WS_W2GU), MP, NGU, D, E, U_GU_P - 96, 96, 32, bid); else run_gemm_r(F, XBB, WSP(bf16, WS_W2GU), MP, NGU, D, E, 0, U_GU_P - 96, G - 32, c32); }
        if (BOTH(11)) GRID_BAR(); }
    if (IN(12)) {
        { pg8::EpiRes<false, false> E{nullptr, nullptr, XR, nullptr, SSQ4, 0.5f, 0}; run_gemm_r(F, ACT, WSP(bf16, WS_W2D), MP, D, FF, E, 0, U_D_P, G, bid); }
        p12_final(F, A, MP, M);
        if (BOTH(12)) GRID_BAR(); }
    if (IN(13)) { p12_final(F, A, 0, MP); }
#undef IN
#undef BOTH
}

extern "C" void kernel_launch(void* const* d_in, const int* in_sizes, int n_in, void* d_out, int out_size, void* d_ws, size_t ws_size, hipStream_t stream) {
    static int grid = 0;
    if (grid == 0) {
        if (n_in != N_IN || (size_t)out_size != O_END || ws_size < WS_END) { fprintf(stderr, "kernel_launch: shape mismatch: n_in %d out %d ws %zu (need %zu)\n", n_in, out_size, ws_size, (size_t)WS_END); grid = -1; return; }
        int dev = 0, cus = 0, per_cu = 0;
        if (hipGetDevice(&dev) != hipSuccess || hipDeviceGetAttribute(&cus, hipDeviceAttributeMultiprocessorCount, dev) != hipSuccess) { grid = -1; return; }
        if (hipFuncSetAttribute((const void*)hymba_fwd, hipFuncAttributeMaxDynamicSharedMemorySize, LDS_BYTES) != hipSuccess) { fprintf(stderr, "kernel_launch: hipFuncSetAttribute failed\n"); grid = -1; return; }
        if (hipOccupancyMaxActiveBlocksPerMultiprocessor(&per_cu, (const void*)hymba_fwd, NWAVES * 64, LDS_BYTES) != hipSuccess || per_cu < 1) { fprintf(stderr, "kernel_launch: occupancy query says %d blocks per CU\n", per_cu); (void)hipGetLastError(); grid = -1; return; }
        grid = cus;
    }
    if (grid < 0) return;
    if (hipMemsetAsync((char*)d_ws + WS_CTL, 0, CTL_ZERO_BYTES, stream) != hipSuccess) return;
    Args a{};
    for (int i = 0; i < N_IN; ++i) a.in[i] = (const float*)d_in[i];
    a.out = (float*)d_out; a.ws = (unsigned char*)d_ws;
    a.ph_lo = 0; a.ph_hi = N_PHASES; hipLaunchKernelGGL(hymba_fwd, dim3(grid), dim3(NWAVES * 64), LDS_BYTES, stream, a);
}
```

```cpp
#include <hip/hip_runtime.h>
#include <cstdio>
#include <cstdint>

constexpr int NWAVES = 8;
constexpr int D = 2048, MP = 8192, MS = 1024, M = MP + MS, TP = 2048, TS = 8, NBP = 4, NBS = 128;
constexpr int FF = 5632, NGU = 2 * FF, DIN = 8736, DINP = 8960, DMIX = 4096, NMEM = 256, MMEM = NBP * NMEM;
constexpr int LRU_H = 16, LRU_B = 128, SSD_H = 32, SSD_P = 64, SSD_N = 128, XBC = 2560;
constexpr int C_XL = 0, C_GL = 2048, C_Z = 4096, C_XBC = 6144, C_DT = 8704;
constexpr float EPS = 1e-6f;
constexpr int NSSQ = 32;
constexpr int NSQV = 160;
constexpr size_t O_Y = 0, O_PLC = (size_t)M * D, O_PLH = O_PLC + (size_t)NBP * 3 * D, O_PSC = O_PLH + (size_t)NBP * D, O_PSH = O_PSC + (size_t)NBP * 3 * XBC,
                 O_PMK = O_PSH + (size_t)NBP * SSD_H * SSD_P * SSD_N, O_PMV = O_PMK + (size_t)MMEM * D, O_SLC = O_PMV + (size_t)MMEM * D, O_SLH = O_SLC + (size_t)NBS * 3 * D,
                 O_SSC = O_SLH + (size_t)NBS * D, O_SSH = O_SSC + (size_t)NBS * 3 * XBC, O_END = O_SSH + (size_t)NBS * SSD_H * SSD_P * SSD_N;
static_assert(O_END == 59766784, "d_out size");
enum { I_XP = 0, I_MEMP, I_XS, I_CK, I_CV, I_SLC, I_SLH, I_SSC, I_SSH, I_F1G, I_F1WG, I_F1WU, I_F1WD, I_MIXG, I_WIN, I_LCW, I_LCB, I_LWA, I_LBA, I_LWX, I_LBX, I_LLAM, I_LOG,
       I_SCW, I_SCB, I_SDTB, I_SALOG, I_SD, I_SOG, I_WOUT, I_XAG, I_MEMG, I_WQ, I_WK, I_WV, I_WO, I_F2G, I_F2WG, I_F2WU, I_F2WD, I_FING, N_IN };
static_assert(N_IN == 41, "inputs");

constexpr size_t MiB = 1u << 20;
constexpr size_t al(size_t x) { return (x + 4095) & ~(size_t)4095; }
constexpr size_t WS_CTL = 0, CTL_ZERO_BYTES = 1 * MiB;
constexpr size_t WS_W1GU = 2 * MiB;
constexpr size_t WS_W1D  = WS_W1GU + al((size_t)NGU * D * 2);
constexpr size_t WS_WIN  = WS_W1D + al((size_t)D * FF * 2);
constexpr size_t WS_WOUT = WS_WIN + al((size_t)DINP * D * 2);
constexpr size_t WS_WQ   = WS_WOUT + al((size_t)D * DMIX * 2);
constexpr size_t WS_WKV  = WS_WQ + al((size_t)D * D * 2);
constexpr size_t WS_WO   = WS_WKV + al((size_t)2 * D * D * 2);
constexpr size_t WS_W2GU = WS_WO + al((size_t)D * D * 2);
constexpr size_t WS_W2D  = WS_W2GU + al((size_t)NGU * D * 2);
constexpr size_t WS_WL   = WS_W2D + al((size_t)D * FF * 2);
constexpr size_t WS_XBA  = WS_WL + al((size_t)LRU_H * 256 * 128 * 2);
constexpr size_t WS_XBB  = WS_XBA + al((size_t)M * D * 2);
constexpr size_t WS_MEMB = WS_XBB + al((size_t)M * D * 2);
constexpr size_t WS_ACT  = WS_MEMB + al((size_t)MMEM * D * 2);
constexpr size_t WS_XR   = WS_ACT + al((size_t)M * FF * 2);
constexpr size_t WS_PROJ = WS_XR + al((size_t)M * D * 4);
constexpr size_t WS_V    = WS_PROJ + al((size_t)M * DINP * 4);
constexpr size_t WS_Q    = WS_V + al((size_t)M * DMIX * 2);
constexpr size_t WS_O    = WS_Q + al((size_t)M * D * 2);
constexpr size_t WS_KM   = WS_O + al((size_t)M * D * 2);
constexpr size_t WS_VT   = WS_KM + al((size_t)MMEM * D * 2);
constexpr size_t WS_SSQ  = WS_VT + al((size_t)MMEM * D * 2);
constexpr size_t WS_SSQM = WS_SSQ + al((size_t)4 * M * NSSQ * 4);
constexpr size_t WS_SQV  = WS_SSQM + al((size_t)MMEM * NSSQ * 4);
constexpr size_t WS_BCC  = WS_SQV + al((size_t)M * NSQV * 4);
constexpr size_t WS_END  = WS_BCC + al((size_t)MP * 512 * 2);
constexpr int CW_TMO = 0, CW_CODE = 1, CW_QUEUE = 64, CW_BAR = 4096;

namespace pg8 {
#define PG8_LAS __attribute__((address_space(3)))
typedef unsigned short bf16_t;
typedef short bf16x8 __attribute__((ext_vector_type(8)));
typedef float f32x4 __attribute__((ext_vector_type(4)));
typedef unsigned u32x4 __attribute__((ext_vector_type(4)));
constexpr int BM = 256, BK = 64, HALF = 128, HTB = HALF * BK * 2  , STAGE_BYTES = 8 * HTB, NXCD = 8, WGM = 8;

__host__ __device__ __forceinline__ int lds_byte(int r, int c) { const int st = (r >> 4) * 2 + (c >> 5), rr = r & 15, cc = c & 31, ob = rr * 64 + cc * 2; return st * 1024 + (ob ^ (((ob >> 9) & 1) << 5)); }
__host__ __device__ __forceinline__ void stage_rc(int b, int& R, int& C) { const int st = b / 1024, sb = b % 1024, swz = sb ^ (((sb >> 9) & 1) << 5); R = (st >> 1) * 16 + swz / 64; C = (st & 1) * 32 + (swz % 64) / 2; }
__host__ __device__ __forceinline__ int perm32(int rho) { const int n = rho >> 4, i = rho & 15; return 8 * (i >> 2) + 4 * n + (i & 3); }

struct Unit { int pm, pn; };
struct Gemm { const bf16_t* A; const bf16_t* Bt; int M, N, K; };

struct StaticOrder {
    int nM, nN, nwg, G, c;
    __host__ __device__ void init(int M, int N, int G_, int c_) { nM = M / BM; nN = N / BM; nwg = nM * nN; G = G_; c = c_; }
    __host__ __device__ bool next(int i, Unit& u) const {
        const long L = (long)i * G + c; if (L >= nwg) return false;
        int wgid = (int)L; { const int q = nwg / NXCD, r = nwg % NXCD, xcd = wgid % NXCD, off = wgid / NXCD; wgid = (xcd < r ? xcd * (q + 1) : r * (q + 1) + (xcd - r) * q) + off; }
        const int nig = WGM * nN, gid = wgid / nig, fm = gid * WGM, gsz = (nM - fm) < WGM ? (nM - fm) : WGM;
        u.pm = fm + ((wgid % nig) % gsz); u.pn = (wgid % nig) / gsz; return true;
    }
    __device__ __forceinline__ void a_ready(const Unit&) const {}
    __device__ __forceinline__ void done(const Unit&) const {}
};

#define PG8_RLX __ATOMIC_RELAXED, __HIP_MEMORY_SCOPE_AGENT
struct QueueOrder {
    int nM, nN, cnt, base, S; unsigned cu;
    unsigned* qhead; volatile PG8_LAS unsigned* slots;
    mutable unsigned pend, taken;
    __device__ __forceinline__ void init(int M, int N, int xq, int& Sx, unsigned cu_, unsigned* qhead_, volatile PG8_LAS unsigned* slots_) {
        nM = M / BM; nN = N / BM; const int nwg = nM * nN;
        if (xq < 0) { base = 0; cnt = nwg; } else { const int q = nwg / NXCD, r = nwg % NXCD; cnt = q + (xq < r ? 1 : 0); base = xq < r ? xq * (q + 1) : r * (q + 1) + (xq - r) * q; }
        S = Sx; Sx += cnt; cu = cu_; qhead = qhead_; slots = slots_; pend = 0u; taken = 0u; }
    __device__ __forceinline__ bool next(int i, Unit& u) const {
        const int L = (int)__builtin_amdgcn_readfirstlane(slots[(cu + (unsigned)i) & 3u]) - S;
        if (L >= cnt) return false;
        const int wgid = base + L, nig = WGM * nN, gid = wgid / nig, fm = gid * WGM, gsz = (nM - fm) < WGM ? (nM - fm) : WGM, rem = wgid - gid * nig;
        u.pm = fm + rem % gsz; u.pn = rem / gsz;
        if (threadIdx.x == 0) pend = __hip_atomic_fetch_add(qhead, 1u, PG8_RLX);
        taken = (unsigned)i + 1u;
        return true;
    }
    __device__ __forceinline__ void a_ready(const Unit&) const {
        if (threadIdx.x == 0) slots[(cu + taken) & 3u] = pend;
        asm volatile("s_waitcnt lgkmcnt(0)" ::: "memory"); __builtin_amdgcn_s_barrier(); asm volatile("" ::: "memory");
    }
    __device__ __forceinline__ void done(const Unit&) const {}
};

struct RangeOrder {
    int nM, nN, lo, n, G, c;
    __device__ __forceinline__ void init(int M, int N, int lo_, int n_, int G_, int c_) { nM = M / BM; nN = N / BM; lo = lo_; n = n_; G = G_; c = c_; }
    __device__ __forceinline__ bool next(int i, Unit& u) const {
        const int Lr = i * G + c; if (c < 0 || c >= G || Lr >= n) return false;
        int w = Lr; { const int q = n / NXCD, r = n % NXCD, xcd = w % NXCD, off = w / NXCD; w = (xcd < r ? xcd * (q + 1) : r * (q + 1) + (xcd - r) * q) + off; }
        const int wgid = lo + w, nig = WGM * nN, gid = wgid / nig, fm = gid * WGM, gsz = (nM - fm) < WGM ? (nM - fm) : WGM, rem = wgid - gid * nig;
        u.pm = fm + rem % gsz; u.pn = rem / gsz; return true;
    }
    __device__ __forceinline__ void a_ready(const Unit&) const {}
    __device__ __forceinline__ void done(const Unit&) const {}
};

__device__ __forceinline__ unsigned cvt_pk_bf16(float lo, float hi) { unsigned r; asm volatile("v_cvt_pk_bf16_f32 %0, %1, %2" : "=v"(r) : "v"(lo), "v"(hi)); return r; }
typedef unsigned u32x2 __attribute__((ext_vector_type(2)));
constexpr float EPS_ = 1e-6f;
__device__ __forceinline__ float row_rstd(const float* ssq, int row, int fq) {
    const f32x4* p = (const f32x4*)(ssq + (size_t)row * 32 + fq * 8);
    const f32x4 a = p[0], b = p[1];
    float s = ((a[0] + a[1]) + (a[2] + a[3])) + ((b[0] + b[1]) + (b[2] + b[3]));
    s += __shfl_xor(s, 16); s += __shfl_xor(s, 32);
    return __builtin_amdgcn_rsqf(s * (1.0f / 2048.0f) + EPS_);
}
__device__ __forceinline__ float silu_f(float x) { return x * __builtin_amdgcn_rcpf(1.0f + __expf(-x)); }

struct EpiSwiglu {
    static constexpr bool PERM = true, AFTER_DRAIN = false;
    bf16_t* O; int ldc; const float* ssq; int rbase;
    __device__ __forceinline__ void operator()(const f32x4 (&acc)[2][2][4][2], const Unit& u, int wr, int wc, int fr, int fq) const {
        const int row0 = rbase + u.pm * BM + wr * 64 + fr, col0 = u.pn * HALF + wc * 32 + 8 * fq;
#pragma unroll
        for (int ai = 0; ai < 2; ++ai)
#pragma unroll
            for (int m = 0; m < 4; ++m) { const int row = row0 + ai * HALF + m * 16; const float rs = row_rstd(ssq, row, fq);
                u32x4 w; float o[8];
#pragma unroll
                for (int n = 0; n < 2; ++n)
#pragma unroll
                    for (int i = 0; i < 4; ++i) { const float g = acc[ai][0][m][n][i] * rs, up = acc[ai][1][m][n][i] * rs; o[4 * n + i] = silu_f(g) * up; }
                w.x = cvt_pk_bf16(o[0], o[1]); w.y = cvt_pk_bf16(o[2], o[3]); w.z = cvt_pk_bf16(o[4], o[5]); w.w = cvt_pk_bf16(o[6], o[7]);
                *(u32x4*)(O + (size_t)row * ldc + col0) = w; }
    }
};
struct EpiKV {
    static constexpr bool PERM = false, AFTER_DRAIN = false;
    float* ko; float* vo; bf16_t* km; bf16_t* vt; const float* ssq; int rbase;
    __device__ __forceinline__ void operator()(const f32x4 (&acc)[2][2][4][2], const Unit& u, int wr, int wc, int fr, int fq) const {
        const int row0 = rbase + u.pm * BM + wr * 64 + fr;
#pragma unroll
        for (int ai = 0; ai < 2; ++ai)
#pragma unroll
            for (int m = 0; m < 4; ++m) { const int row = row0 + ai * HALF + m * 16; const float rs = row_rstd(ssq, row, fq);
#pragma unroll
                for (int bj = 0; bj < 2; ++bj)
#pragma unroll
                    for (int n = 0; n < 2; ++n) { const int col = u.pn * BM + bj * HALF + wc * 32 + n * 16 + 4 * fq; const f32x4 v = acc[ai][bj][m][n] * rs;
                        if (u.pn < 8) { *(f32x4*)(ko + (size_t)row * 2048 + col) = v; u32x2 w; w.x = cvt_pk_bf16(v[0], v[1]); w.y = cvt_pk_bf16(v[2], v[3]); *(u32x2*)(km + (size_t)row * 2048 + col) = w; }
                        else { const int c2 = col - 2048; *(f32x4*)(vo + (size_t)row * 2048 + c2) = v; const int b = row >> 8, key = row & 255;
                            const unsigned w0 = cvt_pk_bf16(v[0], v[1]), w1 = cvt_pk_bf16(v[2], v[3]); bf16_t* t = vt + ((size_t)(b * 2048 + c2)) * 256 + key;
                            t[0] = (bf16_t)(w0 & 0xffffu); t[256] = (bf16_t)(w0 >> 16); t[512] = (bf16_t)(w1 & 0xffffu); t[768] = (bf16_t)(w1 >> 16); } } }
    }
};
template <bool FIRST, bool WRITE_XB> struct EpiRes {
    static constexpr bool PERM = false, AFTER_DRAIN = false;
    const float* xp; const float* xs; float* xr; bf16_t* xb; float* ssq_out; float alpha; int rbase;
    __device__ __forceinline__ void operator()(const f32x4 (&acc)[2][2][4][2], const Unit& u, int wr, int wc, int fr, int fq) const {
        const int row0 = rbase + u.pm * BM + wr * 64 + fr;
#pragma unroll
        for (int ai = 0; ai < 2; ++ai)
#pragma unroll
            for (int m = 0; m < 4; ++m) { const int row = row0 + ai * HALF + m * 16; float q = 0.f;
                const float* base = FIRST ? (row < 8192 ? xp + (size_t)row * 2048 : xs + (size_t)(row - 8192) * 2048) : xr + (size_t)row * 2048;
#pragma unroll
                for (int bj = 0; bj < 2; ++bj)
#pragma unroll
                    for (int n = 0; n < 2; ++n) { const int col = u.pn * BM + bj * HALF + wc * 32 + n * 16 + 4 * fq; const f32x4 b = *(const f32x4*)(base + col); const f32x4 o = b + acc[ai][bj][m][n] * alpha;
                        *(f32x4*)(xr + (size_t)row * 2048 + col) = o; q += (o[0] * o[0] + o[1] * o[1]) + (o[2] * o[2] + o[3] * o[3]);
                        if (WRITE_XB) { u32x2 w; w.x = cvt_pk_bf16(o[0], o[1]); w.y = cvt_pk_bf16(o[2], o[3]); *(u32x2*)(xb + (size_t)row * 2048 + col) = w; } }
                q += __shfl_xor(q, 16); q += __shfl_xor(q, 32);
                if (fq == 0) ssq_out[(size_t)row * 32 + u.pn * 4 + wc] = q; }
    }
};
struct EpiProj {
    static constexpr bool PERM = false, AFTER_DRAIN = false;
    float* C; int ldc; const float* ssq; int rbase;
    __device__ __forceinline__ void operator()(const f32x4 (&acc)[2][2][4][2], const Unit& u, int wr, int wc, int fr, int fq) const {
        const int row0 = rbase + u.pm * BM + wr * 64 + fr;
#pragma unroll
        for (int ai = 0; ai < 2; ++ai)
#pragma unroll
            for (int m = 0; m < 4; ++m) { const int row = row0 + ai * HALF + m * 16; const float rs = row_rstd(ssq, row, fq);
#pragma unroll
                for (int bj = 0; bj < 2; ++bj)
#pragma unroll
                    for (int n = 0; n < 2; ++n) { const int col = u.pn * BM + bj * HALF + wc * 32 + n * 16 + 4 * fq; *(f32x4*)(C + (size_t)row * ldc + col) = acc[ai][bj][m][n] * rs; } }
    }
};
struct EpiQ {
    static constexpr bool PERM = true, AFTER_DRAIN = false;
    bf16_t* O; const float* ssq; float scale; int rbase;
    __device__ __forceinline__ void operator()(const f32x4 (&acc)[2][2][4][2], const Unit& u, int wr, int wc, int fr, int fq) const {
        const int row0 = rbase + u.pm * BM + wr * 64 + fr, col0 = u.pn * BM + wc * 32 + 8 * fq;
#pragma unroll
        for (int ai = 0; ai < 2; ++ai)
#pragma unroll
            for (int m = 0; m < 4; ++m) { const int row = row0 + ai * HALF + m * 16; const float rs = row_rstd(ssq, row, fq) * scale;
#pragma unroll
                for (int bj = 0; bj < 2; ++bj) { const f32x4 v0 = acc[ai][bj][m][0] * rs, v1 = acc[ai][bj][m][1] * rs;
                    u32x4 w; w.x = cvt_pk_bf16(v0[0], v0[1]); w.y = cvt_pk_bf16(v0[2], v0[3]); w.z = cvt_pk_bf16(v1[0], v1[1]); w.w = cvt_pk_bf16(v1[2], v1[3]);
                    *(u32x4*)(O + (size_t)row * 2048 + col0 + bj * HALF) = w; } }
    }
};

template <class Epi, class Sched, bool ALIGN_EPI = false, bool SP2 = false>
__device__ __forceinline__ void gemm_phase(PG8_LAS unsigned char* lds, const Gemm g, const Sched& S, const Epi& E) {
    const int tid = threadIdx.x, wid = __builtin_amdgcn_readfirstlane(tid >> 6), lane = tid & 63, wr = wid >> 2, wc = wid & 3, fr = lane & 15, fq = lane >> 4;
    const int K = g.K, nt = K / BK;
    unsigned voffA[2], voffB[2];
#pragma unroll
    for (int i = 0; i < 2; ++i) { int R, C; stage_rc(tid * 16 + i * 8192, R, C); const int Rb = Epi::PERM ? ((R & ~31) + perm32(R & 31)) : R;
        voffA[i] = (unsigned)(R * K + C) * 2u; voffB[i] = (unsigned)(Rb * K + C) * 2u; }
    const size_t kstep = (size_t)(BK * 2);
    const size_t hstep = (size_t)HALF * K * 2;
    const size_t tstep = 2 * hstep;
    const unsigned ldsw = (unsigned)wid * 1024u;
    const int aoff = lds_byte(wr * 64 + fr, fq * 8), boff = lds_byte(wc * 32 + fr, fq * 8);
#define PG8_SA(b, h) (((b) * 2 + (h)) * HTB)
#define PG8_SB(b, h) ((4 + (b) * 2 + (h)) * HTB)
#define PG8_STAGE(bufoff, gbase, voff) do { _Pragma("unroll") for (int _i = 0; _i < 2; ++_i) \
        __builtin_amdgcn_global_load_lds((const unsigned*)((const char*)(gbase) + (voff)[_i]), (PG8_LAS unsigned*)(lds + (bufoff) + ldsw + _i * 8192), 16, 0, 0); } while (0)
#define PG8_LDA(dst, b, h) do { _Pragma("unroll") for (int m = 0; m < 4; ++m) _Pragma("unroll") for (int k = 0; k < 2; ++k) dst[m][k] = *(const PG8_LAS bf16x8*)(lds + PG8_SA(b, h) + aoff + m * 2048 + k * 1024); } while (0)
#define PG8_LDB(dst, b, h) do { _Pragma("unroll") for (int n = 0; n < 2; ++n) _Pragma("unroll") for (int k = 0; k < 2; ++k) dst[n][k] = *(const PG8_LAS bf16x8*)(lds + PG8_SB(b, h) + boff + n * 2048 + k * 1024); } while (0)
#define PG8_MMA(ai, bj, At, Bt) do { __builtin_amdgcn_s_setprio(1); _Pragma("unroll") for (int m = 0; m < 4; ++m) _Pragma("unroll") for (int n = 0; n < 2; ++n) _Pragma("unroll") for (int k = 0; k < 2; ++k) \
        acc[ai][bj][m][n] = __builtin_amdgcn_mfma_f32_16x16x32_bf16(Bt[n][k], At[m][k], acc[ai][bj][m][n], 0, 0, 0); __builtin_amdgcn_s_setprio(0); } while (0)
#define PG8_WAIT_V(n) asm volatile("s_waitcnt vmcnt(" #n ")" ::: "memory")
#define PG8_WAIT_L(n) asm volatile("s_waitcnt lgkmcnt(" #n ")" ::: "memory")
#define PG8_BAR __builtin_amdgcn_s_barrier()
#define PG8_SCHED __builtin_amdgcn_sched_barrier(0)
    Unit cur, nxt; int ui = 0;
    if (!S.next(0, cur)) return;
    f32x4 acc[2][2][4][2];
#pragma unroll
    for (int a = 0; a < 2; ++a)
#pragma unroll
        for (int b = 0; b < 2; ++b)
#pragma unroll
            for (int m = 0; m < 4; ++m)
#pragma unroll
                for (int n = 0; n < 2; ++n) acc[a][b][m][n] = (f32x4){0.f, 0.f, 0.f, 0.f};
    bf16x8 At[4][2], B0[2][2], B1[2][2];
    const char* cA = (const char*)g.A + (size_t)cur.pm * tstep; const char* cB = (const char*)g.Bt + (size_t)cur.pn * tstep;
    S.a_ready(cur);
    if constexpr (SP2) {
        PG8_STAGE(PG8_SB(0, 0), cB, voffB); PG8_STAGE(PG8_SB(0, 1), cB + hstep, voffB); PG8_STAGE(PG8_SA(0, 0), cA, voffA); PG8_STAGE(PG8_SA(0, 1), cA + hstep, voffA);
        if (wr == 1) PG8_BAR;
        PG8_WAIT_V(2); PG8_BAR;
        PG8_STAGE(PG8_SB(1, 0), cB + kstep, voffB); PG8_STAGE(PG8_SA(1, 0), cA + kstep, voffA); PG8_STAGE(PG8_SB(1, 1), cB + hstep + kstep, voffB);
        PG8_WAIT_V(6); PG8_BAR;
    } else {
        PG8_STAGE(PG8_SB(0, 0), cB, voffB); PG8_STAGE(PG8_SA(0, 0), cA, voffA); PG8_STAGE(PG8_SB(0, 1), cB + hstep, voffB); PG8_STAGE(PG8_SA(0, 1), cA + hstep, voffA);
        if (wr == 1) PG8_BAR;
        PG8_WAIT_V(4); PG8_BAR;
        PG8_STAGE(PG8_SB(1, 0), cB + kstep, voffB); PG8_STAGE(PG8_SA(1, 0), cA + kstep, voffA); PG8_STAGE(PG8_SB(1, 1), cB + hstep + kstep, voffB);
        PG8_WAIT_V(6); PG8_BAR;
    }
    for (;;) {
        const bool has_next = S.next(ui + 1, nxt);
        const char* nA = has_next ? (const char*)g.A + (size_t)nxt.pm * tstep : cA; const char* nB = has_next ? (const char*)g.Bt + (size_t)nxt.pn * tstep : cB;
        for (int t = 0; t < nt; t += 2) {
            const bool last = (t == nt - 2);
            const char* a1 = cA + (size_t)(t + 1) * kstep;
            const char* a2 = last ? nA : cA + (size_t)(t + 2) * kstep; const char* b2 = last ? nB : cB + (size_t)(t + 2) * kstep;
            const char* a3 = a2 + kstep; const char* b3 = b2 + kstep;
            if (last && has_next) S.a_ready(nxt);
            if constexpr (SP2) {
            PG8_LDB(B0, 0, 0); PG8_LDB(B1, 0, 1); PG8_SCHED; PG8_LDA(At, 0, 0); PG8_STAGE(PG8_SA(1, 1), a1 + hstep, voffA);
            PG8_WAIT_V(8); PG8_WAIT_L(0); PG8_BAR; PG8_MMA(0, 0, At, B0); PG8_MMA(0, 1, At, B1); PG8_BAR; PG8_SCHED;
            PG8_LDA(At, 0, 1); PG8_STAGE(PG8_SB(0, 0), b2, voffB); PG8_STAGE(PG8_SB(0, 1), b2 + hstep, voffB); PG8_STAGE(PG8_SA(0, 0), a2, voffA);
            PG8_WAIT_V(8); PG8_WAIT_L(0); PG8_BAR; PG8_MMA(1, 0, At, B0); PG8_MMA(1, 1, At, B1); PG8_BAR; PG8_SCHED;
            PG8_LDB(B0, 1, 0); PG8_LDB(B1, 1, 1); PG8_SCHED; PG8_LDA(At, 1, 0); PG8_STAGE(PG8_SA(0, 1), a2 + hstep, voffA);
            PG8_WAIT_V(8); PG8_WAIT_L(0); PG8_BAR; PG8_MMA(0, 0, At, B0); PG8_MMA(0, 1, At, B1); PG8_BAR; PG8_SCHED;
            PG8_LDA(At, 1, 1); PG8_STAGE(PG8_SB(1, 0), b3, voffB); PG8_STAGE(PG8_SB(1, 1), b3 + hstep, voffB); PG8_STAGE(PG8_SA(1, 0), a3, voffA);
            PG8_WAIT_V(8); PG8_WAIT_L(0); PG8_BAR; PG8_MMA(1, 0, At, B0); PG8_MMA(1, 1, At, B1); PG8_BAR; PG8_SCHED;
            } else {
            PG8_LDB(B0, 0, 0); PG8_SCHED; PG8_LDA(At, 0, 0); PG8_STAGE(PG8_SA(1, 1), a1 + hstep, voffA);
            PG8_WAIT_L(8); PG8_BAR; PG8_WAIT_L(0); PG8_MMA(0, 0, At, B0); PG8_BAR; PG8_SCHED;
            PG8_LDB(B1, 0, 1); PG8_STAGE(PG8_SB(0, 0), b2, voffB);
            PG8_BAR; PG8_WAIT_L(0); PG8_MMA(0, 1, At, B1); PG8_BAR;
            PG8_LDA(At, 0, 1); PG8_STAGE(PG8_SA(0, 0), a2, voffA);
            PG8_BAR; PG8_WAIT_L(0); PG8_MMA(1, 0, At, B0); PG8_BAR; PG8_SCHED;
            PG8_STAGE(PG8_SB(0, 1), b2 + hstep, voffB);
            PG8_WAIT_V(6); PG8_BAR; PG8_MMA(1, 1, At, B1); PG8_BAR;
            PG8_LDB(B0, 1, 0); PG8_SCHED; PG8_LDA(At, 1, 0); PG8_STAGE(PG8_SA(0, 1), a2 + hstep, voffA);
            PG8_WAIT_L(8); PG8_BAR; PG8_WAIT_L(0); PG8_MMA(0, 0, At, B0); PG8_BAR; PG8_SCHED;
            PG8_LDB(B1, 1, 1); PG8_STAGE(PG8_SB(1, 0), b3, voffB);
            PG8_BAR; PG8_WAIT_L(0); PG8_MMA(0, 1, At, B1); PG8_BAR;
            PG8_LDA(At, 1, 1); PG8_STAGE(PG8_SA(1, 0), a3, voffA);
            PG8_BAR; PG8_WAIT_L(0); PG8_MMA(1, 0, At, B0); PG8_BAR; PG8_SCHED;
            PG8_STAGE(PG8_SB(1, 1), b3 + hstep, voffB);
            PG8_WAIT_V(6); PG8_BAR; PG8_MMA(1, 1, At, B1); PG8_BAR;
            }
        }
        if constexpr (ALIGN_EPI) { if (wr == 0) PG8_BAR; }
        if constexpr (!Epi::AFTER_DRAIN) { E(acc, cur, wr, wc, fr, fq); S.done(cur); }
        if (!has_next) break;
#pragma unroll
        for (int a = 0; a < 2; ++a)
#pragma unroll
            for (int b = 0; b < 2; ++b)
#pragma unroll
                for (int m = 0; m < 4; ++m)
#pragma unroll
                    for (int n = 0; n < 2; ++n) acc[a][b][m][n] = (f32x4){0.f, 0.f, 0.f, 0.f};
        cur = nxt; cA = nA; cB = nB; ++ui;
        if constexpr (ALIGN_EPI) { if (wr == 1) PG8_BAR; }
    }
    PG8_WAIT_V(0);
    if constexpr (!ALIGN_EPI) { if (wr == 0) PG8_BAR; }
    PG8_BAR;
    if constexpr (Epi::AFTER_DRAIN) { E.fused(acc, cur, wr, wc, fr, fq, lds, wid, lane); S.done(cur); }
#undef PG8_SA
#undef PG8_SB
#undef PG8_STAGE
#undef PG8_LDA
#undef PG8_LDB
#undef PG8_MMA
#undef PG8_WAIT_V
#undef PG8_WAIT_L
#undef PG8_BAR
#undef PG8_SCHED
}
}
#ifndef PG8_SP2
#define PG8_SP2 true
#endif
#ifndef PG8_ALIGN
#define PG8_ALIGN true
#endif
constexpr int RING_OFF = 0, RING_BYTES = 131072;
constexpr int LDSCTL_OFF = RING_BYTES, MISC_OFF = LDSCTL_OFF + 320;
constexpr int LDS_BYTES = 147456;
static_assert(MISC_OFF + 128 <= LDS_BYTES, "LDS map");

#define GAS __attribute__((address_space(1)))
#define LAS __attribute__((address_space(3)))
typedef unsigned short bf16;
typedef unsigned v4u __attribute__((ext_vector_type(4)));
typedef unsigned v2u __attribute__((ext_vector_type(2)));
typedef float f32x4 __attribute__((ext_vector_type(4)));
typedef float f32x2 __attribute__((ext_vector_type(2)));
typedef short bf16x8 __attribute__((ext_vector_type(8)));
typedef short bf16x4 __attribute__((ext_vector_type(4)));
typedef GAS unsigned gu32;
#define RLX_AGENT __ATOMIC_RELAXED, __HIP_MEMORY_SCOPE_AGENT
#define LDS_WAIT() asm volatile("s_waitcnt lgkmcnt(0)" ::: "memory")
#define VM_WAIT() asm volatile("s_waitcnt vmcnt(0)" ::: "memory")
__device__ __forceinline__ unsigned f2bf(float f) { unsigned u = __builtin_bit_cast(unsigned, f); return (u + 0x7fffu + ((u >> 16) & 1u)) >> 16; }
__device__ __forceinline__ unsigned pk2(float lo, float hi) { return f2bf(lo) | (f2bf(hi) << 16); }
__device__ __forceinline__ float bf2f(unsigned b) { return __builtin_bit_cast(float, b << 16); }
__device__ __forceinline__ float wave_sum(float v) {
#pragma unroll
    for (int o = 1; o < 64; o <<= 1) v += __shfl_xor(v, o);
    return v;
}
__device__ __forceinline__ float sigmoid_f(float x) { return __builtin_amdgcn_rcpf(1.0f + __expf(-x)); }
__device__ __forceinline__ float siluf_(float x) { return x * sigmoid_f(x); }
__device__ __forceinline__ float softplus_f(float x) { return fmaxf(x, 0.f) + __logf(1.0f + __expf(-fabsf(x))); }
__device__ __forceinline__ float gelu_tanh_f(float x) { const float t = 0.7978845608028654f * (x + 0.044715f * x * x * x); return x * sigmoid_f(2.0f * t); }
#define MFMA16(a, b, c) __builtin_amdgcn_mfma_f32_16x16x32_bf16((a), (b), (c), 0, 0, 0)

#define LDS_BAR() do { asm volatile("s_waitcnt lgkmcnt(0)" ::: "memory"); __builtin_amdgcn_s_barrier(); asm volatile("" ::: "memory"); } while (0)

#define XB_TMO      128
#define XB_XCNT(j)  (256  + 64 * (j))
#define XB_XSUB(j)  (1280 + 64 * (j))
#define XB_XGEN(j)  (2304 + 64 * (j))
#define XB_TOP      3328
#define XB_TOPGEN   3392
#define XCD_BAR_WORDS 3456
#define XB_SPIN_CAP (1u << 18)

__device__ __forceinline__ unsigned xb_ld(unsigned* p)              { return __hip_atomic_load(p, __ATOMIC_RELAXED, __HIP_MEMORY_SCOPE_AGENT); }
__device__ __forceinline__ unsigned xb_add(unsigned* p, unsigned v) { return __hip_atomic_fetch_add(p, v, __ATOMIC_RELAXED, __HIP_MEMORY_SCOPE_AGENT); }
__device__ __forceinline__ unsigned xb_xcc_id() { return (unsigned)__builtin_amdgcn_s_getreg((3 << 11) | 20) & 0xFu; }
#define XB_SPIN(cond, bar) do { unsigned _sp = 0; while (cond) { __builtin_amdgcn_s_sleep(1); \
    if ((++_sp & 255u) == 0u) { if (xb_ld(&(bar)[XB_TMO])) break; if (_sp > XB_SPIN_CAP) { atomicAdd(&(bar)[XB_TMO], 1u); break; } } } } while (0)

struct XcdBarrier {
    unsigned* bar; unsigned x;
    volatile LAS unsigned* st;
};

__device__ __forceinline__ XcdBarrier xcd_barrier_post(unsigned* bar, volatile LAS unsigned* st) {
    XcdBarrier b; b.bar = bar; b.x = xb_xcc_id(); b.st = st;
    if (threadIdx.x == 0) (void)xb_add(&bar[XB_XCNT(b.x)], 1u);
    return b;
}
__device__ __forceinline__ void xcd_barrier_complete(unsigned* bar, unsigned x, unsigned& nloc, unsigned& nx) {
    const unsigned G = gridDim.x * gridDim.y * gridDim.z;
    unsigned sum, cnt, mine, sp = 0u;
    for (;;) {
        sum = 0u; cnt = 0u; mine = 0u;
#pragma unroll
        for (unsigned j = 0; j < 16; ++j) { const unsigned c = xb_ld(&bar[XB_XCNT(j)]); sum += c; cnt += (c > 0u) ? 1u : 0u; mine = (j == x) ? c : mine; }
        if (sum == G) break;
        __builtin_amdgcn_s_sleep(1);
        if ((++sp & 255u) == 0u) { if (xb_ld(&bar[XB_TMO])) break; if (sp > XB_SPIN_CAP) { atomicAdd(&bar[XB_TMO], 1u); break; } }
    }
    nloc = mine > 0u ? mine : 1u; nx = cnt > 0u ? cnt : 1u;
}

__device__ __forceinline__ void xcd_barrier(const XcdBarrier& b) {
    asm volatile("s_waitcnt vmcnt(0)" ::: "memory");
    __syncthreads();
    if (threadIdx.x == 0) {
        unsigned* bar = b.bar;
        __builtin_amdgcn_s_waitcnt(0);
        unsigned nloc = b.st[0], nx = b.st[1];
        if (nloc == 0u) { xcd_barrier_complete(bar, b.x, nloc, nx); b.st[0] = nloc; b.st[1] = nx; }
        const unsigned old = xb_add(&bar[XB_XSUB(b.x)], 1u);
        const unsigned gen = old / nloc;
        if (old + 1u == (gen + 1u) * nloc) {
            __builtin_amdgcn_fence(__ATOMIC_RELEASE, "agent");
            asm volatile("s_waitcnt vmcnt(0)" ::: "memory");
            const unsigned og = xb_add(&bar[XB_TOP], 1u);
            const unsigned tg = og / nx;
            if (og + 1u == (tg + 1u) * nx) xb_add(&bar[XB_TOPGEN], 1u);
            else XB_SPIN(xb_ld(&bar[XB_TOPGEN]) == tg, bar);
            __builtin_amdgcn_fence(__ATOMIC_ACQUIRE, "agent");
            xb_add(&bar[XB_XGEN(b.x)], 1u);
            asm volatile("s_waitcnt vmcnt(0)" ::: "memory");
        } else {
            XB_SPIN(xb_ld(&bar[XB_XGEN(b.x)]) == gen, bar);
            __builtin_amdgcn_fence(__ATOMIC_ACQUIRE, "agent");
            asm volatile("s_waitcnt vmcnt(0)" ::: "memory");
        }
    }
    __syncthreads();
}
struct Args { const float* in[41]; float* out; unsigned char* ws; int ph_lo, ph_hi; };
struct Frame {
    LAS unsigned char* lds;
    volatile LAS unsigned* MISC;
    gu32* ctl;
    int tid, lane, wave;
    int vcu, G;
    float* out;
    unsigned char* ws;
};
#define WSP(T, off) ((T*)(F.ws + (off)))
#define INP(i) (A.in[(i)])

__device__ __forceinline__ void p0_transpose_item(const float* W, int N, bf16* WT, int ldt, int kdst, int dst_row0, const float* gain, LAS float* scr, int k0, int n0, int lane) {
    const int rs = lane >> 3, c4 = (lane & 7) * 4; f32x4 v[8]; float gn[8];
    const GAS float* src = (const GAS float*)W + (size_t)(k0 + rs) * N + n0 + c4;
#pragma unroll
    for (int i = 0; i < 8; ++i) { v[i] = *(const GAS f32x4*)(src + (size_t)(8 * i) * N); gn[i] = gain ? gain[k0 + 8 * i + rs] : 1.0f; }
#pragma unroll
    for (int i = 0; i < 8; ++i) { LAS float* d = scr + (8 * i + rs) * 33 + c4; d[0] = v[i].x * gn[i]; d[1] = v[i].y * gn[i]; d[2] = v[i].z * gn[i]; d[3] = v[i].w * gn[i]; }
    LDS_WAIT(); asm volatile("" ::: "memory");
    const int c = lane & 7;
#pragma unroll
    for (int j = 0; j < 4; ++j) { const int n = (lane >> 3) + 8 * j; const LAS float* s = scr + (8 * c) * 33 + n;
        v4u o; o.x = pk2(s[0 * 33], s[1 * 33]); o.y = pk2(s[2 * 33], s[3 * 33]); o.z = pk2(s[4 * 33], s[5 * 33]); o.w = pk2(s[6 * 33], s[7 * 33]);
        *(GAS v4u*)(WT + (size_t)(dst_row0 + n) * ldt + kdst + k0 + 8 * c) = o; }
    LDS_WAIT(); asm volatile("" ::: "memory");
}
__device__ __forceinline__ void p0_tr(const float* W, int K, int N, bf16* WT, int ldt, int kdst, int row_base, int mode  , const float* gain, LAS float* scr, int item, int lane) {
    const int nblk = N / 32, kb = item / nblk, nb = item % nblk, k0 = 64 * kb, n0 = 32 * nb; (void)K;
    const int dr = mode == 0 ? row_base + n0 : (n0 / 128) * 256 + (n0 % 128) + (mode == 2 ? 128 : 0);
    p0_transpose_item(W, N, WT, ldt, kdst, dr, gain, scr, k0, n0, lane);
}
__device__ __forceinline__ void row_to_bf16_ssq(const float* xrow, bf16* orow, float* ssq32, int lane) {
    const GAS f32x4* xr = (const GAS f32x4*)xrow + lane; GAS v2u* o8 = (GAS v2u*)orow + lane; float s = 0.f;
#pragma unroll
    for (int j = 0; j < 8; ++j) { const f32x4 v = xr[64 * j]; s += (v.x * v.x + v.y * v.y) + (v.z * v.z + v.w * v.w); v2u w; w.x = pk2(v.x, v.y); w.y = pk2(v.z, v.w); o8[64 * j] = w; }
    s = wave_sum(s);
    if (lane < 32) ssq32[lane] = lane == 0 ? s : 0.f;
}
template <int SET> __device__ __forceinline__ void convert_weights(Frame& F, const Args& A, int gw, int NGW) {
    LAS float* scr = (LAS float*)(F.lds + RING_OFF + F.wave * 16384);
    constexpr int I_GU = (D / 64) * (FF / 32), I_DN = (FF / 64) * (D / 32), I_IN = (D / 64) * (DIN / 32), I_SQ = (D / 64) * (D / 32), I_L = 16 * 8;
    constexpr int NITEMS = SET == 0 ? 2 * I_GU + I_DN + I_IN + 2 * I_SQ + 2 * I_L : (SET == 1 ? 2 * I_SQ : (SET == 2 ? 2 * I_SQ + 2 * I_GU : I_DN));
    for (int it = gw; it < NITEMS; it += NGW) {
        int r = it;
        if (SET == 0) {
            if (r < I_GU) { p0_tr(INP(I_F1WG), D, FF, WSP(bf16, WS_W1GU), D, 0, 0, 1, INP(I_F1G), scr, r, F.lane); continue; } r -= I_GU;
            if (r < I_GU) { p0_tr(INP(I_F1WU), D, FF, WSP(bf16, WS_W1GU), D, 0, 0, 2, INP(I_F1G), scr, r, F.lane); continue; } r -= I_GU;
            if (r < I_DN) { p0_tr(INP(I_F1WD), FF, D, WSP(bf16, WS_W1D), FF, 0, 0, 0, nullptr, scr, r, F.lane); continue; } r -= I_DN;
            if (r < I_IN) { p0_tr(INP(I_WIN), D, DIN, WSP(bf16, WS_WIN), D, 0, 0, 0, INP(I_MIXG), scr, r, F.lane); continue; } r -= I_IN;
            if (r < I_SQ) { p0_tr(INP(I_WK), D, D, WSP(bf16, WS_WKV), D, 0, 0, 0, INP(I_MEMG), scr, r, F.lane); continue; } r -= I_SQ;
            if (r < I_SQ) { p0_tr(INP(I_WV), D, D, WSP(bf16, WS_WKV), D, 0, D, 0, INP(I_MEMG), scr, r, F.lane); continue; } r -= I_SQ;
            if (r < I_L) { const int h = r >> 3; p0_tr(INP(I_LWA) + (size_t)h * 16384, 128, 128, WSP(bf16, WS_WL), 128, 0, h * 256, 0, nullptr, scr, r & 7, F.lane); continue; } r -= I_L;
            { const int h = r >> 3; p0_tr(INP(I_LWX) + (size_t)h * 16384, 128, 128, WSP(bf16, WS_WL), 128, 0, h * 256 + 128, 0, nullptr, scr, r & 7, F.lane); }
        } else if (SET == 1) {
            if (r < I_SQ) { p0_tr(INP(I_WOUT), D, D, WSP(bf16, WS_WOUT), DMIX, 0, 0, 0, INP(I_LOG), scr, r, F.lane); continue; } r -= I_SQ;
            p0_tr(INP(I_WOUT) + (size_t)D * D, D, D, WSP(bf16, WS_WOUT), DMIX, D, 0, 0, INP(I_SOG), scr, r, F.lane);
        } else if (SET == 2) {
            if (r < I_SQ) { p0_tr(INP(I_WQ), D, D, WSP(bf16, WS_WQ), D, 0, 0, 0, INP(I_XAG), scr, r, F.lane); continue; } r -= I_SQ;
            if (r < I_SQ) { p0_tr(INP(I_WO), D, D, WSP(bf16, WS_WO), D, 0, 0, 0, nullptr, scr, r, F.lane); continue; } r -= I_SQ;
            if (r < I_GU) { p0_tr(INP(I_F2WG), D, FF, WSP(bf16, WS_W2GU), D, 0, 0, 1, INP(I_F2G), scr, r, F.lane); continue; } r -= I_GU;
            p0_tr(INP(I_F2WU), D, FF, WSP(bf16, WS_W2GU), D, 0, 0, 2, INP(I_F2G), scr, r, F.lane);
        } else {
            p0_tr(INP(I_F2WD), FF, D, WSP(bf16, WS_W2D), FF, 0, 0, 0, nullptr, scr, r, F.lane);
        }
    }
}
__device__ __forceinline__ void p0_prologue(Frame& F, const Args& A) {
    const int gw = F.vcu * NWAVES + F.wave, NGW = F.G * NWAVES;
    convert_weights<0>(F, A, gw, NGW);
    for (int m = gw; m < M; m += NGW) { const float* src = m < MP ? INP(I_XP) + (size_t)m * D : INP(I_XS) + (size_t)(m - MP) * D;
        row_to_bf16_ssq(src, WSP(bf16, WS_XBA) + (size_t)m * D, WSP(float, WS_SSQ) + (size_t)m * NSSQ, F.lane); }
    for (int m = gw; m < MMEM; m += NGW) row_to_bf16_ssq(INP(I_MEMP) + (size_t)m * D, WSP(bf16, WS_MEMB) + (size_t)m * D, WSP(float, WS_SSQM) + (size_t)m * NSSQ, F.lane);
    { GAS v4u* z = (GAS v4u*)(WSP(bf16, WS_WIN) + (size_t)DIN * D); const int nz = (DINP - DIN) * D * 2 / 16;
      for (int i = gw * 64 + F.lane; i < nz; i += NGW * 64) z[i] = (v4u){0u, 0u, 0u, 0u}; }
}

__device__ __forceinline__ void p5_normalize(Frame& F, const Args& A, int m0, int m1, int q0, int q1, int gw, int NGW) {
    const int lane = F.lane;
    bf16* V = WSP(bf16, WS_V); const float* SQ = WSP(float, WS_SQV);
    for (int m = m0 + gw; m < m1; m += NGW) {
        const float* sq = SQ + (size_t)m * NSQV;
        const float pl = lane < 32 ? sq[lane] : 0.f, p0 = sq[32 + lane], p1 = sq[96 + lane];
        const float rl = __builtin_amdgcn_rsqf(wave_sum(pl) * (1.0f / 2048.0f) + EPS), r0 = __builtin_amdgcn_rsqf(wave_sum(p0) * (1.0f / 1024.0f) + EPS), r1 = __builtin_amdgcn_rsqf(wave_sum(p1) * (1.0f / 1024.0f) + EPS);
        GAS v4u* row = (GAS v4u*)(V + (size_t)m * DMIX) + lane;
#pragma unroll
        for (int i = 0; i < 8; ++i) { const float rs = i < 4 ? rl : (i < 6 ? r0 : r1); v4u w = row[64 * i];
            w.x = pk2(bf2f(w.x & 0xffffu) * rs, bf2f(w.x >> 16) * rs); w.y = pk2(bf2f(w.y & 0xffffu) * rs, bf2f(w.y >> 16) * rs);
            w.z = pk2(bf2f(w.z & 0xffffu) * rs, bf2f(w.z >> 16) * rs); w.w = pk2(bf2f(w.w & 0xffffu) * rs, bf2f(w.w >> 16) * rs); row[64 * i] = w; }
    }
    const float* P = WSP(float, WS_PROJ);
    for (int it = q0 * 3 + gw; it < q1 * 3; it += NGW) { const int sq = it / 3, k = it % 3;
        const int row = sq < NBP ? sq * TP + TP - 3 + k : MP + (sq - NBP) * TS + TS - 3 + k;
        float* lc = sq < NBP ? F.out + O_PLC + (size_t)(sq * 3 + k) * D : F.out + O_SLC + (size_t)((sq - NBP) * 3 + k) * D;
        float* sc = sq < NBP ? F.out + O_PSC + (size_t)(sq * 3 + k) * XBC : F.out + O_SSC + (size_t)((sq - NBP) * 3 + k) * XBC;
        const float* src = P + (size_t)row * DINP;
        for (int c = lane * 4; c < D; c += 256) *(GAS f32x4*)(lc + c) = *(const GAS f32x4*)(src + C_XL + c);
        for (int c = lane * 4; c < XBC; c += 256) *(GAS f32x4*)(sc + c) = *(const GAS f32x4*)(src + C_XBC + c);
    }
}
__device__ __forceinline__ void p12_final(Frame& F, const Args& A, int m0, int m1) {
    const int gw = F.vcu * NWAVES + F.wave, NGW = F.G * NWAVES, lane = F.lane;
    const float* XR = WSP(float, WS_XR); const float* SSQ = WSP(float, WS_SSQ) + (size_t)4 * M * NSSQ; const float* g = INP(I_FING);
    for (int m = m0 + gw; m < m1; m += NGW) {
        const float p = lane < 32 ? SSQ[(size_t)m * NSSQ + lane] : 0.f; const float rs = __builtin_amdgcn_rsqf(wave_sum(p) * (1.0f / 2048.0f) + EPS);
        const GAS f32x4* xr = (const GAS f32x4*)(XR + (size_t)m * D) + lane; const GAS f32x4* gg = (const GAS f32x4*)g + lane; GAS f32x4* o = (GAS f32x4*)(F.out + O_Y + (size_t)m * D) + lane;
#pragma unroll
        for (int j = 0; j < 8; ++j) o[64 * j] = xr[64 * j] * rs * gg[64 * j];
    }
}

__device__ __forceinline__ void p3b_bcconv(Frame& F, const Args& A) {
    const float* P = WSP(float, WS_PROJ); bf16* BCC = WSP(bf16, WS_BCC);
    const int q = F.tid & 127, rsub = F.tid >> 7;
    const int xc = 2048 + 4 * q;
    f32x4 w[4];
#pragma unroll
    for (int k = 0; k < 4; ++k) w[k] = *(const GAS f32x4*)(INP(I_SCW) + (size_t)k * XBC + xc);
    const f32x4 bb = *(const GAS f32x4*)(INP(I_SCB) + xc);
    for (int r0 = blockIdx.x * 4; r0 < MP; r0 += F.G * 4) { const int R = r0 + rsub, t = R & (TP - 1);
        const GAS float* src = (const GAS float*)P + (size_t)R * DINP + C_XBC + xc; f32x4 v = bb;
#pragma unroll
        for (int k = 0; k < 4; ++k) { if (t - 3 + k >= 0) v = v + w[k] * *(const GAS f32x4*)(src - (ptrdiff_t)(3 - k) * DINP); }
        v2u o; o.x = pk2(siluf_(v[0]), siluf_(v[1])); o.y = pk2(siluf_(v[2]), siluf_(v[3]));
        *(GAS v2u*)(BCC + (size_t)R * 512 + 4 * q) = o; }
}

__device__ __forceinline__ bf16x8 pack8(const f32x4 a, const f32x4 b) { v4u w; w.x = pg8::cvt_pk_bf16(a[0], a[1]); w.y = pg8::cvt_pk_bf16(a[2], a[3]); w.z = pg8::cvt_pk_bf16(b[0], b[1]); w.w = pg8::cvt_pk_bf16(b[2], b[3]); return __builtin_bit_cast(bf16x8, w); }
#define SCHED_FENCE() __builtin_amdgcn_sched_barrier(0)
__device__ __forceinline__ void attn_prompt_item(Frame& F, const Args& A, int b, int h, int qt) {
    const int lane = F.lane, c16 = lane & 15, g = lane >> 4;
    const int R = b * TP + qt * 16 + c16;
    const bf16* Q = WSP(bf16, WS_Q) + (size_t)R * D + h * 512;
    bf16x8 qf[16];
#pragma unroll
    for (int ks = 0; ks < 16; ++ks) qf[ks] = *(const GAS bf16x8*)(Q + ks * 32 + 8 * g);
    const GAS char* kb = (const GAS char*)(WSP(bf16, WS_KM) + (size_t)(b * NMEM) * D + h * 512); const unsigned ko = (unsigned)(c16 * D + 8 * g) * 2u;
    f32x4 s[16]; bf16x8 kbuf[2][8];
#define KLOAD(step_) do { const int kt_ = (step_) >> 1, hf_ = (step_) & 1; _Pragma("unroll") for (int i = 0; i < 8; ++i) kbuf[(step_) & 1][i] = *(const GAS bf16x8*)(kb + (size_t)kt_ * 16 * D * 2 + ko + (hf_ * 8 + i) * 64); } while (0)
    KLOAD(0);
#pragma unroll
    for (int step = 0; step < 32; ++step) { const int kt = step >> 1, hf = step & 1;
        if (step + 1 < 32) KLOAD(step + 1);
        SCHED_FENCE();
        if (hf == 0) s[kt] = (f32x4){0.f, 0.f, 0.f, 0.f};
#pragma unroll
        for (int i = 0; i < 8; ++i) s[kt] = MFMA16(kbuf[step & 1][i], qf[hf * 8 + i], s[kt]);
        SCHED_FENCE(); }
#undef KLOAD
    const GAS char* vb = (const GAS char*)(WSP(bf16, WS_VT) + (size_t)(b * D + h * 512) * NMEM); const unsigned vo = (unsigned)(c16 * NMEM + 4 * g) * 2u;
    v2u vbuf[2][16];
#define VLOAD(dt_) do { _Pragma("unroll") for (int kk = 0; kk < 8; ++kk) { vbuf[(dt_) & 1][2 * kk] = *(const GAS v2u*)(vb + (size_t)(dt_) * 16 * NMEM * 2 + vo + kk * 64); vbuf[(dt_) & 1][2 * kk + 1] = *(const GAS v2u*)(vb + (size_t)(dt_) * 16 * NMEM * 2 + vo + kk * 64 + 32); } } while (0)
    VLOAD(0);
    float mx = -3.0e38f;
#pragma unroll
    for (int kt = 0; kt < 16; ++kt) mx = fmaxf(mx, fmaxf(fmaxf(s[kt][0], s[kt][1]), fmaxf(s[kt][2], s[kt][3])));
    mx = fmaxf(mx, __shfl_xor(mx, 16)); mx = fmaxf(mx, __shfl_xor(mx, 32));
    float sum = 0.f;
#pragma unroll
    for (int kt = 0; kt < 16; ++kt) {
#pragma unroll
        for (int j = 0; j < 4; ++j) { const float e = __expf(s[kt][j] - mx); s[kt][j] = e; sum += e; } }
    sum += __shfl_xor(sum, 16); sum += __shfl_xor(sum, 32);
    const float inv = 1.0f / sum;
    bf16x8 pf[8];
#pragma unroll
    for (int kk = 0; kk < 8; ++kk) pf[kk] = pack8(s[2 * kk], s[2 * kk + 1]);
    bf16* O = WSP(bf16, WS_O) + (size_t)R * D + h * 512 + 4 * g;
#pragma unroll
    for (int dt = 0; dt < 32; ++dt) { f32x4 o = (f32x4){0.f, 0.f, 0.f, 0.f};
        if (dt + 1 < 32) VLOAD(dt + 1);
        SCHED_FENCE();
#pragma unroll
        for (int kk = 0; kk < 8; ++kk) { v4u w; w.x = vbuf[dt & 1][2 * kk].x; w.y = vbuf[dt & 1][2 * kk].y; w.z = vbuf[dt & 1][2 * kk + 1].x; w.w = vbuf[dt & 1][2 * kk + 1].y; o = MFMA16(__builtin_bit_cast(bf16x8, w), pf[kk], o); }
        o = o * inv;
        { v2u w; w.x = pg8::cvt_pk_bf16(o[0], o[1]); w.y = pg8::cvt_pk_bf16(o[2], o[3]); *(GAS v2u*)(O + dt * 16) = w; }
        SCHED_FENCE(); }
#undef VLOAD
}
constexpr int AT_ML = 0, AT_PF = 1024;
__device__ __forceinline__ void attn_sample_wg(Frame& F, const Args& A, int b, int h) {
    const int lane = F.lane, w = F.wave, c16 = lane & 15, g = lane >> 4;
    LAS float* ML = (LAS float*)(F.lds + AT_ML); LAS v4u* PF = (LAS v4u*)(F.lds + AT_PF);
    const int R = MP + b * TS + (c16 & 7); const bool qvalid = c16 < 8;
    const bf16* Q = WSP(bf16, WS_Q) + (size_t)R * D + h * 512;
    bf16x8 qf[16];
#pragma unroll
    for (int ks = 0; ks < 16; ++ks) qf[ks] = *(const GAS bf16x8*)(Q + ks * 32 + 8 * g);
    const GAS char* kb = (const GAS char*)(INP(I_CK) + (size_t)(b * NMEM + 32 * w) * D + h * 512); const unsigned ko = (unsigned)(c16 * D + 8 * g) * 4u;
    f32x4 s[2]; f32x4 kbuf[2][16];
#define KLOAD(step_) do { const int t_ = (step_) >> 1, hf_ = (step_) & 1; _Pragma("unroll") for (int i = 0; i < 8; ++i) { \
        kbuf[(step_) & 1][2 * i] = *(const GAS f32x4*)(kb + (size_t)t_ * 16 * D * 4 + ko + (hf_ * 8 + i) * 128); kbuf[(step_) & 1][2 * i + 1] = *(const GAS f32x4*)(kb + (size_t)t_ * 16 * D * 4 + ko + (hf_ * 8 + i) * 128 + 16); } } while (0)
    KLOAD(0);
#pragma unroll
    for (int step = 0; step < 4; ++step) { const int t = step >> 1, hf = step & 1;
        if (step + 1 < 4) KLOAD(step + 1);
        SCHED_FENCE();
        if (hf == 0) s[t] = (f32x4){0.f, 0.f, 0.f, 0.f};
#pragma unroll
        for (int i = 0; i < 8; ++i) s[t] = MFMA16(pack8(kbuf[step & 1][2 * i], kbuf[step & 1][2 * i + 1]), qf[hf * 8 + i], s[t]);
        SCHED_FENCE(); }
#undef KLOAD
    const GAS char* vb = (const GAS char*)(INP(I_CV) + (size_t)(b * NMEM) * D + h * 512); const unsigned vo2 = (unsigned)(4 * g * D + c16) * 4u;
    float vbuf[2][64];
#define VLOAD(i_) do { const int dt_ = 4 * w + (i_); _Pragma("unroll") for (int kk = 0; kk < 8; ++kk) { const GAS char* v0 = vb + (size_t)(kk * 32) * D * 4 + dt_ * 64 + vo2; \
        _Pragma("unroll") for (int j = 0; j < 4; ++j) { vbuf[(i_) & 1][kk * 8 + j] = *(const GAS float*)(v0 + (size_t)j * D * 4); vbuf[(i_) & 1][kk * 8 + 4 + j] = *(const GAS float*)(v0 + (size_t)(16 + j) * D * 4); } } } while (0)
    VLOAD(0);
    float mx = fmaxf(fmaxf(fmaxf(s[0][0], s[0][1]), fmaxf(s[0][2], s[0][3])), fmaxf(fmaxf(s[1][0], s[1][1]), fmaxf(s[1][2], s[1][3])));
    mx = fmaxf(mx, __shfl_xor(mx, 16)); mx = fmaxf(mx, __shfl_xor(mx, 32));
    float sum = 0.f;
#pragma unroll
    for (int t = 0; t < 2; ++t)
#pragma unroll
        for (int j = 0; j < 4; ++j) { const float e = __expf(s[t][j] - mx); s[t][j] = e; sum += e; }
    sum += __shfl_xor(sum, 16); sum += __shfl_xor(sum, 32);
    if (g == 0) { ML[(w * 16 + c16) * 2] = mx; ML[(w * 16 + c16) * 2 + 1] = sum; }
    LDS_BAR();
    float gm = -3.0e38f;
#pragma unroll
    for (int ww = 0; ww < 8; ++ww) gm = fmaxf(gm, ML[(ww * 16 + c16) * 2]);
    float tot = 0.f;
#pragma unroll
    for (int ww = 0; ww < 8; ++ww) tot += ML[(ww * 16 + c16) * 2 + 1] * __expf(ML[(ww * 16 + c16) * 2] - gm);
    const float f = __expf(mx - gm), inv = 1.0f / tot;
    { const bf16x8 pk = pack8(s[0] * f, s[1] * f); PF[w * 64 + lane] = __builtin_bit_cast(v4u, pk); }
    LDS_BAR();
    bf16x8 pf[8];
#pragma unroll
    for (int kk = 0; kk < 8; ++kk) pf[kk] = __builtin_bit_cast(bf16x8, PF[kk * 64 + lane]);
    bf16* O = WSP(bf16, WS_O) + (size_t)R * D + h * 512 + 4 * g;
#pragma unroll
    for (int i = 0; i < 4; ++i) { const int dt = 4 * w + i; f32x4 o = (f32x4){0.f, 0.f, 0.f, 0.f};
        if (i + 1 < 4) VLOAD(i + 1);
        SCHED_FENCE();
#pragma unroll
        for (int kk = 0; kk < 8; ++kk) { const float* vv = &vbuf[i & 1][kk * 8]; o = MFMA16(pack8((f32x4){vv[0], vv[1], vv[2], vv[3]}, (f32x4){vv[4], vv[5], vv[6], vv[7]}), pf[kk], o); }
        o = o * inv;
        if (qvalid) { v2u wv; wv.x = pg8::cvt_pk_bf16(o[0], o[1]); wv.y = pg8::cvt_pk_bf16(o[2], o[3]); *(GAS v2u*)(O + dt * 16) = wv; }
        SCHED_FENCE(); }
#undef VLOAD
    LDS_BAR();
}
__device__ __forceinline__ void p8_attn_sample(Frame& F, const Args& A) {
    for (int it = blockIdx.x; it < NBS * 4; it += F.G) attn_sample_wg(F, A, it >> 2, it & 3);
}
constexpr int AP_BUF = 33792, AP_KP = 1040, AP_VP = 528;
__device__ __forceinline__ void attn_prompt_wg(Frame& F, const Args& A, int b, int h, int qb) {
    const int tid = F.tid, lane = F.lane, w = F.wave, c16 = lane & 15, g = lane >> 4;
    LAS unsigned char* L0 = F.lds;
    const int R = b * TP + qb * 128 + w * 16 + c16;
    const bf16* Q = WSP(bf16, WS_Q) + (size_t)R * D + h * 512;
    bf16x8 qf[16];
#pragma unroll
    for (int ks = 0; ks < 16; ++ks) qf[ks] = *(const GAS bf16x8*)(Q + ks * 32 + 8 * g);
    const int kkey = tid >> 4, kseg = tid & 15;
    const GAS char* kg = (const GAS char*)(WSP(bf16, WS_KM) + (size_t)(b * NMEM) * D + h * 512) + (size_t)kkey * D * 2 + kseg * 64;
    const unsigned kl = (unsigned)(kkey * AP_KP + kseg * 64);
    v4u st[4];
#define AP_LOAD(src_) do { _Pragma("unroll") for (int j = 0; j < 4; ++j) st[j] = *(const GAS v4u*)((src_) + j * 16); } while (0)
#define AP_STORE(buf_, off_) do { _Pragma("unroll") for (int j = 0; j < 4; ++j) *(LAS v4u*)(L0 + (buf_) * AP_BUF + (off_) + j * 16) = st[j]; } while (0)
    AP_LOAD(kg); AP_STORE(0, kl); LDS_BAR();
    f32x4 s[16];
#pragma unroll
    for (int t = 0; t < 8; ++t) {
        if (t + 1 < 8) AP_LOAD(kg + (size_t)(t + 1) * 32 * D * 2);
        SCHED_FENCE();
#pragma unroll
        for (int tt = 0; tt < 2; ++tt) { const int kt = 2 * t + tt; s[kt] = (f32x4){0.f, 0.f, 0.f, 0.f};
#pragma unroll
            for (int ks = 0; ks < 16; ++ks) { const bf16x8 kf = *(const LAS bf16x8*)(L0 + (t & 1) * AP_BUF + (16 * tt + c16) * AP_KP + ks * 64 + g * 16); s[kt] = MFMA16(kf, qf[ks], s[kt]); } }
        SCHED_FENCE();
        if (t + 1 < 8) AP_STORE((t + 1) & 1, kl);
        LDS_BAR(); }
    const int vrow = tid >> 3, vseg = tid & 7;
    const GAS char* vg = (const GAS char*)(WSP(bf16, WS_VT) + (size_t)(b * D + h * 512) * NMEM) + (size_t)vrow * NMEM * 2 + vseg * 64;
    const unsigned vl = (unsigned)(vrow * AP_VP + vseg * 64);
    AP_LOAD(vg);
    float mx = -3.0e38f;
#pragma unroll
    for (int kt = 0; kt < 16; ++kt) mx = fmaxf(mx, fmaxf(fmaxf(s[kt][0], s[kt][1]), fmaxf(s[kt][2], s[kt][3])));
    mx = fmaxf(mx, __shfl_xor(mx, 16)); mx = fmaxf(mx, __shfl_xor(mx, 32));
    float sum = 0.f;
#pragma unroll
    for (int kt = 0; kt < 16; ++kt) {
#pragma unroll
        for (int j = 0; j < 4; ++j) { const float e = __expf(s[kt][j] - mx); s[kt][j] = e; sum += e; } }
    sum += __shfl_xor(sum, 16); sum += __shfl_xor(sum, 32);
    const float inv = 1.0f / sum;
    bf16x8 pf[8];
#pragma unroll
    for (int kk = 0; kk < 8; ++kk) pf[kk] = pack8(s[2 * kk], s[2 * kk + 1]);
    AP_STORE(0, vl); LDS_BAR();
    bf16* O = WSP(bf16, WS_O) + (size_t)R * D + h * 512 + 4 * g;
#pragma unroll
    for (int u = 0; u < 8; ++u) {
        if (u + 1 < 8) AP_LOAD(vg + (size_t)(u + 1) * 64 * NMEM * 2);
        SCHED_FENCE();
#pragma unroll
        for (int i = 0; i < 4; ++i) { f32x4 o = (f32x4){0.f, 0.f, 0.f, 0.f};
#pragma unroll
            for (int kk = 0; kk < 8; ++kk) { const LAS unsigned char* vp = L0 + (u & 1) * AP_BUF + (16 * i + c16) * AP_VP + kk * 64 + g * 8; const v2u lo = *(const LAS v2u*)vp, hi = *(const LAS v2u*)(vp + 32);
                v4u wv; wv.x = lo.x; wv.y = lo.y; wv.z = hi.x; wv.w = hi.y; o = MFMA16(__builtin_bit_cast(bf16x8, wv), pf[kk], o); }
            o = o * inv;
            { v2u wv; wv.x = pg8::cvt_pk_bf16(o[0], o[1]); wv.y = pg8::cvt_pk_bf16(o[2], o[3]); *(GAS v2u*)(O + (4 * u + i) * 16) = wv; } }
        SCHED_FENCE();
        if (u + 1 < 8) AP_STORE((u + 1) & 1, vl);
        LDS_BAR(); }
#undef AP_LOAD
#undef AP_STORE
}
__device__ __forceinline__ void p8_attn_prompt(Frame& F, const Args& A, int rank, int ngrp) {
    if (rank < 0) return;
    for (int it = rank; it < NBP * 4 * (TP / 128); it += ngrp) attn_prompt_wg(F, A, it >> 6, (it >> 4) & 3, it & 15);
}

__device__ __forceinline__ float conv4(const float* cur, int t, const float* st, int sp, float w0, float w1, float w2, float w3, float bias) {
    const float x3 = cur[0];
    const float x2 = t >= 1 ? cur[-(ptrdiff_t)DINP] : (st ? st[2 * sp] : 0.f);
    const float x1 = t >= 2 ? cur[-(ptrdiff_t)2 * DINP] : (st ? st[(t + 1) * sp] : 0.f);
    const float x0 = t >= 3 ? cur[-(ptrdiff_t)3 * DINP] : (st ? st[t * sp] : 0.f);
    return bias + w0 * x0 + w1 * x1 + w2 * x2 + w3 * x3;
}
constexpr int LR_U32 = 0, LR_UB = 32768, LR_UBP = 136, LR_A32 = 50176, LR_B32 = 66560, LR_SEG = 82944, LR_CAR = 85504;
#define LDG_F32(base_, voff_) (*(const GAS float*)((const GAS char*)(base_) + (voff_)))
template <bool SAMPLE, int PROBE = 0  >
__device__ __forceinline__ void lru_item(Frame& F, const Args& A, int sidx, int h, int half) {
    LAS float* U32 = (LAS float*)(F.lds + LR_U32); LAS bf16* UB = (LAS bf16*)(F.lds + LR_UB); LAS float* A32 = (LAS float*)(F.lds + LR_A32); LAS float* B32 = (LAS float*)(F.lds + LR_B32);
    LAS float* SEG = (LAS float*)(F.lds + LR_SEG); LAS float* CAR = (LAS float*)(F.lds + LR_CAR);
    const int tid = F.tid, lane = F.lane, w = F.wave, c16 = lane & 15, g = lane >> 4;
    const float* P = WSP(float, WS_PROJ);
    const bf16* WL = WSP(bf16, WS_WL) + (size_t)h * 256 * 128;
    const int nt = w & 3, mt0 = 2 * (w >> 2), hcol0 = 64 * half + 16 * nt;
    bf16x8 ba[4], bx[4];
#pragma unroll
    for (int ks = 0; ks < 4; ++ks) { ba[ks] = *(const GAS bf16x8*)(WL + (size_t)(hcol0 + c16) * 128 + ks * 32 + 8 * g); bx[ks] = *(const GAS bf16x8*)(WL + (size_t)(128 + hcol0 + c16) * 128 + ks * 32 + 8 * g); }
    const int mch = h * 128 + hcol0 + c16;
    const float b_a = INP(I_LBA)[mch], b_x = INP(I_LBX)[mch], cl = -8.0f * softplus_f(-INP(I_LLAM)[mch]);
    const int tq = w >> 1, cc = (w & 1) * 64 + lane, ch = h * 128 + cc;
    const unsigned voffx = (unsigned)(C_XL + ch) * 4u, voffg = (unsigned)(C_GL + h * 128 + 64 * half + lane) * 4u;
    const float cw0 = INP(I_LCW)[ch], cw1 = INP(I_LCW)[D + ch], cw2 = INP(I_LCW)[2 * D + ch], cw3 = INP(I_LCW)[3 * D + ch], cb = INP(I_LCB)[ch];
    const int nchunk = SAMPLE ? 1 : TP / 64;
    if (tid < 64) CAR[tid] = 0.f;
    float raw[2][22];
#define LRU_ISSUE(chunk_, st_) do { \
        if (SAMPLE) { \
            _Pragma("unroll") for (int q = 0; q < 2; ++q) { const int sq_ = sidx * 8 + tq * 2 + q; \
                _Pragma("unroll") for (int k = 0; k < 3; ++k) raw[st_][q * 11 + k] = LDG_F32(INP(I_SLC) + (size_t)(sq_ * 3 + k) * D, (unsigned)ch * 4u); \
                _Pragma("unroll") for (int t = 0; t < 8; ++t) raw[st_][q * 11 + 3 + t] = LDG_F32(P + (size_t)(MP + sq_ * 8 + t) * DINP, voffx); } \
        } else { \
            const int R0_ = sidx * TP + (chunk_) * 64 + tq * 16; \
            _Pragma("unroll") for (int i = 0; i < 19; ++i) { const bool ok = ((chunk_) > 0 || tq > 0 || i >= 3); raw[st_][i] = ok ? LDG_F32(P + (size_t)(R0_ - 3 + i) * DINP, voffx) : 0.f; } \
        } } while (0)
    LRU_ISSUE(0, 0);
    float ggn[8];
    { const int R0f = SAMPLE ? MP + sidx * 64 : sidx * TP;
#pragma unroll
      for (int i = 0; i < 8; ++i) ggn[i] = LDG_F32(P + (size_t)(R0f + 8 * w + i) * DINP, voffg); }
#pragma unroll 2
    for (int chunk = 0; chunk < nchunk; ++chunk) {
        int ln_ = lane; asm volatile("" : "+v"(ln_));
        const int lane = ln_, c16 = lane & 15, g = lane >> 4, cc = (w & 1) * 64 + lane;
        const int R0 = SAMPLE ? MP + sidx * 64 : sidx * TP + chunk * 64;
        if (chunk + 1 < nchunk) { if (chunk & 1) LRU_ISSUE(chunk + 1, 0); else LRU_ISSUE(chunk + 1, 1); }
        float gg[8];
#pragma unroll
        for (int i = 0; i < 8; ++i) gg[i] = ggn[i];
        if (chunk + 1 < nchunk) {
#pragma unroll
            for (int i = 0; i < 8; ++i) ggn[i] = LDG_F32(P + (size_t)(R0 + 64 + 8 * w + i) * DINP, voffg); }
#pragma unroll
        for (int i = 0; i < 16; ++i) { const int r = tq * 16 + i; const int o = SAMPLE ? (i >> 3) * 11 + (i & 7) : i;
            const float u = (chunk & 1) ? cb + cw0 * raw[1][o] + cw1 * raw[1][o + 1] + cw2 * raw[1][o + 2] + cw3 * raw[1][o + 3] : cb + cw0 * raw[0][o] + cw1 * raw[0][o + 1] + cw2 * raw[0][o + 2] + cw3 * raw[0][o + 3];
            U32[r * 128 + cc] = u; UB[r * LR_UBP + cc] = (bf16)f2bf(u); }
        LDS_BAR();
        f32x4 ra[2], rx[2];
#pragma unroll
        for (int mi = 0; mi < 2; ++mi) { ra[mi] = (f32x4){0.f, 0.f, 0.f, 0.f}; rx[mi] = (f32x4){0.f, 0.f, 0.f, 0.f};
#pragma unroll
            for (int ks = 0; ks < 4; ++ks) { const bf16x8 af = *(const LAS bf16x8*)(UB + (16 * (mt0 + mi) + c16) * LR_UBP + ks * 32 + 8 * g); ra[mi] = MFMA16(af, ba[ks], ra[mi]); rx[mi] = MFMA16(af, bx[ks], rx[mi]); } }
#pragma unroll
        for (int mi = 0; mi < (PROBE >= 4 ? 0 : 2); ++mi)
#pragma unroll
            for (int j = 0; j < 4; ++j) { const int r = 16 * (mt0 + mi) + 4 * g + j; const float rr = sigmoid_f(ra[mi][j] + b_a), ii = sigmoid_f(rx[mi][j] + b_x), la = cl * rr;
                const float a = __expf(la), x2 = 2.0f * la;
                const float m2 = x2 > -0.25f ? -x2 * (1.0f + x2 * (0.5f + x2 * (0.16666667f + x2 * (0.041666668f + x2 * 0.0083333338f)))) : 1.0f - a * a;
                const float u = U32[r * 128 + hcol0 + c16]; A32[r * 64 + 16 * nt + c16] = a; B32[r * 64 + 16 * nt + c16] = __builtin_amdgcn_sqrtf(m2) * ii * u; }
        LDS_BAR();
        if (tid < 256 && PROBE < 3) { const int cch = tid & 63, seg = tid >> 6;
            if (SAMPLE) {
#pragma unroll
                for (int q = 0; q < 2; ++q) { const int sq = sidx * 8 + seg * 2 + q; float hh = INP(I_SLH)[(size_t)sq * D + h * 128 + 64 * half + cch];
#pragma unroll
                    for (int t = 0; t < 8; ++t) { const int r = 16 * seg + 8 * q + t; hh = A32[r * 64 + cch] * hh + B32[r * 64 + cch]; B32[r * 64 + cch] = hh; }
                    F.out[O_SLH + (size_t)sq * D + h * 128 + 64 * half + cch] = hh; }
            } else {
                float ap = 1.f, hp = 0.f;
#pragma unroll
                for (int i = 0; i < 16; ++i) { const int r = 16 * seg + i; const float a = A32[r * 64 + cch]; hp = a * hp + B32[r * 64 + cch]; ap *= a; }
                SEG[seg * 64 + cch] = ap; SEG[256 + seg * 64 + cch] = hp;
            } }
        if (!SAMPLE) {
            LDS_BAR();
            if (tid < 256 && PROBE < 3) { const int cch = tid & 63, seg = tid >> 6; float hh = CAR[cch];
#pragma unroll
                for (int s2 = 0; s2 < 3; ++s2) if (s2 < seg) hh = SEG[s2 * 64 + cch] * hh + SEG[256 + s2 * 64 + cch];
#pragma unroll
                for (int i = 0; i < 16; ++i) { const int r = 16 * seg + i; hh = A32[r * 64 + cch] * hh + B32[r * 64 + cch]; B32[r * 64 + cch] = hh; }
                if (seg == 3) { SEG[512 + cch] = hh; if (chunk == nchunk - 1 && PROBE == 0) F.out[O_PLH + (size_t)sidx * D + h * 128 + 64 * half + cch] = hh; } }
        }
        LDS_BAR();
        if (!SAMPLE && tid < 64) CAR[tid] = SEG[512 + tid];
        if (PROBE < 2) { float q[8];
#pragma unroll
            for (int i = 0; i < 8; ++i) { const int r = 8 * w + i, R = R0 + r;
                const float v0 = B32[r * 64 + lane] * gelu_tanh_f(gg[i]); q[i] = v0 * v0;
                if (PROBE == 0 || v0 == 1.2345e38f) WSP(bf16, WS_V)[(size_t)R * DMIX + h * 128 + 64 * half + lane] = (bf16)f2bf(v0); }
#pragma unroll
            for (int o = 1; o < 64; o <<= 1) {
#pragma unroll
                for (int i = 0; i < 8; ++i) q[i] += __shfl_xor(q[i], o); }
            float qs = q[0];
#pragma unroll
            for (int i = 1; i < 8; ++i) qs = (lane == i) ? q[i] : qs;
            if (lane < 8 && (PROBE == 0 || qs == 1.2345e38f)) WSP(float, WS_SQV)[(size_t)(R0 + 8 * w + lane) * NSQV + 2 * h + half] = qs; }
        LDS_BAR();
    }
#undef LRU_ISSUE
}
constexpr int SD_WX = 107520, SD_RX = 108800, SD_CS = 0, SD_DT = 256, SD_WG = 512, SD_CM = 1024, SD_BM = 18432, SD_BT = 35840, SD_XT = 54272, SD_XS = 63488, SD_HB = 72704, SD_XF = 90112;
constexpr int SP136 = 136, SP72 = 72, SP68 = 68;
template <int L  , int PROBE = 0  >
__device__ __forceinline__ void ssd_item(Frame& F, const Args& A, int sq, int head) {
    constexpr bool SAMPLE = (L == 16); constexpr int LT = L / 16, KK = (L + 31) / 32, TV = SAMPLE ? TS : L;
    LAS float* CS = (LAS float*)(F.lds + SD_CS); LAS float* DT = (LAS float*)(F.lds + SD_DT); LAS float* WG = (LAS float*)(F.lds + SD_WG);
    LAS bf16* CM = (LAS bf16*)(F.lds + SD_CM); LAS bf16* BM = (LAS bf16*)(F.lds + SD_BM); LAS bf16* BT = (LAS bf16*)(F.lds + SD_BT);
    LAS bf16* XT = (LAS bf16*)(F.lds + SD_XT); LAS bf16* XS = (LAS bf16*)(F.lds + SD_XS); LAS bf16* HB = (LAS bf16*)(F.lds + SD_HB); LAS float* XF = (LAS float*)(F.lds + SD_XF);
    const int tid = F.tid, lane = F.lane, w = F.wave, c16 = lane & 15, g = lane >> 4, grp = head >> 4;
    const float* P = WSP(float, WS_PROJ);
    const float Aneg = -__expf(INP(I_SALOG)[head]), dtb = INP(I_SDTB)[head], Dh = INP(I_SD)[head];
    const int hpt = w & 3, hnt0 = 4 * (w >> 2);
    f32x4 Hacc[4];
    const size_t hbase = ((size_t)(sq * SSD_H + head) * SSD_P) * SSD_N;
#pragma unroll
    for (int i = 0; i < 4; ++i)
#pragma unroll
        for (int j = 0; j < 4; ++j) Hacc[i][j] = SAMPLE ? INP(I_SSH)[hbase + (size_t)(16 * hpt + 4 * g + j) * SSD_N + 16 * (hnt0 + i) + c16] : 0.f;
    const int cgb = lane, rbb = w, gx = lane & 15, rsub = lane >> 4, rp = 4 * w + rsub;
    const int xcb = 2048 + (cgb >> 5) * 256 + grp * 128 + 4 * (cgb & 31), xcx = head * 64 + 4 * gx;
    const bool actB = SAMPLE ? (w < 2) : true, actX = SAMPLE ? (w < 2) : true;
    const unsigned voffb = (unsigned)(C_XBC + xcb) * 4u, voffxx = (unsigned)(rsub * 2 * DINP + C_XBC + xcx) * 4u, voffxs = (unsigned)(rsub * 2 * XBC + xcx) * 4u;
    f32x4 wB[4], wX[4], bB, bX;
#pragma unroll
    for (int k = 0; k < 4; ++k) { wB[k] = *(const GAS f32x4*)(INP(I_SCW) + (size_t)k * XBC + xcb); wX[k] = *(const GAS f32x4*)(INP(I_SCW) + (size_t)k * XBC + xcx); }
    bB = *(const GAS f32x4*)(INP(I_SCB) + xcb); bX = *(const GAS f32x4*)(INP(I_SCB) + xcx);
    f32x4 rawB[11], rawX[5]; float rawdt = 0.f;
    v4u rawBC4[2][4]; f32x4 rawXr[2][2]; float rawdt2[2] = {0.f, 0.f};
    const unsigned voffbc2 = (unsigned)(lane * 1024 + (w < 4 ? grp * 128 + 32 * w : 256 + grp * 128 + 32 * (w - 4)) * 2);
    const unsigned voffx2 = (unsigned)(lane * DINP + C_XBC + head * 64 + 8 * w) * 4u;
    LAS float* RX = (LAS float*)(F.lds + SD_RX) + w * (67 * 8);
    if (!SAMPLE && lane < 6) *(LAS f32x4*)(RX + lane * 4) = (f32x4){0.f, 0.f, 0.f, 0.f};
    LAS f32x4* WX = (LAS f32x4*)(F.lds + SD_WX) + w * 10;
    if (!SAMPLE && lane < 10) { const int k = lane >> 1, q = lane & 1; WX[lane] = k < 4 ? *(const GAS f32x4*)(INP(I_SCW) + (size_t)k * XBC + head * 64 + 8 * w + 4 * q) : *(const GAS f32x4*)(INP(I_SCB) + head * 64 + 8 * w + 4 * q); }
#define SSD_LDROW(dst_, chunk_, rr_, rl_, vp_, vs_) do { const int rr__ = (rr_); const int tu__ = SAMPLE ? rr__ : (chunk_) * 64 + rr__; const int tl__ = SAMPLE ? (rl_) : (chunk_) * 64 + (rl_); \
        const GAS char* pb__ = (const GAS char*)(P + (size_t)((SAMPLE ? MP + sq * TS : sq * TP + (chunk_) * 64) + rr__) * DINP); \
        const GAS char* sb__ = (const GAS char*)(INP(I_SSC) + (size_t)(sq * 3 + 3 + tu__) * XBC); \
        if ((rl_) >= TV) dst_ = (f32x4){0.f, 0.f, 0.f, 0.f}; \
        else if (tl__ >= 0) dst_ = *(const GAS f32x4*)(pb__ + (vp_)); \
        else if (SAMPLE) dst_ = *(const GAS f32x4*)(sb__ + (vs_)); \
        else dst_ = (f32x4){0.f, 0.f, 0.f, 0.f}; } while (0)
#define SSD_ISSUE(chunk_, st_) do { \
        if (SAMPLE) { if (actB) { _Pragma("unroll") for (int i = 0; i < 11; ++i) SSD_LDROW(rawB[i], chunk_, 8 * rbb - 3 + i, 8 * rbb - 3 + i, voffb, (unsigned)xcb * 4u); } \
            if (actX) { _Pragma("unroll") for (int i = 0; i < 5; ++i) SSD_LDROW(rawX[i], chunk_, 8 * w - 3 + i, 2 * rp - 3 + i, voffxx, voffxs); } } \
        else { const GAS char* bc_ = (const GAS char*)(WSP(bf16, WS_BCC) + (size_t)(sq * TP + (chunk_) * 64) * 512) + voffbc2; \
            _Pragma("unroll") for (int i = 0; i < 4; ++i) rawBC4[st_][i] = *(const GAS v4u*)(bc_ + i * 16); \
            const GAS char* px_ = (const GAS char*)(P + (size_t)(sq * TP + (chunk_) * 64) * DINP) + voffx2; \
            _Pragma("unroll") for (int q = 0; q < 2; ++q) rawXr[st_][q] = *(const GAS f32x4*)(px_ + q * 16); \
            if (w == 0) rawdt2[st_] = P[(size_t)(sq * TP + (chunk_) * 64 + lane) * DINP + C_DT + head]; } \
        if (SAMPLE && w == 0) { const int r_ = lane; rawdt = (r_ < TV) ? P[(size_t)(MP + sq * TS + r_) * DINP + C_DT + head] : 0.f; } } while (0)
    SSD_ISSUE(0, 0);
#pragma unroll
    for (int i = 0; i < 4; ++i)
#pragma unroll
        for (int j = 0; j < 4; ++j) HB[(16 * hpt + 4 * g + j) * SP136 + 16 * (hnt0 + i) + c16] = (bf16)f2bf(Hacc[i][j]);
    if (SAMPLE) {
        for (int e = tid; e < 64 * 16; e += 512) { const int p = e >> 4, c = 16 + (e & 15); XT[p * SP72 + c] = 0; XS[p * SP72 + c] = 0; }
        for (int e = tid; e < 128 * 16; e += 512) { const int n = e >> 4, c = 16 + (e & 15); BT[n * SP72 + c] = 0; }
    }
    const int nchunk = SAMPLE ? 1 : TP / 64;
    constexpr int NPT0 = (L == 64) ? 2 : 1; f32x4 z4n[NPT0];
    const unsigned voffz = (unsigned)(c16 * DINP + C_Z + head * 64 + 16 * ((L == 64) ? 2 * (w >> 2) : (w & 3)) + 4 * g) * 4u;
    { const int lt0 = (L == 64) ? (w & 3) : 0; const int R0f = SAMPLE ? MP + sq * TS : sq * TP;
#pragma unroll
      for (int pi = 0; pi < NPT0; ++pi) { z4n[pi] = (f32x4){0.f, 0.f, 0.f, 0.f}; if (16 * lt0 + c16 < TV) z4n[pi] = *(const GAS f32x4*)((const GAS char*)(P + (size_t)(R0f + 16 * lt0) * DINP) + voffz + pi * 64); } }
#pragma unroll 2
    for (int chunk = 0; chunk < nchunk; ++chunk) {
        int ln_ = lane; asm volatile("" : "+v"(ln_));
        const int lane = ln_, c16 = lane & 15, g = lane >> 4, cgb = lane, gx = lane & 15, rsub = lane >> 4, rp = 4 * w + rsub;
        const int R0 = SAMPLE ? MP + sq * TS : sq * TP + chunk * 64;
        if (!SAMPLE && chunk + 1 < nchunk) { if (chunk & 1) SSD_ISSUE(chunk + 1, 0); else SSD_ISSUE(chunk + 1, 1); }
        const int lt_ = (L == 64) ? (w & 3) : 0, l_ = 16 * lt_ + c16; constexpr int NPT = (L == 64) ? 2 : 1; const int pt0_ = (L == 64) ? 2 * (w >> 2) : (w & 3);
        f32x4 z4[NPT];
#pragma unroll
        for (int pi = 0; pi < NPT; ++pi) z4[pi] = z4n[pi];
        if (chunk + 1 < nchunk) {
#pragma unroll
            for (int pi = 0; pi < NPT; ++pi) z4n[pi] = *(const GAS f32x4*)((const GAS char*)(P + (size_t)(R0 + 64 + 16 * lt_) * DINP) + voffz + pi * 64); }
        if (SAMPLE) {
        if (actB) {
#pragma unroll
            for (int i = 0; i < 8; ++i) { const int r = 8 * rbb + i; v2u pk;
                if (SAMPLE) { f32x4 v = bB + wB[0] * rawB[i] + wB[1] * rawB[i + 1] + wB[2] * rawB[i + 2] + wB[3] * rawB[i + 3];
                    if (r >= TV) v = (f32x4){0.f, 0.f, 0.f, 0.f}; else { v[0] = siluf_(v[0]); v[1] = siluf_(v[1]); v[2] = siluf_(v[2]); v[3] = siluf_(v[3]); }
                    pk.x = pk2(v[0], v[1]); pk.y = pk2(v[2], v[3]); }
                else { pk.x = 0u; pk.y = 0u; }
                const int n = 4 * (cgb & 31);
                if (cgb < 32) { *(LAS v2u*)(BM + r * SP136 + n) = pk; BT[(n + 0) * SP72 + r] = (bf16)(pk.x & 0xffffu); BT[(n + 1) * SP72 + r] = (bf16)(pk.x >> 16); BT[(n + 2) * SP72 + r] = (bf16)(pk.y & 0xffffu); BT[(n + 3) * SP72 + r] = (bf16)(pk.y >> 16); }
                else *(LAS v2u*)(CM + r * SP136 + n) = pk; } }
        if (actX) {
#pragma unroll
            for (int i = 0; i < 2; ++i) { const int r = 2 * rp + i; f32x4 v = bX + wX[0] * rawX[i] + wX[1] * rawX[i + 1] + wX[2] * rawX[i + 2] + wX[3] * rawX[i + 3];
                if (r >= TV) v = (f32x4){0.f, 0.f, 0.f, 0.f}; else { v[0] = siluf_(v[0]); v[1] = siluf_(v[1]); v[2] = siluf_(v[2]); v[3] = siluf_(v[3]); }
                *(LAS f32x4*)(XF + r * SP68 + 4 * gx) = v; const unsigned p0 = pk2(v[0], v[1]), p1 = pk2(v[2], v[3]); const int p = 4 * gx;
                XT[(p + 0) * SP72 + r] = (bf16)(p0 & 0xffffu); XT[(p + 1) * SP72 + r] = (bf16)(p0 >> 16); XT[(p + 2) * SP72 + r] = (bf16)(p1 & 0xffffu); XT[(p + 3) * SP72 + r] = (bf16)(p1 >> 16); } }
        } else {
#pragma unroll
            for (int i = 0; i < 4; ++i) { const v4u v = (chunk & 1) ? rawBC4[1][i] : rawBC4[0][i]; const int n0 = 32 * (w & 3) + 8 * i;
                if (w < 4) { *(LAS v4u*)(BM + lane * SP136 + n0) = v;
                    BT[(n0 + 0) * SP72 + lane] = (bf16)(v.x & 0xffffu); BT[(n0 + 1) * SP72 + lane] = (bf16)(v.x >> 16); BT[(n0 + 2) * SP72 + lane] = (bf16)(v.y & 0xffffu); BT[(n0 + 3) * SP72 + lane] = (bf16)(v.y >> 16);
                    BT[(n0 + 4) * SP72 + lane] = (bf16)(v.z & 0xffffu); BT[(n0 + 5) * SP72 + lane] = (bf16)(v.z >> 16); BT[(n0 + 6) * SP72 + lane] = (bf16)(v.w & 0xffffu); BT[(n0 + 7) * SP72 + lane] = (bf16)(v.w >> 16); }
                else *(LAS v4u*)(CM + lane * SP136 + n0) = v; }
            f32x4 xr[2]; xr[0] = (chunk & 1) ? rawXr[1][0] : rawXr[0][0]; xr[1] = (chunk & 1) ? rawXr[1][1] : rawXr[0][1];
            *(LAS f32x4*)(RX + (lane + 3) * 8) = xr[0]; *(LAS f32x4*)(RX + (lane + 3) * 8 + 4) = xr[1];
            f32x4 xm[3][2];
#pragma unroll
            for (int k = 0; k < 3; ++k) { xm[k][0] = *(const LAS f32x4*)(RX + (lane + k) * 8); xm[k][1] = *(const LAS f32x4*)(RX + (lane + k) * 8 + 4); }
            asm volatile("s_waitcnt lgkmcnt(0)" ::: "memory");
            if (lane >= 61) { *(LAS f32x4*)(RX + (lane - 61) * 8) = xr[0]; *(LAS f32x4*)(RX + (lane - 61) * 8 + 4) = xr[1]; }
#pragma unroll
            for (int q = 0; q < 2; ++q) { f32x4 v = WX[8 + q] + WX[q] * xm[0][q] + WX[2 + q] * xm[1][q] + WX[4 + q] * xm[2][q] + WX[6 + q] * xr[q];
                v[0] = siluf_(v[0]); v[1] = siluf_(v[1]); v[2] = siluf_(v[2]); v[3] = siluf_(v[3]);
                *(LAS f32x4*)(XF + lane * SP68 + 8 * w + 4 * q) = v; const unsigned p0 = pk2(v[0], v[1]), p1 = pk2(v[2], v[3]); const int p = 8 * w + 4 * q;
                XT[(p + 0) * SP72 + lane] = (bf16)(p0 & 0xffffu); XT[(p + 1) * SP72 + lane] = (bf16)(p0 >> 16); XT[(p + 2) * SP72 + lane] = (bf16)(p1 & 0xffffu); XT[(p + 3) * SP72 + lane] = (bf16)(p1 >> 16); }
        }
        if (w == 0) { const int r = lane; float dt = 0.f;
            if (r < TV) dt = softplus_f((SAMPLE ? rawdt : ((chunk & 1) ? rawdt2[1] : rawdt2[0])) + dtb);
            float cs = dt * Aneg;
#pragma unroll
            for (int o = 1; o < 64; o <<= 1) { const float up = __shfl_up(cs, o); if (lane >= o) cs += up; }
            const float csl = __shfl(cs, L - 1);
            if (r < L) { CS[r] = cs; DT[r] = dt; WG[r] = __expf(csl - cs) * dt; } }
        LDS_BAR();
        if (PROBE >= 4) {} else if (SAMPLE) { for (int e = tid; e < 64 * L; e += 512) { const int p = e & 63, l = e >> 6; XS[p * SP72 + l] = (bf16)f2bf(XF[l * SP68 + p] * WG[l]); } }
        else { const float wg = WG[lane]; const f32x4 x0 = *(const LAS f32x4*)(XF + lane * SP68 + 8 * w), x1 = *(const LAS f32x4*)(XF + lane * SP68 + 8 * w + 4);
#pragma unroll
            for (int j = 0; j < 4; ++j) { XS[(8 * w + j) * SP72 + lane] = (bf16)f2bf(x0[j] * wg); XS[(8 * w + 4 + j) * SP72 + lane] = (bf16)f2bf(x1[j] * wg); } }
        LDS_BAR();
        if ((L == 64 || w < 4) && PROBE < 2) {
            const int l = l_, pt0 = pt0_;
            bf16x8 cf[4];
#pragma unroll
            for (int ks = 0; ks < 4; ++ks) cf[ks] = *(const LAS bf16x8*)(CM + l * SP136 + ks * 32 + 8 * g);
            const float cs_l = CS[l];
            f32x4 gt[2 * KK];
#pragma unroll
            for (int st = 0; st < 2 * KK; ++st) { gt[st] = (f32x4){0.f, 0.f, 0.f, 0.f};
                if (st < LT) {
#pragma unroll
                    for (int ks = 0; ks < 4; ++ks) { const bf16x8 af = *(const LAS bf16x8*)(BM + (16 * st + c16) * SP136 + ks * 32 + 8 * g); gt[st] = MFMA16(af, cf[ks], gt[st]); }
                    { const f32x4 css = *(const LAS f32x4*)(CS + 16 * st + 4 * g), dts = *(const LAS f32x4*)(DT + 16 * st + 4 * g);
#pragma unroll
                      for (int j = 0; j < 4; ++j) { const float e = __expf(fminf(cs_l - css[j], 0.f)) * dts[j]; const float val = gt[st][j] * e; gt[st][j] = (16 * st + 4 * g + j <= l) ? val : 0.f; } } } }
            bf16x8 wf[KK];
#pragma unroll
            for (int kk = 0; kk < KK; ++kk) wf[kk] = pack8(gt[2 * kk], gt[2 * kk + 1]);
            const float ecl = __expf(cs_l); const bool valid = (l < TV); const int R = R0 + l;
            f32x4 a1[NPT], a2[NPT];
#pragma unroll
            for (int pi = 0; pi < NPT; ++pi) { const int pt = pt0 + pi; a1[pi] = (f32x4){0.f, 0.f, 0.f, 0.f}; a2[pi] = (f32x4){0.f, 0.f, 0.f, 0.f};
#pragma unroll
                for (int kk = 0; kk < KK; ++kk) { const v2u lo = *(const LAS v2u*)(XT + (16 * pt + c16) * SP72 + 32 * kk + 4 * g), hi = *(const LAS v2u*)(XT + (16 * pt + c16) * SP72 + 32 * kk + 16 + 4 * g);
                    v4u wv; wv.x = lo.x; wv.y = lo.y; wv.z = hi.x; wv.w = hi.y; a1[pi] = MFMA16(__builtin_bit_cast(bf16x8, wv), wf[kk], a1[pi]); }
#pragma unroll
                for (int ks = 0; ks < 4; ++ks) { const bf16x8 af = *(const LAS bf16x8*)(HB + (16 * pt + c16) * SP136 + ks * 32 + 8 * g); a2[pi] = MFMA16(af, cf[ks], a2[pi]); } }
            float qq[NPT]; v2u oo[NPT];
#pragma unroll
            for (int pi = 0; pi < NPT; ++pi) { const f32x4 x4 = *(const LAS f32x4*)(XF + l * SP68 + 16 * (pt0 + pi) + 4 * g); float v[4]; qq[pi] = 0.f;
#pragma unroll
                for (int j = 0; j < 4; ++j) { const float y = a1[pi][j] + ecl * a2[pi][j] + Dh * x4[j]; v[j] = y * siluf_(z4[pi][j]); qq[pi] += v[j] * v[j]; }
                oo[pi].x = pk2(v[0], v[1]); oo[pi].y = pk2(v[2], v[3]); }
#pragma unroll
            for (int pi = 0; pi < NPT; ++pi) qq[pi] += __shfl_xor(qq[pi], 16);
#pragma unroll
            for (int pi = 0; pi < NPT; ++pi) qq[pi] += __shfl_xor(qq[pi], 32);
            if (valid && (PROBE == 0 || qq[0] == 1.2345e38f)) {
#pragma unroll
                for (int pi = 0; pi < NPT; ++pi) *(GAS v2u*)(WSP(bf16, WS_V) + (size_t)R * DMIX + 2048 + head * 64 + 16 * (pt0 + pi) + 4 * g) = oo[pi];
                if (g == 0) {
#pragma unroll
                    for (int pi = 0; pi < NPT; ++pi) WSP(float, WS_SQV)[(size_t)R * NSQV + 32 + head * 4 + pt0 + pi] = qq[pi]; } }
        }
        LDS_BAR();
        if (PROBE < 3) { const float dec = __expf(CS[L - 1]);
#pragma unroll
          for (int i = 0; i < 4; ++i) Hacc[i] = Hacc[i] * dec;
#pragma unroll
          for (int kk = 0; kk < KK; ++kk) { const bf16x8 af = *(const LAS bf16x8*)(XS + (16 * hpt + c16) * SP72 + 32 * kk + 8 * g);
#pragma unroll
              for (int i = 0; i < 4; ++i) { const bf16x8 bfr = *(const LAS bf16x8*)(BT + (16 * (hnt0 + i) + c16) * SP72 + 32 * kk + 8 * g); Hacc[i] = MFMA16(af, bfr, Hacc[i]); } }
          if (chunk + 1 < nchunk) {
#pragma unroll
              for (int i = 0; i < 4; ++i)
#pragma unroll
                  for (int j = 0; j < 4; ++j) HB[(16 * hpt + 4 * g + j) * SP136 + 16 * (hnt0 + i) + c16] = (bf16)f2bf(Hacc[i][j]); } }
        LDS_BAR();
    }
    float* ho = F.out + (SAMPLE ? O_SSH : O_PSH) + hbase;
#pragma unroll
    for (int i = 0; i < 4; ++i)
#pragma unroll
        for (int j = 0; j < 4; ++j) if (PROBE == 0 || Hacc[i][j] == 1.2345e38f) ho[(size_t)(16 * hpt + 4 * g + j) * SSD_N + 16 * (hnt0 + i) + c16] = Hacc[i][j];
}
__device__ __forceinline__ void ssd_sample4(Frame& F, const Args& A, int sq, int hq) {
    LAS float* CS = (LAS float*)(F.lds + SD_CS); LAS float* DT = (LAS float*)(F.lds + SD_DT); LAS float* WG = (LAS float*)(F.lds + SD_WG);
    LAS bf16* CM = (LAS bf16*)(F.lds + SD_CM); LAS bf16* BM = (LAS bf16*)(F.lds + SD_BM); LAS bf16* BT = (LAS bf16*)(F.lds + SD_BT);
    LAS bf16* XT = (LAS bf16*)(F.lds + SD_XT); LAS bf16* XS = (LAS bf16*)(F.lds + SD_XS); LAS bf16* HB = (LAS bf16*)(F.lds + SD_HB); LAS float* XF = (LAS float*)(F.lds + SD_XF);
    const int tid = F.tid, lane = F.lane, w = F.wave, c16 = lane & 15, g = lane >> 4, head0 = 4 * hq, grp = head0 >> 4;
    const float* P = WSP(float, WS_PROJ); const int R0 = MP + sq * TS;
    const int hpt = w & 3, hnt0 = 4 * (w >> 2);
    f32x4 Hacc[4][4];
#pragma unroll
    for (int hh = 0; hh < 4; ++hh)
#pragma unroll
        for (int i = 0; i < 4; ++i) Hacc[hh][i] = *(const GAS f32x4*)(INP(I_SSH) + ((size_t)(sq * SSD_H + head0 + hh) * SSD_P + 16 * hpt + c16) * SSD_N + 16 * (hnt0 + i) + 4 * g);
    const int r = w, xcb = 2048 + (lane >> 5) * 256 + grp * 128 + 4 * (lane & 31), xh = lane >> 4, xcx = (head0 + xh) * 64 + 4 * (lane & 15);
    f32x4 tb[4], tx[4];
#pragma unroll
    for (int k = 0; k < 4; ++k) { const int t = r - 3 + k;
        const float* src = t >= 0 ? P + (size_t)(R0 + t) * DINP + C_XBC : INP(I_SSC) + (size_t)(sq * 3 + 3 + t) * XBC;
        tb[k] = *(const GAS f32x4*)(src + xcb); tx[k] = *(const GAS f32x4*)(src + xcx); }
    f32x4 z4[4];
#pragma unroll
    for (int hh = 0; hh < 4; ++hh) { z4[hh] = (f32x4){0.f, 0.f, 0.f, 0.f}; if (w < 4 && c16 < TS) z4[hh] = *(const GAS f32x4*)(P + (size_t)(R0 + c16) * DINP + C_Z + (head0 + hh) * 64 + 16 * w + 4 * g); }
    float rawdt = 0.f; if (w < 4 && lane < TS) rawdt = P[(size_t)(R0 + lane) * DINP + C_DT + head0 + w];
    f32x4 wb[4], wx[4];
#pragma unroll
    for (int k = 0; k < 4; ++k) { wb[k] = *(const GAS f32x4*)(INP(I_SCW) + (size_t)k * XBC + xcb); wx[k] = *(const GAS f32x4*)(INP(I_SCW) + (size_t)k * XBC + xcx); }
    const f32x4 bb = *(const GAS f32x4*)(INP(I_SCB) + xcb), bx = *(const GAS f32x4*)(INP(I_SCB) + xcx);
    for (int e = tid; e < 128 * 8; e += 512) { const int n = e >> 3, c = 16 + 2 * (e & 7); *(LAS unsigned*)(BT + n * SP72 + c) = 0u; }
    for (int e = tid; e < 64 * 8; e += 512) { const int p = e >> 3, c = 16 + 2 * (e & 7); *(LAS unsigned*)(XT + p * SP72 + c) = 0u; *(LAS unsigned*)(XS + p * SP72 + c) = 0u; }
    { f32x4 v = bb + wb[0] * tb[0] + wb[1] * tb[1] + wb[2] * tb[2] + wb[3] * tb[3]; v[0] = siluf_(v[0]); v[1] = siluf_(v[1]); v[2] = siluf_(v[2]); v[3] = siluf_(v[3]);
      v2u pk; pk.x = pk2(v[0], v[1]); pk.y = pk2(v[2], v[3]); const v2u zz = {0u, 0u}; const int n = 4 * (lane & 31);
      if (lane < 32) { *(LAS v2u*)(BM + r * SP136 + n) = pk; *(LAS v2u*)(BM + (r + 8) * SP136 + n) = zz;
          BT[(n + 0) * SP72 + r] = (bf16)(pk.x & 0xffffu); BT[(n + 1) * SP72 + r] = (bf16)(pk.x >> 16); BT[(n + 2) * SP72 + r] = (bf16)(pk.y & 0xffffu); BT[(n + 3) * SP72 + r] = (bf16)(pk.y >> 16);
          BT[(n + 0) * SP72 + r + 8] = 0; BT[(n + 1) * SP72 + r + 8] = 0; BT[(n + 2) * SP72 + r + 8] = 0; BT[(n + 3) * SP72 + r + 8] = 0; }
      else { *(LAS v2u*)(CM + r * SP136 + n) = pk; *(LAS v2u*)(CM + (r + 8) * SP136 + n) = zz; } }
    f32x4 xv = bx + wx[0] * tx[0] + wx[1] * tx[1] + wx[2] * tx[2] + wx[3] * tx[3]; xv[0] = siluf_(xv[0]); xv[1] = siluf_(xv[1]); xv[2] = siluf_(xv[2]); xv[3] = siluf_(xv[3]);
    if (w < 4) { float dt = 0.f; if (lane < TS) dt = softplus_f(rawdt + INP(I_SDTB)[head0 + w]);
        float cs = dt * -__expf(INP(I_SALOG)[head0 + w]);
#pragma unroll
        for (int o = 1; o < 16; o <<= 1) { const float up = __shfl_up(cs, o); if (lane >= o) cs += up; }
        const float csl = __shfl(cs, 15);
        if (lane < 16) { CS[w * 16 + lane] = cs; DT[w * 16 + lane] = dt; WG[w * 16 + lane] = __expf(csl - cs) * dt; } }
    LDS_BAR();
    bf16x8 cf[4]; f32x4 gt0 = (f32x4){0.f, 0.f, 0.f, 0.f};
    if (w < 4) {
#pragma unroll
        for (int ks = 0; ks < 4; ++ks) cf[ks] = *(const LAS bf16x8*)(CM + c16 * SP136 + ks * 32 + 8 * g);
#pragma unroll
        for (int ks = 0; ks < 4; ++ks) { const bf16x8 af = *(const LAS bf16x8*)(BM + c16 * SP136 + ks * 32 + 8 * g); gt0 = MFMA16(af, cf[ks], gt0); } }
#pragma unroll
    for (int hh = 0; hh < 4; ++hh) { const int head = head0 + hh;
#pragma unroll
        for (int i = 0; i < 4; ++i) { v2u hb; hb.x = pk2(Hacc[hh][i][0], Hacc[hh][i][1]); hb.y = pk2(Hacc[hh][i][2], Hacc[hh][i][3]); *(LAS v2u*)(HB + (16 * hpt + c16) * SP136 + 16 * (hnt0 + i) + 4 * g) = hb; }
        if (xh == hh) { const int p = 4 * (lane & 15); *(LAS f32x4*)(XF + r * SP68 + p) = xv; *(LAS f32x4*)(XF + (r + 8) * SP68 + p) = (f32x4){0.f, 0.f, 0.f, 0.f};
            const unsigned p0 = pk2(xv[0], xv[1]), p1 = pk2(xv[2], xv[3]);
            XT[(p + 0) * SP72 + r] = (bf16)(p0 & 0xffffu); XT[(p + 1) * SP72 + r] = (bf16)(p0 >> 16); XT[(p + 2) * SP72 + r] = (bf16)(p1 & 0xffffu); XT[(p + 3) * SP72 + r] = (bf16)(p1 >> 16);
            XT[(p + 0) * SP72 + r + 8] = 0; XT[(p + 1) * SP72 + r + 8] = 0; XT[(p + 2) * SP72 + r + 8] = 0; XT[(p + 3) * SP72 + r + 8] = 0; }
        LDS_BAR();
        for (int e = tid; e < 64 * 16; e += 512) { const int p = e & 63, l = e >> 6; XS[p * SP72 + l] = (bf16)f2bf(XF[l * SP68 + p] * WG[hh * 16 + l]); }
        LDS_BAR();
        if (w < 4) { const int l = c16, pt = w; const float cs_l = CS[hh * 16 + l]; f32x4 gm;
            { const f32x4 css = *(const LAS f32x4*)(CS + hh * 16 + 4 * g), dts = *(const LAS f32x4*)(DT + hh * 16 + 4 * g);
#pragma unroll
              for (int j = 0; j < 4; ++j) { const float e = __expf(fminf(cs_l - css[j], 0.f)) * dts[j]; const float val = gt0[j] * e; gm[j] = (4 * g + j <= l) ? val : 0.f; } }
            const bf16x8 wf = pack8(gm, (f32x4){0.f, 0.f, 0.f, 0.f});
            f32x4 a1 = (f32x4){0.f, 0.f, 0.f, 0.f}, a2 = (f32x4){0.f, 0.f, 0.f, 0.f};
            { const v2u lo = *(const LAS v2u*)(XT + (16 * pt + c16) * SP72 + 4 * g), hi = *(const LAS v2u*)(XT + (16 * pt + c16) * SP72 + 16 + 4 * g); v4u wv; wv.x = lo.x; wv.y = lo.y; wv.z = hi.x; wv.w = hi.y; a1 = MFMA16(__builtin_bit_cast(bf16x8, wv), wf, a1); }
#pragma unroll
            for (int ks = 0; ks < 4; ++ks) { const bf16x8 af = *(const LAS bf16x8*)(HB + (16 * pt + c16) * SP136 + ks * 32 + 8 * g); a2 = MFMA16(af, cf[ks], a2); }
            const f32x4 x4 = *(const LAS f32x4*)(XF + l * SP68 + 16 * pt + 4 * g); const float ecl = __expf(cs_l), Dh = INP(I_SD)[head];
            float v[4], q = 0.f;
#pragma unroll
            for (int j = 0; j < 4; ++j) { const float y = a1[j] + ecl * a2[j] + Dh * x4[j]; v[j] = y * siluf_(z4[hh][j]); q += v[j] * v[j]; }
            q += __shfl_xor(q, 16); q += __shfl_xor(q, 32);
            if (l < TS) { const int R = R0 + l; v2u o; o.x = pk2(v[0], v[1]); o.y = pk2(v[2], v[3]); *(GAS v2u*)(WSP(bf16, WS_V) + (size_t)R * DMIX + 2048 + head * 64 + 16 * pt + 4 * g) = o;
                if (g == 0) WSP(float, WS_SQV)[(size_t)R * NSQV + 32 + head * 4 + pt] = q; } }
        LDS_BAR();
        { const float dec = __expf(CS[hh * 16 + 15]); const bf16x8 af = *(const LAS bf16x8*)(XS + (16 * hpt + c16) * SP72 + 8 * g);
#pragma unroll
          for (int i = 0; i < 4; ++i) { const bf16x8 bfr = *(const LAS bf16x8*)(BT + (16 * (hnt0 + i) + c16) * SP72 + 8 * g); Hacc[hh][i] = MFMA16(bfr, af, Hacc[hh][i] * dec); } }
        LDS_BAR();
    }
#pragma unroll
    for (int hh = 0; hh < 4; ++hh)
#pragma unroll
        for (int i = 0; i < 4; ++i) *(GAS f32x4*)(F.out + O_SSH + ((size_t)(sq * SSD_H + head0 + hh) * SSD_P + 16 * hpt + c16) * SSD_N + 16 * (hnt0 + i) + 4 * g) = Hacc[hh][i];
}
__device__ __forceinline__ void p4_mixer_prompt(Frame& F, const Args& A) {
    for (int it = blockIdx.x; it < 128 + 128; it += F.G) {
        if (it < 128) lru_item<false>(F, A, it >> 5, (it >> 1) & 15, it & 1); else ssd_item<64>(F, A, (it - 128) >> 5, (it - 128) & 31);
    }
}
__device__ __forceinline__ void p4_mixer_sample(Frame& F, const Args& A, int qoff) {
    for (;;) {
        LDS_BAR();
        if (F.tid == 0) F.MISC[0] = __hip_atomic_fetch_add(F.ctl + CW_QUEUE + qoff, 1u, RLX_AGENT);
        LDS_BAR();
        const int it = (int)F.MISC[0];
        if (it >= 512 + NBS * (SSD_H / 4)) break;
        if (it < 512) lru_item<true>(F, A, it >> 5, (it >> 1) & 15, it & 1); else ssd_sample4(F, A, (it - 512) >> 3, (it - 512) & 7);
    }
}

#ifndef LRU_PROBE
#define LRU_PROBE 0
#endif
#ifndef SSD_PROBE
#define SSD_PROBE 0
#endif
#ifndef DUP_PHASE
#define DUP_PHASE -1
#endif
#ifndef MK_PER_PHASE
#define MK_PER_PHASE 0
#endif
constexpr int N_PHASES = 14;
constexpr int CW_QH = 20480;
template <class Epi> __device__ __forceinline__ void run_gemm_r(Frame& F, const bf16* Aop, const bf16* Bt, int Mr, int N, int K, const Epi& E, int lo, int n, int G, int c) {
    pg8::Gemm g{Aop, Bt, Mr, N, K}; pg8::RangeOrder R; R.init(Mr, N, lo, n, G, c);
    pg8::gemm_phase<Epi, pg8::RangeOrder, PG8_ALIGN, PG8_SP2>(F.lds + RING_OFF, g, R, E);
}
__global__ void __launch_bounds__(NWAVES * 64, 2) hymba_fwd(Args args) {
    extern __shared__ __attribute__((aligned(16))) unsigned char lds[];
    const Args& A = args;
    Frame F;
    F.lds = (LAS unsigned char*)lds;
    F.MISC = (volatile LAS unsigned*)(F.lds + MISC_OFF);
    F.tid = threadIdx.x; F.lane = F.tid & 63; F.wave = __builtin_amdgcn_readfirstlane(F.tid >> 6);
    F.G = gridDim.x; { const int bx = blockIdx.x; F.vcu = (F.G % 8 == 0) ? (bx % 8) * (F.G / 8) + bx / 8 : bx; }
    F.ws = args.ws; F.out = args.out; F.ctl = (gu32*)(args.ws + WS_CTL);
    for (int u = F.tid; u < (LDS_BYTES - LDSCTL_OFF) / 4; u += NWAVES * 64) ((LAS unsigned*)(F.lds + LDSCTL_OFF))[u] = 0u;
    __syncthreads();
    XcdBarrier bar = xcd_barrier_post((unsigned*)(F.ctl + CW_BAR), F.MISC + 8);
#define GRID_BAR() xcd_barrier(bar)
#define SLOT_BEGIN(slot_) do { cu = 0u; Sx = 0; if (xq == -2) { unsigned ok = 1u; for (int j = 0; j < 16; ++j) { const unsigned c_ = xb_ld((unsigned*)(F.ctl + CW_BAR) + XB_XCNT(j)); ok &= (j < 8) ? (c_ > 0u) : (c_ == 0u); } \
            xq = ok ? (int)(bar.x & 7u) : -1; } \
        __syncthreads(); if (F.tid == 0) F.MISC[16] = __hip_atomic_fetch_add(F.ctl + CW_QH + 64 * ((slot_) * 8 + (xq < 0 ? 0 : xq)), 1u, RLX_AGENT); __syncthreads(); } while (0)
    const int lo = args.ph_lo, hi = args.ph_hi;
#define IN(k) (lo <= (k) && (k) < hi)
#define BOTH(k) (IN(k) && IN((k) + 1))
    const int bid = blockIdx.x;
    float* SSQ0 = WSP(float, WS_SSQ); float* SSQ1 = SSQ0 + (size_t)M * NSSQ; float* SSQ2 = SSQ1 + (size_t)M * NSSQ; float* SSQ3 = SSQ2 + (size_t)M * NSSQ; float* SSQ4 = SSQ3 + (size_t)M * NSSQ;
    unsigned cu = 0u; int Sx = 0, xq = -2;
    bf16* XBA = WSP(bf16, WS_XBA); bf16* XBB = WSP(bf16, WS_XBB); bf16* ACT = WSP(bf16, WS_ACT); float* XR = WSP(float, WS_XR); bf16* VV = WSP(bf16, WS_V); bf16* QQ = WSP(bf16, WS_Q); bf16* OO = WSP(bf16, WS_O);
    constexpr float QSCALE = 0.04419417382415922f;

    if (IN(0)) { p0_prologue(F, A); if (BOTH(0)) GRID_BAR(); }
    constexpr int U_GU_P = (MP / 256) * (NGU / 256), U_GU_S = (MS / 256) * (NGU / 256), U_D_P = (MP / 256) * (D / 256), U_D_S = (MS / 256) * (D / 256), U_IN_P = (MP / 256) * (DINP / 256), U_IN_S = (MS / 256) * (DINP / 256), U_KV = (MMEM / 256) * (2 * D / 256);
    const int G = F.G, c32 = bid - 32;
    if (IN(1)) {
        { pg8::EpiKV E{F.out + O_PMK, F.out + O_PMV, WSP(bf16, WS_KM), WSP(bf16, WS_VT), WSP(float, WS_SSQM), 0}; run_gemm_r(F, WSP(bf16, WS_MEMB), WSP(bf16, WS_WKV), MMEM, 2 * D, D, E, 0, U_KV, G, bid); }
        { pg8::EpiSwiglu E{ACT, FF, SSQ0, MP}; run_gemm_r(F, XBA + (size_t)MP * D, WSP(bf16, WS_W1GU), MS, NGU, D, E, 0, U_GU_S, G, bid - 64 >= 0 ? bid - 64 : bid + G - 64); }
        if (BOTH(1)) GRID_BAR(); }
    if (IN(2)) {
        { pg8::EpiRes<true, true> E{INP(I_XP), INP(I_XS), XR, XBB, SSQ1, 0.5f, MP}; run_gemm_r(F, ACT + (size_t)MP * FF, WSP(bf16, WS_W1D), MS, D, FF, E, 0, U_D_S, 32, bid < 32 ? bid : -1); }
        { pg8::EpiSwiglu E{ACT, FF, SSQ0, 0}; if (bid < 32) run_gemm_r(F, XBA, WSP(bf16, WS_W1GU), MP, NGU, D, E, U_GU_P - 96, 96, 32, bid); else run_gemm_r(F, XBA, WSP(bf16, WS_W1GU), MP, NGU, D, E, 0, U_GU_P - 96, G - 32, c32); }
        if (BOTH(2)) GRID_BAR(); }
    if (IN(3)) {
        { pg8::EpiRes<true, true> E{INP(I_XP), INP(I_XS), XR, XBB, SSQ1, 0.5f, 0}; run_gemm_r(F, ACT, WSP(bf16, WS_W1D), MP, D, FF, E, 0, U_D_P, G, bid); }
        { pg8::EpiProj E{WSP(float, WS_PROJ), DINP, SSQ1, MP}; run_gemm_r(F, XBB + (size_t)MP * D, WSP(bf16, WS_WIN), MS, DINP, D, E, 0, U_IN_S, G, bid); }
        if (G > U_IN_S) { if (bid >= U_IN_S) convert_weights<1>(F, A, (bid - U_IN_S) * NWAVES + F.wave, (G - U_IN_S) * NWAVES); } else convert_weights<1>(F, A, F.vcu * NWAVES + F.wave, G * NWAVES);
        if (BOTH(3)) GRID_BAR(); }
    if (IN(4)) {
        { pg8::EpiProj E{WSP(float, WS_PROJ), DINP, SSQ1, 0}; run_gemm_r(F, XBB, WSP(bf16, WS_WIN), MP, DINP, D, E, 0, U_IN_P, G, bid); }
        p4_mixer_sample(F, A, 0);
        if (BOTH(4)) GRID_BAR(); }
    if (IN(5)) { p3b_bcconv(F, A); GRID_BAR(); }
    if (IN(5)) {
        p4_mixer_prompt(F, A);
#if SSD_PROBE
        GRID_BAR(); if (bid >= 128) ssd_item<64, SSD_PROBE>(F, A, (bid - 128) >> 5, (bid - 128) & 31);
#endif
#if LRU_PROBE
        GRID_BAR(); if (bid < 128) lru_item<false, LRU_PROBE>(F, A, bid >> 5, (bid >> 1) & 15, bid & 1);
#endif
        p5_normalize(F, A, MP, M, NBP, NBP + NBS, F.vcu * NWAVES + F.wave, F.G * NWAVES);
        if (BOTH(5)) GRID_BAR(); }
    if (IN(6)) {
        { pg8::EpiRes<false, true> E{nullptr, nullptr, XR, XBA, SSQ2, 1.0f, MP}; run_gemm_r(F, VV + (size_t)MP * DMIX, WSP(bf16, WS_WOUT), MS, D, DMIX, E, 0, U_D_S, 32, bid < 32 ? bid : -1); }
        if (G > 32) { if (bid >= 32) { p5_normalize(F, A, 0, MP, 0, NBP, c32 * NWAVES + F.wave, (G - 32) * NWAVES); convert_weights<2>(F, A, c32 * NWAVES + F.wave, (G - 32) * NWAVES); } }
        else { p5_normalize(F, A, 0, MP, 0, NBP, F.vcu * NWAVES + F.wave, G * NWAVES); convert_weights<2>(F, A, F.vcu * NWAVES + F.wave, G * NWAVES); }
        if (BOTH(6)) GRID_BAR(); }
    if (IN(7)) {
        { pg8::EpiRes<false, true> E{nullptr, nullptr, XR, XBA, SSQ2, 1.0f, 0}; run_gemm_r(F, VV, WSP(bf16, WS_WOUT), MP, D, DMIX, E, 0, U_D_P, G, bid); }
        { pg8::EpiQ E{QQ, SSQ2, QSCALE, MP}; run_gemm_r(F, XBA + (size_t)MP * D, WSP(bf16, WS_WQ), MS, D, D, E, 0, U_D_S, 32, bid < 32 ? bid : -1); }
        if (G > 32) { if (bid >= 32) convert_weights<3>(F, A, c32 * NWAVES + F.wave, (G - 32) * NWAVES); } else convert_weights<3>(F, A, F.vcu * NWAVES + F.wave, G * NWAVES);
        if (BOTH(7)) GRID_BAR(); }
    if (IN(8)) {
        const bool attn_first = ((bid >> 3) & 1) != 0;
        if (attn_first) p8_attn_sample(F, A);
        { pg8::EpiQ E{QQ, SSQ2, QSCALE, 0}; run_gemm_r(F, XBA, WSP(bf16, WS_WQ), MP, D, D, E, 0, U_D_P, G, bid); }
        if (!attn_first) p8_attn_sample(F, A);
        if (BOTH(8)) GRID_BAR(); }
    if (IN(9)) {
        { pg8::EpiRes<false, true> E{nullptr, nullptr, XR, XBB, SSQ3, 1.0f, MP}; run_gemm_r(F, OO + (size_t)MP * D, WSP(bf16, WS_WO), MS, D, D, E, 0, U_D_S, 32, bid < 32 ? bid : -1); }
        if (G > 32) p8_attn_prompt(F, A, c32, G - 32); else p8_attn_prompt(F, A, bid, G);
        if (BOTH(9)) GRID_BAR(); }
    if (IN(10)) {
        { pg8::EpiRes<false, true> E{nullptr, nullptr, XR, XBB, SSQ3, 1.0f, 0}; run_gemm_r(F, OO, WSP(bf16, WS_WO), MP, D, D, E, 0, U_D_P, G, bid); }
        { pg8::EpiSwiglu E{ACT, FF, SSQ3, MP}; run_gemm_r(F, XBB + (size_t)MP * D, WSP(bf16, WS_W2GU), MS, NGU, D, E, 0, U_GU_S, G, bid); }
        if (BOTH(10)) GRID_BAR(); }
    if (IN(11)) {
        { pg8::EpiRes<false, false> E{nullptr, nullptr, XR, nullptr, SSQ4, 0.5f, MP}; run_gemm_r(F, ACT + (size_t)MP * FF, WSP(bf16, WS_W2D), MS, D, FF, E, 0, U_D_S, 32, bid < 32 ? bid : -1); }
        { pg8::EpiSwiglu E{ACT, FF, SSQ3, 0}; if (bid < 32) run_gemm_r(F, XBB, WSP(bf16, WS_W2GU), MP, NGU, D, E, U_GU_P - 96, 96, 32, bid); else run_gemm_r(F, XBB, WSP(bf16, WS_W2GU), MP, NGU, D, E, 0, U_GU_P - 96, G - 32, c32); }
        if (BOTH(11)) GRID_BAR(); }
    if (IN(12)) {
        { pg8::EpiRes<false, false> E{nullptr, nullptr, XR, nullptr, SSQ4, 0.5f, 0}; run_gemm_r(F, ACT, WSP(bf16, WS_W2D), MP, D, FF, E, 0, U_D_P, G, bid); }
        p12_final(F, A, MP, M);
        if (BOTH(12)) GRID_BAR(); }
    if (IN(13)) { p12_final(F, A, 0, MP); }
#undef IN
#undef BOTH
}

extern "C" void kernel_launch(void* const* d_in, const int* in_sizes, int n_in, void* d_out, int out_size, void* d_ws, size_t ws_size, hipStream_t stream) {
    static int grid = 0;
    if (grid == 0) {
        if (n_in != N_IN || (size_t)out_size != O_END || ws_size < WS_END) { fprintf(stderr, "kernel_launch: shape mismatch: n_in %d out %d ws %zu (need %zu)\n", n_in, out_size, ws_size, (size_t)WS_END); grid = -1; return; }
        int dev = 0, cus = 0, per_cu = 0;
        if (hipGetDevice(&dev) != hipSuccess || hipDeviceGetAttribute(&cus, hipDeviceAttributeMultiprocessorCount, dev) != hipSuccess) { grid = -1; return; }
        if (hipFuncSetAttribute((const void*)hymba_fwd, hipFuncAttributeMaxDynamicSharedMemorySize, LDS_BYTES) != hipSuccess) { fprintf(stderr, "kernel_launch: hipFuncSetAttribute failed\n"); grid = -1; return; }
        if (hipOccupancyMaxActiveBlocksPerMultiprocessor(&per_cu, (const void*)hymba_fwd, NWAVES * 64, LDS_BYTES) != hipSuccess || per_cu < 1) { fprintf(stderr, "kernel_launch: occupancy query says %d blocks per CU\n", per_cu); (void)hipGetLastError(); grid = -1; return; }
        grid = cus;
    }
    if (grid < 0) return;
    if (hipMemsetAsync((char*)d_ws + WS_CTL, 0, CTL_ZERO_BYTES, stream) != hipSuccess) return;
    Args a{};
    for (int i = 0; i < N_IN; ++i) a.in[i] = (const float*)d_in[i];
    a.out = (float*)d_out; a.ws = (unsigned char*)d_ws;
    a.ph_lo = 0; a.ph_hi = N_PHASES; hipLaunchKernelGGL(hymba_fwd, dim3(grid), dim3(NWAVES * 64), LDS_BYTES, stream, a);
}
```
